# Optimizing an MI355X kernel written in HIP

```python
import math
import jax, jax.numpy as jnp
from jax import lax
import numpy as np

D_MODEL = 2048
BATCH = 8
SEQ = 2048
DEPTH = 1

ATTN_WIDTH = D_MODEL // 2
CONV_WIDTH = D_MODEL - ATTN_WIDTH
HEAD_DIM = 128
N_ATTN_HEADS = ATTN_WIDTH // HEAD_DIM
CONV_GROUPS = 8
CONV_K = 3
MOBA_BLOCK = 256
MOBA_TOPK = 3
Q_CHUNK = 64
D_FF = 4 * D_MODEL
LN_EPS = 1e-5
RMS_EPS = 1e-6
DEEPNORM_ALPHA = (2.0 * DEPTH) ** 0.25
DEEPNORM_BETA = (8.0 * DEPTH) ** -0.25

kernel_name = 'hymba_moba_shortconv_deepnorm_block'


def layer_norm(x, g, b):
    xf = x.astype(jnp.float32)
    mu = jnp.mean(xf, axis=-1, keepdims=True)
    var = jnp.mean(jnp.square(xf - mu), axis=-1, keepdims=True)
    return ((xf - mu) * lax.rsqrt(var + LN_EPS) * g.astype(jnp.float32) + b.astype(jnp.float32)).astype(x.dtype)


def rms_norm(x, g):
    xf = x.astype(jnp.float32)
    ms = jnp.mean(jnp.square(xf), axis=-1, keepdims=True)
    return (xf * lax.rsqrt(ms + RMS_EPS) * g.astype(jnp.float32)).astype(x.dtype)


def moba_attention(q, k, v):
    B, S, H, Dh = q.shape
    n_blocks = -(-S // MOBA_BLOCK)
    s_pad = n_blocks * MOBA_BLOCK
    top_k = max(1, min(MOBA_TOPK, n_blocks - 1))
    n_chunks = S // Q_CHUNK
    scale = Dh ** -0.5

    pad = ((0, 0), (0, s_pad - S), (0, 0), (0, 0))
    kb = jnp.pad(k, pad).reshape(B, n_blocks, MOBA_BLOCK, H, Dh).transpose(0, 3, 1, 2, 4)
    vb = jnp.pad(v, pad).reshape(B, n_blocks, MOBA_BLOCK, H, Dh).transpose(0, 3, 1, 2, 4)
    k_mean = jnp.mean(kb.astype(jnp.float32), axis=3)
    qc = q.reshape(B, n_chunks, Q_CHUNK, H, Dh).transpose(0, 1, 3, 2, 4)

    chunk_ids = jnp.arange(n_chunks)
    head_ids = jnp.arange(H)[:, None, None]
    blk_ids = jnp.arange(n_blocks)
    key_off = jnp.arange(MOBA_BLOCK)
    q_off = jnp.arange(Q_CHUNK)
    slot_ids = jnp.arange(top_k)

    def per_batch(args):
        q_b, kb_b, vb_b, km_b = args

        def per_chunk(cargs):
            q_c, c = cargs
            q_pos = c * Q_CHUNK + q_off
            own = (c * Q_CHUNK) // MOBA_BLOCK
            gate = jnp.einsum('hqd,hnd->hqn', q_c.astype(jnp.float32), km_b)
            gate = jnp.where(blk_ids[None, None, :] < own, gate, -jnp.inf)
            _, sel = lax.top_k(gate, top_k)
            sel_valid = slot_ids < own
            k_sel = kb_b[head_ids, sel]
            v_sel = vb_b[head_ids, sel]
            s_sel = jnp.einsum('hqd,hqkjd->hqkj', q_c, k_sel,
                               preferred_element_type=jnp.float32) * scale
            s_sel = jnp.where(sel_valid[None, None, :, None], s_sel, -jnp.inf)
            k_own = lax.dynamic_index_in_dim(kb_b, own, axis=1, keepdims=False)
            v_own = lax.dynamic_index_in_dim(vb_b, own, axis=1, keepdims=False)
            s_own = jnp.einsum('hqd,hjd->hqj', q_c, k_own,
                               preferred_element_type=jnp.float32) * scale
            k_pos = own * MOBA_BLOCK + key_off
            s_own = jnp.where(k_pos[None, None, :] <= q_pos[None, :, None], s_own, -jnp.inf)
            s_all = jnp.concatenate([s_sel.reshape(H, Q_CHUNK, top_k * MOBA_BLOCK), s_own], axis=-1)
            p = jax.nn.softmax(s_all, axis=-1).astype(v_sel.dtype)
            p_sel = p[..., :top_k * MOBA_BLOCK].reshape(H, Q_CHUNK, top_k, MOBA_BLOCK)
            p_own = p[..., top_k * MOBA_BLOCK:]
            return (jnp.einsum('hqkj,hqkjd->hqd', p_sel, v_sel)
                    + jnp.einsum('hqj,hjd->hqd', p_own, v_own))

        return lax.map(per_chunk, (q_b, chunk_ids))

    out = lax.map(per_batch, (qc, kb, vb, k_mean))
    return out.transpose(0, 1, 3, 2, 4).reshape(B, S, H * Dh)


def short_conv(b_gate, c_gate, u, conv_w):
    S = u.shape[1]
    z = c_gate * u
    zp = jnp.pad(z, ((0, 0), (CONV_K - 1, 0), (0, 0)))
    y = conv_w[0] * zp[:, 0:S]
    for j in range(1, CONV_K):
        y = y + conv_w[j] * zp[:, j:j + S]
    return b_gate * y


def setup_inputs(seed: int = 0) -> dict:
    key = jax.random.key(seed)
    ks = jax.random.split(key, 13)
    d = D_MODEL
    n_in = 3 * ATTN_WIDTH + 3 * CONV_WIDTH
    nrm = jax.random.normal
    f32 = jnp.float32
    x = nrm(ks[0], (BATCH, SEQ, d), f32)
    w_in = nrm(ks[1], (DEPTH, d, n_in), f32) * d ** -0.5
    conv_w = nrm(ks[2], (DEPTH, CONV_K, CONV_WIDTH), f32) * CONV_K ** -0.5
    attn_out_g = 1.0 + 0.02 * nrm(ks[3], (DEPTH, ATTN_WIDTH), f32)
    conv_out_g = 1.0 + 0.02 * nrm(ks[4], (DEPTH, CONV_WIDTH), f32)
    w_o = nrm(ks[5], (DEPTH, d, d), f32) * (d ** -0.5 * DEEPNORM_BETA)
    ln1_g = 1.0 + 0.02 * nrm(ks[6], (DEPTH, d), f32)
    ln1_b = 0.02 * nrm(ks[7], (DEPTH, d), f32)
    w_up = nrm(ks[8], (DEPTH, d, D_FF), f32) * d ** -0.5
    w_down = nrm(ks[9], (DEPTH, D_FF, d), f32) * (D_FF ** -0.5 * DEEPNORM_BETA)
    ln2_g = 1.0 + 0.02 * nrm(ks[10], (DEPTH, d), f32)
    ln2_b = 0.02 * nrm(ks[11], (DEPTH, d), f32)
    return {'x': x, 'w_in': w_in, 'conv_w': conv_w, 'attn_out_g': attn_out_g,
            'conv_out_g': conv_out_g, 'w_o': w_o, 'ln1_g': ln1_g, 'ln1_b': ln1_b,
            'w_up': w_up, 'w_down': w_down, 'ln2_g': ln2_g, 'ln2_b': ln2_b}


def reference(x, w_in, conv_w, attn_out_g, conv_out_g, w_o, ln1_g, ln1_b,
              w_up, w_down, ln2_g, ln2_b):
    B, S, _ = x.shape
    A, C = ATTN_WIDTH, CONV_WIDTH
    splits = [A, 2 * A, 3 * A, 3 * A + C, 3 * A + 2 * C]
    for l in range(DEPTH):
        proj = x @ w_in[l]
        q, k, v, b_gate, c_gate, u = jnp.split(proj, splits, axis=-1)
        q = q.reshape(B, S, N_ATTN_HEADS, HEAD_DIM)
        k = k.reshape(B, S, N_ATTN_HEADS, HEAD_DIM)
        v = v.reshape(B, S, N_ATTN_HEADS, HEAD_DIM)
        attn = moba_attention(q, k, v)
        conv = short_conv(b_gate, c_gate, u, conv_w[l])
        mixed = jnp.concatenate([rms_norm(attn, attn_out_g[l]),
                                 rms_norm(conv, conv_out_g[l])], axis=-1)
        h = layer_norm(DEEPNORM_ALPHA * x + mixed @ w_o[l], ln1_g[l], ln1_b[l])
        ff = jnp.square(jax.nn.relu(h @ w_up[l])) @ w_down[l]
        x = layer_norm(DEEPNORM_ALPHA * h + ff, ln2_g[l], ln2_b[l])
    return x
```

```cpp
#include <hip/hip_runtime.h>
#include <hip/hip_cooperative_groups.h>
#include <cstdio>
#include <cstdint>
namespace cg = cooperative_groups;

constexpr int M_TOK = 16384, DM = 2048, SEQ = 2048, NBATCH = 8, AW = 1024, NPROJ = 6144, FF = 8192, NHEAD = 8, HD = 128, NBLK = 8;
constexpr float LN_EPS = 1e-5f, RMS_EPS = 1e-6f, ALPHA = 1.189207115002721f;
constexpr float WQ_SCALE = 1536.f, WQ_INV = 1.0f / 1536.f;
constexpr float AQ_SCALE = 16.f, WOA_SCALE = 512.f, P3_ATT_INV = 1.0f / (16.f * 512.f);
constexpr int MIX_PITCH = 3072;
constexpr float YQ_SCALE = 24.f, YQ_INV = 1.0f / 24.f;
constexpr float WDN_SCALE = 1024.f, WDN_INV_SCALE = 1.0f / 1024.f;

namespace pg8 {
#define PG8_LAS __attribute__((address_space(3)))
typedef unsigned short bf16_t;
typedef short bf16x8 __attribute__((ext_vector_type(8)));
typedef float f32x4 __attribute__((ext_vector_type(4)));
typedef unsigned u32x4 __attribute__((ext_vector_type(4)));
typedef int v4i_t __attribute__((ext_vector_type(4)));
constexpr int BM = 256, BK = 64, HALF = 128, HTB = HALF * BK * 2  , STAGE_BYTES = 8 * HTB, NXCD = 8, WGM = 8;

__host__ __device__ __forceinline__ int lds_byte(int r, int c) { const int st = (r >> 4) * 2 + (c >> 5), rr = r & 15, cc = c & 31, ob = rr * 64 + cc * 2; return st * 1024 + (ob ^ (((ob >> 9) & 1) << 5)); }
__host__ __device__ __forceinline__ void stage_rc(int b, int& R, int& C) { const int st = b / 1024, sb = b % 1024, swz = sb ^ (((sb >> 9) & 1) << 5); R = (st >> 1) * 16 + swz / 64; C = (st & 1) * 32 + (swz % 64) / 2; }
__host__ __device__ __forceinline__ int perm32(int rho) { const int n = rho >> 4, i = rho & 15; return 8 * (i >> 2) + 4 * n + (i & 3); }

struct Unit { int pm, pn; };
struct Gemm { const bf16_t* A; const bf16_t* Bt; int M, N, K; };

struct StaticOrder {
    int nM, nN, nwg, G, c;
    __host__ __device__ void init(int M, int N, int G_, int c_) { nM = M / BM; nN = N / BM; nwg = nM * nN; G = G_; c = c_; }
    __host__ __device__ bool next(int i, Unit& u) const {
        const long L = (long)i * G + c; if (L >= nwg) return false;
        int wgid = (int)L; { const int q = nwg / NXCD, r = nwg % NXCD, xcd = wgid % NXCD, off = wgid / NXCD; wgid = (xcd < r ? xcd * (q + 1) : r * (q + 1) + (xcd - r) * q) + off; }
        const int nig = WGM * nN, gid = wgid / nig, fm = gid * WGM, gsz = (nM - fm) < WGM ? (nM - fm) : WGM;
        u.pm = fm + ((wgid % nig) % gsz); u.pn = (wgid % nig) / gsz; return true;
    }
    __device__ __forceinline__ void a_ready(const Unit&) const {}
    __device__ __forceinline__ void done(const Unit&) const {}
};
__device__ __forceinline__ unsigned cvt_pk_bf16(float lo, float hi) { unsigned r; asm volatile("v_cvt_pk_bf16_f32 %0, %1, %2" : "=v"(r) : "v"(lo), "v"(hi)); return r; }
__device__ __forceinline__ float bf_lo(unsigned w) { return __uint_as_float(w << 16); }
__device__ __forceinline__ float bf_hi(unsigned w) { return __uint_as_float(w & 0xffff0000u); }
__device__ __forceinline__ float hsum4(f32x4 v) { return (v[0] + v[1]) + (v[2] + v[3]); }
__device__ __forceinline__ float hsq4(f32x4 v) { return (v[0] * v[0] + v[1] * v[1]) + (v[2] * v[2] + v[3] * v[3]); }
__device__ __forceinline__ unsigned pack_i8x4(f32x4 v) {
    const unsigned u0 = __float_as_uint(__builtin_amdgcn_fmed3f(v[0], -127.f, 127.f) + 12582912.f), u1 = __float_as_uint(__builtin_amdgcn_fmed3f(v[1], -127.f, 127.f) + 12582912.f);
    const unsigned u2 = __float_as_uint(__builtin_amdgcn_fmed3f(v[2], -127.f, 127.f) + 12582912.f), u3 = __float_as_uint(__builtin_amdgcn_fmed3f(v[3], -127.f, 127.f) + 12582912.f);
    const unsigned w01 = __builtin_amdgcn_perm(u1, u0, 0x0c0c0400u), w23 = __builtin_amdgcn_perm(u3, u2, 0x0c0c0400u);
    return __builtin_amdgcn_perm(w23, w01, 0x05040100u);
}
__device__ __forceinline__ f32x4 i32_to_f32(f32x4 a) { return __builtin_convertvector(__builtin_bit_cast(v4i_t, a), f32x4); }
__device__ __forceinline__ void atomic_addf(float* p, float v) { (void)__hip_atomic_fetch_add(p, v, __ATOMIC_RELAXED, __HIP_MEMORY_SCOPE_AGENT); }

struct EpiProj {
    static constexpr bool PERM = true, AFTER_DRAIN = false, MID = false; static constexpr int MID_T = 0;
    bf16_t* O; float* kpart;
    __device__ __forceinline__ void mid(f32x4 (&)[2][2][4][2], PG8_LAS unsigned char*, int, int) const {}
    __device__ __forceinline__ void operator()(const f32x4 (&acc)[2][2][4][2], const Unit& u, int wr, int wc, int fr, int fq) const {
        const int t = u.pn >> 2, colt = (u.pn & 3) * BM;
        const int row0 = u.pm * BM + wr * 64 + fr;
        bf16_t* base = O + (size_t)t * ((size_t)M_TOK * 1024);
        const int col0 = colt + wc * 32 + 8 * fq;
#pragma unroll
        for (int ai = 0; ai < 2; ++ai)
#pragma unroll
            for (int m = 0; m < 4; ++m) { bf16_t* rowp = base + (size_t)(row0 + ai * HALF + m * 16) * 1024 + col0;
#pragma unroll
                for (int bj = 0; bj < 2; ++bj) { const f32x4 v0 = acc[ai][bj][m][0], v1 = acc[ai][bj][m][1];
                    u32x4 w; w.x = cvt_pk_bf16(v0[0], v0[1]); w.y = cvt_pk_bf16(v0[2], v0[3]); w.z = cvt_pk_bf16(v1[0], v1[1]); w.w = cvt_pk_bf16(v1[2], v1[3]);
                    *(u32x4*)(rowp + bj * HALF) = w; } }
        if (t == 1) {
#pragma unroll
            for (int bj = 0; bj < 2; ++bj)
#pragma unroll
                for (int n = 0; n < 2; ++n) { f32x4 s = (f32x4){0.f, 0.f, 0.f, 0.f};
#pragma unroll
                    for (int ai = 0; ai < 2; ++ai)
#pragma unroll
                        for (int m = 0; m < 4; ++m) s += acc[ai][bj][m][n];
#pragma unroll
                    for (int o = 1; o < 16; o <<= 1) { s[0] += __shfl_xor(s[0], o); s[1] += __shfl_xor(s[1], o); s[2] += __shfl_xor(s[2], o); s[3] += __shfl_xor(s[3], o); }
                    if (fr == 0) *(f32x4*)(kpart + ((size_t)wr * 64 + u.pm) * 1024 + col0 + bj * HALF + 4 * n) = s; }
        }
    }
};

struct EpiProjI8 {
    static constexpr bool PERM = true, AFTER_DRAIN = false, MID = false, LDSX = false; static constexpr int MID_T = 0;
    bf16_t* O; const float* xs;
    __device__ __forceinline__ void mid(f32x4 (&)[2][2][4][2], PG8_LAS unsigned char*, int, int) const {}
    __device__ __forceinline__ void operator()(const f32x4 (&acc)[2][2][4][2], const Unit& u, int wr, int wc, int fr, int fq) const {
        const int row0 = u.pm * BM + wr * 64 + fr;
        float sc[2][4];
#pragma unroll
        for (int ai = 0; ai < 2; ++ai)
#pragma unroll
            for (int m = 0; m < 4; ++m) sc[ai][m] = xs[row0 + ai * HALF + m * 16] * WQ_INV;
        if (u.pn >= 8) {
            bf16_t* zb = O + (size_t)4 * ((size_t)M_TOK * 1024); const int ch0 = (u.pn - 8) * HALF + wc * 32 + 8 * fq;
#pragma unroll
            for (int ai = 0; ai < 2; ++ai)
#pragma unroll
                for (int m = 0; m < 4; ++m) { const float s2 = sc[ai][m] * sc[ai][m];
                    const f32x4 v0 = i32_to_f32(acc[ai][0][m][0]) * i32_to_f32(acc[ai][1][m][0]) * s2, v1 = i32_to_f32(acc[ai][0][m][1]) * i32_to_f32(acc[ai][1][m][1]) * s2;
                    u32x4 w; w.x = cvt_pk_bf16(v0[0], v0[1]); w.y = cvt_pk_bf16(v0[2], v0[3]); w.z = cvt_pk_bf16(v1[0], v1[1]); w.w = cvt_pk_bf16(v1[2], v1[3]);
                    *(u32x4*)(zb + (size_t)(row0 + ai * HALF + m * 16) * 1024 + ch0) = w; }
            return;
        }
        bf16_t* base = O + (size_t)(2 + (u.pn >> 2)) * ((size_t)M_TOK * 1024);
        const int col0 = (u.pn & 3) * BM + wc * 32 + 8 * fq;
#pragma unroll
        for (int ai = 0; ai < 2; ++ai)
#pragma unroll
            for (int m = 0; m < 4; ++m) { bf16_t* rowp = base + (size_t)(row0 + ai * HALF + m * 16) * 1024 + col0;
#pragma unroll
                for (int bj = 0; bj < 2; ++bj) { const f32x4 v0 = i32_to_f32(acc[ai][bj][m][0]) * sc[ai][m], v1 = i32_to_f32(acc[ai][bj][m][1]) * sc[ai][m];
                    u32x4 w; w.x = cvt_pk_bf16(v0[0], v0[1]); w.y = cvt_pk_bf16(v0[2], v0[3]); w.z = cvt_pk_bf16(v1[0], v1[1]); w.w = cvt_pk_bf16(v1[2], v1[3]);
                    *(u32x4*)(rowp + bj * HALF) = w; } }
    }
};

struct EpiWo {
    static constexpr bool PERM = true, AFTER_DRAIN = false, MID = true; static constexpr int MID_T = 8;
    const bf16_t* xb; bf16_t* YB; unsigned char* Y8; float* stats; const float* ssq;
    __device__ __forceinline__ void pre(const Unit& u, PG8_LAS unsigned char* ldsx, int tid) const {
        if (tid < BM) { const int row = u.pm * BM + tid;
            const f32x4 a = *(const f32x4*)(ssq + (size_t)row * 8), b = *(const f32x4*)(ssq + (size_t)row * 8 + 4);
            ((PG8_LAS float*)ldsx)[tid] = __builtin_amdgcn_rsqf((hsum4(a) + hsum4(b)) * (1.0f / 1024.0f) + RMS_EPS) * P3_ATT_INV; }
    }
    __device__ __forceinline__ void mid(f32x4 (&acc)[2][2][4][2], PG8_LAS unsigned char* ldsx, int wr, int fr) const {
#pragma unroll
        for (int ai = 0; ai < 2; ++ai)
#pragma unroll
            for (int m = 0; m < 4; ++m) { const float ra = ((const PG8_LAS float*)ldsx)[ai * HALF + wr * 64 + m * 16 + fr];
#pragma unroll
                for (int bj = 0; bj < 2; ++bj)
#pragma unroll
                    for (int n = 0; n < 2; ++n) acc[ai][bj][m][n] *= ra; }
    }
    __device__ __forceinline__ void operator()(const f32x4 (&acc)[2][2][4][2], const Unit& u, int wr, int wc, int fr, int fq) const {
        const int row0 = u.pm * BM + wr * 64 + fr, col0 = u.pn * BM + wc * 32 + 8 * fq;
#pragma unroll
        for (int ai = 0; ai < 2; ++ai) {
        u32x4 xr[2][4][2];
#pragma unroll
            for (int m = 0; m < 4; ++m)
#pragma unroll
                for (int bj = 0; bj < 2; ++bj) xr[ai][m][bj] = __builtin_nontemporal_load((const u32x4*)(xb + (size_t)(row0 + ai * HALF + m * 16) * DM + col0 + bj * HALF));
#pragma unroll
            for (int m = 0; m < 4; ++m) { const int row = row0 + ai * HALF + m * 16; float s = 0.f, q = 0.f;
#pragma unroll
                for (int bj = 0; bj < 2; ++bj) { const u32x4 xw = xr[ai][m][bj];
                    const f32x4 x0 = (f32x4){bf_lo(xw.x), bf_hi(xw.x), bf_lo(xw.y), bf_hi(xw.y)}, x1 = (f32x4){bf_lo(xw.z), bf_hi(xw.z), bf_lo(xw.w), bf_hi(xw.w)};
                    const f32x4 v0 = acc[ai][bj][m][0] + x0 * ALPHA, v1 = acc[ai][bj][m][1] + x1 * ALPHA;
                    s += hsum4(v0) + hsum4(v1); q += hsq4(v0) + hsq4(v1);
                    u32x4 w; w.x = cvt_pk_bf16(v0[0], v0[1]); w.y = cvt_pk_bf16(v0[2], v0[3]); w.z = cvt_pk_bf16(v1[0], v1[1]); w.w = cvt_pk_bf16(v1[2], v1[3]);
                    const int col = col0 + bj * HALF;
                    typedef unsigned u32x2 __attribute__((ext_vector_type(2)));
                    *(u32x2*)(Y8 + (size_t)row * DM + col) = (u32x2){pack_i8x4(v0 * YQ_SCALE), pack_i8x4(v1 * YQ_SCALE)}; }
                s += __shfl_xor(s, 16); s += __shfl_xor(s, 32); q += __shfl_xor(q, 16); q += __shfl_xor(q, 32);
                if (fq == 0) { atomic_addf(stats + (size_t)row * 2, s); atomic_addf(stats + (size_t)row * 2 + 1, q); } }
        }
    }
};

struct EpiUp {
    static constexpr bool PERM = true, AFTER_DRAIN = false, MID = false; static constexpr int MID_T = 0;
    const float* stats1; const float* c1; const float* c2; unsigned char* R;
    __device__ __forceinline__ void mid(f32x4 (&)[2][2][4][2], PG8_LAS unsigned char*, int, int) const {}
    __device__ __forceinline__ void operator()(const f32x4 (&acc)[2][2][4][2], const Unit& u, int wr, int wc, int fr, int fq) const {
        const int row0 = u.pm * BM + wr * 64 + fr, col0 = u.pn * BM + wc * 32 + 8 * fq;
        f32x4 k1[2][2], k2[2][2];
#pragma unroll
        for (int bj = 0; bj < 2; ++bj)
#pragma unroll
            for (int n = 0; n < 2; ++n) { k1[bj][n] = *(const f32x4*)(c1 + col0 + bj * HALF + 4 * n); k2[bj][n] = *(const f32x4*)(c2 + col0 + bj * HALF + 4 * n); }
        typedef float f32x2 __attribute__((ext_vector_type(2))); f32x2 st[2][4];
#pragma unroll
        for (int ai = 0; ai < 2; ++ai)
#pragma unroll
            for (int m = 0; m < 4; ++m) st[ai][m] = *(const f32x2*)(stats1 + (size_t)(row0 + ai * HALF + m * 16) * 2);
        int w0 = 0, w1 = 0;
#pragma unroll
        for (int ai = 0; ai < 2; ++ai)
#pragma unroll
            for (int m = 0; m < 4; ++m) { const int row = row0 + ai * HALF + m * 16;
                const float sm = st[ai][m].x, sq = st[ai][m].y;
                const float mu = sm * (1.0f / DM), var = sq * (1.0f / DM) - mu * mu, rstd = __builtin_amdgcn_rsqf(var + LN_EPS), rs = rstd * (YQ_INV * WQ_INV), nm = -rstd * mu;
#pragma unroll
                for (int bj = 0; bj < 2; ++bj) {
                    f32x4 v0 = i32_to_f32(acc[ai][bj][m][0]) * rs + (k1[bj][0] * nm + k2[bj][0]), v1 = i32_to_f32(acc[ai][bj][m][1]) * rs + (k1[bj][1] * nm + k2[bj][1]);
#pragma unroll
                    for (int e = 0; e < 4; ++e) { v0[e] = __builtin_amdgcn_fmed3f(v0[e], 0.f, 21.166f); v1[e] = __builtin_amdgcn_fmed3f(v1[e], 0.f, 21.166f); }
                    v0 = v0 * v0; v1 = v1 * v1;
                    w0 = __builtin_amdgcn_cvt_pk_fp8_f32(v0[0], v0[1], w0, false); w0 = __builtin_amdgcn_cvt_pk_fp8_f32(v0[2], v0[3], w0, true);
                    w1 = __builtin_amdgcn_cvt_pk_fp8_f32(v1[0], v1[1], w1, false); w1 = __builtin_amdgcn_cvt_pk_fp8_f32(v1[2], v1[3], w1, true);
                    typedef int i32x2 __attribute__((ext_vector_type(2)));
                    *(i32x2*)(R + (size_t)row * FF + col0 + bj * HALF) = (i32x2){w0, w1}; } }
    }
};

struct EpiDownLN {
    static constexpr bool PERM = true, AFTER_DRAIN = false, MID = false; static constexpr int MID_T = 0;
    const unsigned char* Y8; const float* stats1; const float* g1; const float* b1; float* stats2; unsigned* cnt; const float* g2; const float* b2; float* out;
    __device__ __forceinline__ void mid(f32x4 (&)[2][2][4][2], PG8_LAS unsigned char*, int, int) const {}
    __device__ __forceinline__ void operator()(f32x4 (&acc)[2][2][4][2], const Unit& u, int wr, int wc, int fr, int fq) const {
        const int row0 = u.pm * BM + wr * 64 + fr, col0 = u.pn * BM + wc * 32 + 8 * fq;
        typedef float f32x2 __attribute__((ext_vector_type(2)));
        {
        f32x4 gv[2][2], bv[2][2];
#pragma unroll
        for (int bj = 0; bj < 2; ++bj)
#pragma unroll
            for (int n = 0; n < 2; ++n) { gv[bj][n] = *(const f32x4*)(g1 + col0 + bj * HALF + 4 * n); bv[bj][n] = *(const f32x4*)(b1 + col0 + bj * HALF + 4 * n); }
#pragma unroll
        for (int aim = 0; aim < 4; ++aim) { const int ai = aim >> 1;
            typedef unsigned u32x2 __attribute__((ext_vector_type(2))); u32x2 yr[4][2];
#pragma unroll
            for (int m = 2 * (aim & 1); m < 2 * (aim & 1) + 2; ++m)
#pragma unroll
                for (int bj = 0; bj < 2; ++bj) { const int row = row0 + ai * HALF + m * 16, col = col0 + bj * HALF;
                    yr[m][bj] = __builtin_nontemporal_load((const u32x2*)(Y8 + (size_t)row * DM + col)); }
#pragma unroll
            for (int m = 2 * (aim & 1); m < 2 * (aim & 1) + 2; ++m) { const int row = row0 + ai * HALF + m * 16;
                const f32x2 stv = *(const f32x2*)(stats1 + (size_t)row * 2); const float sm = stv.x, sq = stv.y;
                const float mu = sm * (1.0f / DM), var = sq * (1.0f / DM) - mu * mu, rstd = __builtin_amdgcn_rsqf(var + LN_EPS);
                float s = 0.f, q = 0.f;
#pragma unroll
                for (int bj = 0; bj < 2; ++bj) { const u32x2 yb = yr[m][bj];
                    f32x4 y0 = (f32x4){(float)(int)(signed char)(yb.x), (float)(int)(signed char)(yb.x >> 8), (float)(int)(signed char)(yb.x >> 16), (float)((int)yb.x >> 24)} * YQ_INV;
                    f32x4 y1 = (f32x4){(float)(int)(signed char)(yb.y), (float)(int)(signed char)(yb.y >> 8), (float)(int)(signed char)(yb.y >> 16), (float)((int)yb.y >> 24)} * YQ_INV;
                    const f32x4 h0 = (y0 - mu) * rstd * gv[bj][0] + bv[bj][0], h1 = (y1 - mu) * rstd * gv[bj][1] + bv[bj][1];
                    const f32x4 v0 = acc[ai][bj][m][0] * WDN_INV_SCALE + h0 * ALPHA, v1 = acc[ai][bj][m][1] * WDN_INV_SCALE + h1 * ALPHA;
                    s += hsum4(v0) + hsum4(v1); q += hsq4(v0) + hsq4(v1);
                    acc[ai][bj][m][0] = v0; acc[ai][bj][m][1] = v1; }
                s += __shfl_xor(s, 16); s += __shfl_xor(s, 32); q += __shfl_xor(q, 16); q += __shfl_xor(q, 32);
                if (fq == 0) { atomic_addf(stats2 + (size_t)row * 2, s); atomic_addf(stats2 + (size_t)row * 2 + 1, q); } }
        }
        }
        asm volatile("s_waitcnt vmcnt(0)" ::: "memory");
        unsigned* pc = cnt + 64 * u.pm;
        if (fr == 0 && fq == 0) (void)__hip_atomic_fetch_add(pc, 1u, __ATOMIC_RELAXED, __HIP_MEMORY_SCOPE_AGENT);
        { unsigned spins = 0;
          while ((unsigned)__builtin_amdgcn_readfirstlane(__hip_atomic_load(pc, __ATOMIC_RELAXED, __HIP_MEMORY_SCOPE_AGENT)) < 64u) { __builtin_amdgcn_s_sleep(2); if (++spins > (1u << 20)) break; } }
        f32x4 gg[2][2], bb[2][2];
#pragma unroll
        for (int bj = 0; bj < 2; ++bj)
#pragma unroll
            for (int n = 0; n < 2; ++n) { gg[bj][n] = *(const f32x4*)(g2 + col0 + bj * HALF + 4 * n); bb[bj][n] = *(const f32x4*)(b2 + col0 + bj * HALF + 4 * n); }
#pragma unroll
        for (int ai = 0; ai < 2; ++ai)
#pragma unroll
            for (int m = 0; m < 4; ++m) { const int row = row0 + ai * HALF + m * 16;
                const float sm = __hip_atomic_load(stats2 + (size_t)row * 2, __ATOMIC_RELAXED, __HIP_MEMORY_SCOPE_AGENT), sq = __hip_atomic_load(stats2 + (size_t)row * 2 + 1, __ATOMIC_RELAXED, __HIP_MEMORY_SCOPE_AGENT);
                const float mu = sm * (1.0f / DM), var = sq * (1.0f / DM) - mu * mu, rstd = __builtin_amdgcn_rsqf(var + LN_EPS);
#pragma unroll
                for (int bj = 0; bj < 2; ++bj) { float* op = out + (size_t)row * DM + col0 + bj * HALF;
                    *(f32x4*)op = (acc[ai][bj][m][0] - mu) * rstd * gg[bj][0] + bb[bj][0];
                    *(f32x4*)(op + 4) = (acc[ai][bj][m][1] - mu) * rstd * gg[bj][1] + bb[bj][1]; } }
    }
};
struct PanelOrder {
    int G, vcu, ntile;
    __host__ __device__ void init(int M, int N, int G_, int c) { G = G_; vcu = (G_ % 8 == 0) ? (c % 8) * (G_ / 8) + c / 8 : c; ntile = (M / BM) * (N / BM); }
    __host__ __device__ bool next(int i, Unit& u) const { const int idx = i * G + vcu; if (idx >= ntile) return false; u.pm = idx >> 3; u.pn = idx & 7; return true; }
    __device__ __forceinline__ void a_ready(const Unit&) const {}
    __device__ __forceinline__ void done(const Unit&) const {}
};

template <class Epi, class Sched, bool ALIGN_EPI = false, bool SP2 = false, int FP8M = 0, int F8T1 = 0>
__device__ __forceinline__ void gemm_phase(PG8_LAS unsigned char* lds, const Gemm g, const Sched& S, const Epi& E) {
    int tid_ = threadIdx.x; asm volatile("" : "+v"(tid_));
    const int tid = tid_, wid = __builtin_amdgcn_readfirstlane(tid >> 6), lane = tid & 63, wr = wid >> 2, wc = wid & 3, fr = lane & 15, fq = lane >> 4;
    const int K = g.K, nt = K / BK;
    unsigned voffA[2], voffB[2];
#pragma unroll
    for (int i = 0; i < 2; ++i) { int R, C; stage_rc(tid * 16 + i * 8192, R, C); const int Rb = Epi::PERM ? ((R & ~31) + perm32(R & 31)) : R;
        voffA[i] = (unsigned)(R * K + C) * 2u; voffB[i] = (unsigned)(Rb * K + C) * 2u; }
    const size_t kstep = (size_t)(BK * 2);
    const size_t hstep = (size_t)HALF * K * 2;
    const size_t tstep = 2 * hstep;
    const unsigned ldsw = (unsigned)wid * 1024u;
    const int aoff = lds_byte(wr * 64 + fr, fq * 8), boff = lds_byte(wc * 32 + fr, fq * 8);
#define PG8_SA(b, h) (((b) * 2 + (h)) * HTB)
#define PG8_SB(b, h) ((4 + (b) * 2 + (h)) * HTB)
#define PG8_STAGE(bufoff, gbase, voff) do { _Pragma("unroll") for (int _i = 0; _i < 2; ++_i) \
        __builtin_amdgcn_global_load_lds((const unsigned*)((const char*)(gbase) + (voff)[_i]), (PG8_LAS unsigned*)(lds + (bufoff) + ldsw + _i * 8192), 16, 0, 0); } while (0)
#define PG8_LDA(dst, b, h) do { _Pragma("unroll") for (int m = 0; m < 4; ++m) _Pragma("unroll") for (int k = 0; k < 2; ++k) dst[m][k] = *(const PG8_LAS bf16x8*)(lds + PG8_SA(b, h) + aoff + m * 2048 + k * 1024); } while (0)
#define PG8_LDB(dst, b, h) do { _Pragma("unroll") for (int n = 0; n < 2; ++n) _Pragma("unroll") for (int k = 0; k < 2; ++k) dst[n][k] = *(const PG8_LAS bf16x8*)(lds + PG8_SB(b, h) + boff + n * 2048 + k * 1024); } while (0)
#define PG8_CAT(x0, x1) __builtin_shufflevector(__builtin_bit_cast(v4i_t, x0), __builtin_bit_cast(v4i_t, x1), 0, 1, 2, 3, 4, 5, 6, 7)
#define PG8_MMA_F8(ai, bj, At, Bt) do { __builtin_amdgcn_s_setprio(1); _Pragma("unroll") for (int m = 0; m < 4; ++m) _Pragma("unroll") for (int n = 0; n < 2; ++n) \
        asm volatile("v_mfma_scale_f32_16x16x128_f8f6f4 %0, %1, %2, %0, %3, %3 op_sel_hi:[0,0,0]" : "+v"(acc[ai][bj][m][n]) : "v"(PG8_CAT(Bt[n][0], Bt[n][1])), "v"(PG8_CAT(At[m][0], At[m][1])), "v"(scl8)); \
        __builtin_amdgcn_s_setprio(0); } while (0)
#define PG8_MMA_B16A(ai, bj, At, Bt) do { __builtin_amdgcn_s_setprio(1); _Pragma("unroll") for (int m = 0; m < 4; ++m) _Pragma("unroll") for (int n = 0; n < 2; ++n) _Pragma("unroll") for (int k = 0; k < 2; ++k) \
        asm volatile("v_mfma_f32_16x16x32_bf16 %0, %1, %2, %0" : "+v"(acc[ai][bj][m][n]) : "v"(Bt[n][k]), "v"(At[m][k]));   \
        __builtin_amdgcn_s_setprio(0); } while (0)
#define PG8_MMA_B16(ai, bj, At, Bt) do { __builtin_amdgcn_s_setprio(1); _Pragma("unroll") for (int m = 0; m < 4; ++m) _Pragma("unroll") for (int n = 0; n < 2; ++n) _Pragma("unroll") for (int k = 0; k < 2; ++k) \
        acc[ai][bj][m][n] = __builtin_amdgcn_mfma_f32_16x16x32_bf16(Bt[n][k], At[m][k], acc[ai][bj][m][n], 0, 0, 0); __builtin_amdgcn_s_setprio(0); } while (0)
#define PG8_MMA_I8(ai, bj, At, Bt) do { __builtin_amdgcn_s_setprio(1); _Pragma("unroll") for (int m = 0; m < 4; ++m) _Pragma("unroll") for (int n = 0; n < 2; ++n) _Pragma("unroll") for (int k = 0; k < 2; ++k) \
        acc[ai][bj][m][n] = __builtin_bit_cast(f32x4, __builtin_amdgcn_mfma_i32_16x16x64_i8(__builtin_bit_cast(v4i_t, Bt[n][k]), __builtin_bit_cast(v4i_t, At[m][k]), __builtin_bit_cast(v4i_t, acc[ai][bj][m][n]), 0, 0, 0)); \
        __builtin_amdgcn_s_setprio(0); } while (0)
#define PG8_MMA(ai, bj, At, Bt) PG8_MMA_B16(ai, bj, At, Bt)
#define PG8_WAIT_V(n) asm volatile("s_waitcnt vmcnt(" #n ")" ::: "memory")
#define PG8_WAIT_L(n) asm volatile("s_waitcnt lgkmcnt(" #n ")" ::: "memory")
#define PG8_BAR __builtin_amdgcn_s_barrier()
#define PG8_SCHED __builtin_amdgcn_sched_barrier(0)
#define PG8_ITER_SP2(MMA_) do { \
            PG8_LDB(B0, 0, 0); PG8_LDB(B1, 0, 1); PG8_SCHED; PG8_LDA(At, 0, 0); PG8_STAGE(PG8_SA(1, 1), a1 + hstep, voffA); \
            PG8_WAIT_V(8); PG8_WAIT_L(0); PG8_BAR; MMA_(0, 0, At, B0); MMA_(0, 1, At, B1); PG8_BAR; PG8_SCHED; \
            PG8_LDA(At, 0, 1); PG8_STAGE(PG8_SB(0, 0), b2, voffB); PG8_STAGE(PG8_SB(0, 1), b2 + hstep, voffB); PG8_STAGE(PG8_SA(0, 0), a2, voffA); \
            PG8_WAIT_V(8); PG8_WAIT_L(0); PG8_BAR; MMA_(1, 0, At, B0); MMA_(1, 1, At, B1); PG8_BAR; PG8_SCHED; \
            PG8_LDB(B0, 1, 0); PG8_LDB(B1, 1, 1); PG8_SCHED; PG8_LDA(At, 1, 0); PG8_STAGE(PG8_SA(0, 1), a2 + hstep, voffA); \
            PG8_WAIT_V(8); PG8_WAIT_L(0); PG8_BAR; MMA_(0, 0, At, B0); MMA_(0, 1, At, B1); PG8_BAR; PG8_SCHED; \
            PG8_LDA(At, 1, 1); PG8_STAGE(PG8_SB(1, 0), b3, voffB); PG8_STAGE(PG8_SB(1, 1), b3 + hstep, voffB); PG8_STAGE(PG8_SA(1, 0), a3, voffA); \
            PG8_WAIT_V(8); PG8_WAIT_L(0); PG8_BAR; MMA_(1, 0, At, B0); MMA_(1, 1, At, B1); PG8_BAR; PG8_SCHED; \
            } while (0)
    Unit cur, nxt; int ui = 0;
    if (!S.next(0, cur)) return;
    f32x4 acc[2][2][4][2];
#pragma unroll
    for (int a = 0; a < 2; ++a)
#pragma unroll
        for (int b = 0; b < 2; ++b)
#pragma unroll
            for (int m = 0; m < 4; ++m)
#pragma unroll
                for (int n = 0; n < 2; ++n) acc[a][b][m][n] = (f32x4){0.f, 0.f, 0.f, 0.f};
    bf16x8 At[4][2], B0[2][2], B1[2][2];
    int scl8 = 0x7f7f7f7f; asm volatile("" : "+v"(scl8));
    const char* cA = (const char*)g.A + (size_t)cur.pm * tstep; const char* cB = (const char*)g.Bt + (size_t)cur.pn * tstep;
    S.a_ready(cur);
    if constexpr (Epi::MID) E.pre(cur, lds + STAGE_BYTES, tid);
    if constexpr (SP2) {
        PG8_STAGE(PG8_SB(0, 0), cB, voffB); PG8_STAGE(PG8_SB(0, 1), cB + hstep, voffB); PG8_STAGE(PG8_SA(0, 0), cA, voffA); PG8_STAGE(PG8_SA(0, 1), cA + hstep, voffA);
        if (wr == 1) PG8_BAR;
        PG8_WAIT_V(2); PG8_BAR;
        PG8_STAGE(PG8_SB(1, 0), cB + kstep, voffB); PG8_STAGE(PG8_SA(1, 0), cA + kstep, voffA); PG8_STAGE(PG8_SB(1, 1), cB + hstep + kstep, voffB);
        PG8_WAIT_V(6); PG8_BAR;
    } else {
        PG8_STAGE(PG8_SB(0, 0), cB, voffB); PG8_STAGE(PG8_SA(0, 0), cA, voffA); PG8_STAGE(PG8_SB(0, 1), cB + hstep, voffB); PG8_STAGE(PG8_SA(0, 1), cA + hstep, voffA);
        if (wr == 1) PG8_BAR;
        PG8_WAIT_V(4); PG8_BAR;
        PG8_STAGE(PG8_SB(1, 0), cB + kstep, voffB); PG8_STAGE(PG8_SA(1, 0), cA + kstep, voffA); PG8_STAGE(PG8_SB(1, 1), cB + hstep + kstep, voffB);
        PG8_WAIT_V(6); PG8_BAR;
    }
    for (;;) {
        const bool has_next = S.next(ui + 1, nxt);
        const char* nA = has_next ? (const char*)g.A + (size_t)nxt.pm * tstep : cA; const char* nB = has_next ? (const char*)g.Bt + (size_t)nxt.pn * tstep : cB;
        constexpr int SPLIT = Epi::MID ? Epi::MID_T : (FP8M == 1 ? F8T1 : 0);
        if constexpr (SPLIT > 0 && SP2) {
            for (int t = 0; t < SPLIT; t += 2) {
                const char* a1 = cA + (size_t)(t + 1) * kstep; const char* a2 = cA + (size_t)(t + 2) * kstep; const char* b2 = cB + (size_t)(t + 2) * kstep;
                const char* a3 = a2 + kstep; const char* b3 = b2 + kstep;
                if constexpr (FP8M == 1) PG8_ITER_SP2(PG8_MMA_B16A); else if constexpr (FP8M == 2 || FP8M == 6) PG8_ITER_SP2(PG8_MMA_F8); else if constexpr (FP8M == 3) PG8_ITER_SP2(PG8_MMA_I8); else PG8_ITER_SP2(PG8_MMA_B16);
            }
            if constexpr (FP8M == 1) asm volatile("s_nop 15" ::: "memory");
            if constexpr (FP8M == 6) { asm volatile("s_nop 15\n\ts_nop 15" ::: "memory"); PG8_SCHED; }
            if constexpr (Epi::MID) E.mid(acc, lds + STAGE_BYTES, wr, fr);
        }
        for (int t = SPLIT; t < nt; t += 2) {
            const bool last = (t == nt - 2);
            const char* a1 = cA + (size_t)(t + 1) * kstep;
            const char* a2 = last ? nA : cA + (size_t)(t + 2) * kstep; const char* b2 = last ? nB : cB + (size_t)(t + 2) * kstep;
            const char* a3 = a2 + kstep; const char* b3 = b2 + kstep;
            if (last && has_next) S.a_ready(nxt);
            if constexpr (SP2) {
            if constexpr (FP8M == 1) PG8_ITER_SP2(PG8_MMA_F8);
            else if constexpr (FP8M == 2) PG8_ITER_SP2(PG8_MMA_F8);
            else if constexpr (FP8M == 3) PG8_ITER_SP2(PG8_MMA_I8);
            else PG8_ITER_SP2(PG8_MMA_B16);
            } else {
            PG8_LDB(B0, 0, 0); PG8_SCHED; PG8_LDA(At, 0, 0); PG8_STAGE(PG8_SA(1, 1), a1 + hstep, voffA);
            PG8_WAIT_L(8); PG8_BAR; PG8_WAIT_L(0); PG8_MMA(0, 0, At, B0); PG8_BAR; PG8_SCHED;
            PG8_LDB(B1, 0, 1); PG8_STAGE(PG8_SB(0, 0), b2, voffB);
            PG8_BAR; PG8_WAIT_L(0); PG8_MMA(0, 1, At, B1); PG8_BAR;
            PG8_LDA(At, 0, 1); PG8_STAGE(PG8_SA(0, 0), a2, voffA);
            PG8_BAR; PG8_WAIT_L(0); PG8_MMA(1, 0, At, B0); PG8_BAR; PG8_SCHED;
            PG8_STAGE(PG8_SB(0, 1), b2 + hstep, voffB);
            PG8_WAIT_V(6); PG8_BAR; PG8_MMA(1, 1, At, B1); PG8_BAR;
            PG8_LDB(B0, 1, 0); PG8_SCHED; PG8_LDA(At, 1, 0); PG8_STAGE(PG8_SA(0, 1), a2 + hstep, voffA);
            PG8_WAIT_L(8); PG8_BAR; PG8_WAIT_L(0); PG8_MMA(0, 0, At, B0); PG8_BAR; PG8_SCHED;
            PG8_LDB(B1, 1, 1); PG8_STAGE(PG8_SB(1, 0), b3, voffB);
            PG8_BAR; PG8_WAIT_L(0); PG8_MMA(0, 1, At, B1); PG8_BAR;
            PG8_LDA(At, 1, 1); PG8_STAGE(PG8_SA(1, 0), a3, voffA);
            PG8_BAR; PG8_WAIT_L(0); PG8_MMA(1, 0, At, B0); PG8_BAR; PG8_SCHED;
            PG8_STAGE(PG8_SB(1, 1), b3 + hstep, voffB);
            PG8_WAIT_V(6); PG8_BAR; PG8_MMA(1, 1, At, B1); PG8_BAR;
            }
        }
        if constexpr (ALIGN_EPI) { if (wr == 0) PG8_BAR; }
        if constexpr (FP8M == 1 || FP8M == 2) { asm volatile("s_nop 15\n\ts_nop 15" ::: "memory"); PG8_SCHED; }
        if constexpr (!Epi::AFTER_DRAIN) { E(acc, cur, wr, wc, fr, fq); S.done(cur); }
        if (!has_next) break;
#pragma unroll
        for (int a = 0; a < 2; ++a)
#pragma unroll
            for (int b = 0; b < 2; ++b)
#pragma unroll
                for (int m = 0; m < 4; ++m)
#pragma unroll
                    for (int n = 0; n < 2; ++n) acc[a][b][m][n] = (f32x4){0.f, 0.f, 0.f, 0.f};
        cur = nxt; cA = nA; cB = nB; ++ui;
        if constexpr (Epi::MID) E.pre(cur, lds + STAGE_BYTES, tid);
        if constexpr (ALIGN_EPI) { if (wr == 1) PG8_BAR; }
    }
    PG8_WAIT_V(0);
    if constexpr (!ALIGN_EPI) { if (wr == 0) PG8_BAR; }
    PG8_BAR;
    if constexpr (Epi::AFTER_DRAIN) { E.fused(acc, cur, wr, wc, fr, fq, lds, wid, lane); S.done(cur); }
#undef PG8_SA
#undef PG8_SB
#undef PG8_STAGE
#undef PG8_LDA
#undef PG8_LDB
#undef PG8_MMA
#undef PG8_MMA_F8
#undef PG8_MMA_I8
#undef PG8_MMA_B16
#undef PG8_MMA_B16A
#undef PG8_ITER_SP2
#undef PG8_CAT
#undef PG8_WAIT_V
#undef PG8_WAIT_L
#undef PG8_BAR
#undef PG8_SCHED
}
}

#ifndef PG8_SP2
#define PG8_SP2 true
#endif
#ifndef PG8_ALIGN
#define PG8_ALIGN true
#endif
namespace att {
typedef unsigned short bf16;
typedef short bf16x8 __attribute__((ext_vector_type(8)));
typedef short s16x4 __attribute__((ext_vector_type(4)));
typedef float f32x16 __attribute__((ext_vector_type(16)));
typedef float f32x4 __attribute__((ext_vector_type(4)));
typedef unsigned u32x4 __attribute__((ext_vector_type(4)));
constexpr int D = 128, NW = 8, QBLK = 32, KVBLK = 64, QB = NW * QBLK, LDQ = 1024, LDO = 2048;
constexpr int SHM_V = KVBLK * D * 2, SHM_K = KVBLK * D * 2;
constexpr int NVB = 3;
constexpr int LDS_BYTES = NVB * SHM_V + 2 * SHM_K + NW * 64 * 4;
constexpr int KM_OFF = LDS_BYTES + NW * QBLK * D * 2, KM_PITCH = 272;
constexpr float SCALE = 0.08838834764831845f, THR = 8.f;
constexpr size_t KPART_STRIDE = (size_t)64 * 1024;

#define KSWZ(row, colB) ((((colB) >> 7) * 8192) + (row) * 128 + (((((colB) >> 4) & 7) ^ (((row) >> 1) & 7)) << 4))
#define SBAR() __builtin_amdgcn_sched_barrier(0)
__device__ __forceinline__ int v_st(int k, int c) { const int kk = (k & ~0xC) | ((k & 4) << 1) | ((k & 8) >> 1); return ((kk >> 3) * 4 + (c >> 5)) * 512 + ((kk & 7) * 32 + (c & 31)) * 2; }
__device__ __forceinline__ int v_rd_base(int lane) { return ((lane & 3) << 3) | (((lane >> 2) & 3) << 6) | (((lane >> 4) & 1) << 5) | (((lane >> 5) & 1) << 8); }
constexpr int v_rd_off(int d0, int ks, int half) { return d0 * 512 + ks * 4096 + half * 2048; }
__device__ __forceinline__ int crow(int r, int hi) { return (r & 3) + 8 * (r >> 2) + 4 * hi; }
__device__ __forceinline__ unsigned cvtpk(float lo, float hi) { unsigned r; asm volatile("v_cvt_pk_bf16_f32 %0, %1, %2" : "=v"(r) : "v"(lo), "v"(hi)); return r; }
__device__ __forceinline__ bf16x8 pack8(f32x4 a, f32x4 b) { u32x4 w = {cvtpk(a[0], a[1]), cvtpk(a[2], a[3]), cvtpk(b[0], b[1]), cvtpk(b[2], b[3])}; return *reinterpret_cast<bf16x8*>(&w); }
__device__ __forceinline__ bf16x8 load8(const bf16* p) { return *reinterpret_cast<const bf16x8*>(p); }
__device__ __forceinline__ void mask_tile(f32x16& p0, f32x16& p1, int dq) {
#define MT1(P, r, c_) do { float t_ = P[r]; asm volatile("v_cmp_le_i32 vcc, %1, %2\n\tv_cndmask_b32 %0, %3, %0, vcc" : "+v"(t_) : "n"(c_), "v"(dq), "v"(NEG) : "vcc"); P[r] = t_; } while (0)
    float NEG = -__builtin_inff(); asm volatile("" : "+v"(NEG));
    MT1(p0, 0, 0); MT1(p0, 1, 1); MT1(p0, 2, 2); MT1(p0, 3, 3); MT1(p0, 4, 8); MT1(p0, 5, 9); MT1(p0, 6, 10); MT1(p0, 7, 11);
    MT1(p0, 8, 16); MT1(p0, 9, 17); MT1(p0, 10, 18); MT1(p0, 11, 19); MT1(p0, 12, 24); MT1(p0, 13, 25); MT1(p0, 14, 26); MT1(p0, 15, 27);
    MT1(p1, 0, 32); MT1(p1, 1, 33); MT1(p1, 2, 34); MT1(p1, 3, 35); MT1(p1, 4, 40); MT1(p1, 5, 41); MT1(p1, 6, 42); MT1(p1, 7, 43);
    MT1(p1, 8, 48); MT1(p1, 9, 49); MT1(p1, 10, 50); MT1(p1, 11, 51); MT1(p1, 12, 56); MT1(p1, 13, 57); MT1(p1, 14, 58); MT1(p1, 15, 59);
#undef MT1
}
__device__ __forceinline__ void mask_all(f32x16& p0, f32x16& p1, bool keep) {
    const float NEG = -__builtin_inff();
#pragma unroll
    for (int r = 0; r < 16; ++r) { p0[r] = keep ? p0[r] : NEG; p1[r] = keep ? p1[r] : NEG; }
}
__device__ __forceinline__ void partialSM(f32x16& p0, f32x16& p1, float& m_reg, float& mn, float& alpha) {
    float pmax = p0[0];
#pragma unroll
    for (int r = 1; r < 16; ++r) pmax = fmaxf(pmax, p0[r]);
#pragma unroll
    for (int r = 0; r < 16; ++r) pmax = fmaxf(pmax, p1[r]);
    { auto rr = __builtin_amdgcn_permlane32_swap(__float_as_uint(pmax), __float_as_uint(pmax), false, false);
      pmax = fmaxf(__uint_as_float(rr[0]), __uint_as_float(rr[1])); }
    constexpr float C2 = 1.4426950408889634f * SCALE;
    if (__builtin_expect(__all((pmax - m_reg) * SCALE <= THR), 1)) { mn = m_reg; alpha = 1.f; }
    else { mn = fmaxf(m_reg, pmax); alpha = __builtin_amdgcn_exp2f((m_reg - mn) * C2); m_reg = mn; }
    const float mnL = -mn * C2;
#pragma unroll
    for (int r = 0; r < 16; ++r) p0[r] = fmaf(p0[r], C2, mnL);
#pragma unroll
    for (int r = 0; r < 16; ++r) p1[r] = fmaf(p1[r], C2, mnL);
#pragma unroll
    for (int r = 0; r < 16; ++r) p0[r] = __builtin_amdgcn_exp2f(p0[r]);
}
__device__ __forceinline__ void finishSM(f32x16& p0, f32x16& p1, float alpha, float& l_reg, bf16x8& pa0, bf16x8& pa1, bf16x8& pa2, bf16x8& pa3) {
#pragma unroll
    for (int r = 0; r < 16; ++r) p1[r] = __builtin_amdgcn_exp2f(p1[r]);
    float ps = 0;
#pragma unroll
    for (int r = 0; r < 16; ++r) ps += p0[r];
#pragma unroll
    for (int r = 0; r < 16; ++r) ps += p1[r];
    { auto rr = __builtin_amdgcn_permlane32_swap(__float_as_uint(ps), __float_as_uint(ps), false, false);
      ps = __uint_as_float(rr[0]) + __uint_as_float(rr[1]); }
    l_reg = l_reg * alpha + ps;
#define PK4(P, B_, OUT) do { unsigned a0 = cvtpk(P[B_+0], P[B_+1]), a1 = cvtpk(P[B_+2], P[B_+3]);                          \
        unsigned b0 = cvtpk(P[B_+4], P[B_+5]), b1 = cvtpk(P[B_+6], P[B_+7]);                                             \
        auto r0 = __builtin_amdgcn_permlane32_swap(a0, b0, false, false); auto r1 = __builtin_amdgcn_permlane32_swap(a1, b1, false, false); \
        u32x4 w = {r0[0], r1[0], r0[1], r1[1]}; OUT = *reinterpret_cast<bf16x8*>(&w); } while (0)
    PK4(p0, 0, pa0); PK4(p0, 8, pa1); PK4(p1, 0, pa2); PK4(p1, 8, pa3);
#undef PK4
}
template <int KB>
__device__ __forceinline__ void qkt(f32x16& p0, f32x16& p1, const char* K_lds, int r32, int hi, const bf16x8* qr) {
    p0 = f32x16{}; p1 = f32x16{};
    int kb[4];
#pragma unroll
    for (int dd = 0; dd < 4; ++dd) kb[dd] = (int)(uintptr_t)(K_lds + KSWZ(r32, (dd * 16 + hi * 8) * 2));
#define KRD(dst, d0_) do { asm volatile("ds_read_b128 %0, %1 offset:%2" : "=&v"(dst[0]) : "v"(kb[(d0_) & 3]), "i"(KB * SHM_K + ((d0_) >> 2) * 8192) : "memory");          \
                           asm volatile("ds_read_b128 %0, %1 offset:%2" : "=&v"(dst[1]) : "v"(kb[(d0_) & 3]), "i"(KB * SHM_K + ((d0_) >> 2) * 8192 + 32 * 128) : "memory"); } while (0)
#define KMM(f, d0_, n_) do { asm volatile("s_waitcnt lgkmcnt(" #n_ ")" ::: "memory"); SBAR();                                                              \
        p0 = __builtin_amdgcn_mfma_f32_32x32x16_bf16(f[0], qr[d0_], p0, 0, 0, 0); p1 = __builtin_amdgcn_mfma_f32_32x32x16_bf16(f[1], qr[d0_], p1, 0, 0, 0); SBAR(); } while (0)
    bf16x8 fa[2], fb[2];
    KRD(fa, 0); KRD(fb, 1);
    KMM(fa, 0, 2); KRD(fa, 2);
    KMM(fb, 1, 2); KRD(fb, 3);
    KMM(fa, 2, 2); KRD(fa, 4);
    KMM(fb, 3, 2); KRD(fb, 5);
    KMM(fa, 4, 2); KRD(fa, 6);
    KMM(fb, 5, 2); KRD(fb, 7);
    KMM(fa, 6, 2);
    KMM(fb, 7, 0);
#undef KRD
#undef KMM
}
template <int KB>
__device__ __forceinline__ void qkt_c(f32x16& p0, f32x16& p1, const char* K_lds, int r32, int hi, const bf16x8* qr) {
    p0 = f32x16{}; p1 = f32x16{};
    const char* kb[4];
#pragma unroll
    for (int dd = 0; dd < 4; ++dd) kb[dd] = K_lds + KB * SHM_K + KSWZ(r32, (dd * 16 + hi * 8) * 2);
#pragma unroll
    for (int d0 = 0; d0 < 8; ++d0) { const char* a = kb[d0 & 3] + (d0 >> 2) * 8192;
        bf16x8 b0 = *reinterpret_cast<const bf16x8*>(a);
        bf16x8 b1 = *reinterpret_cast<const bf16x8*>(a + 32 * 128);
        p0 = __builtin_amdgcn_mfma_f32_32x32x16_bf16(b0, qr[d0], p0, 0, 0, 0);
        p1 = __builtin_amdgcn_mfma_f32_32x32x16_bf16(b1, qr[d0], p1, 0, 0, 0); }
}
__device__ __forceinline__ void pv_tile(f32x16* o, int vb0, bf16x8 pa0, bf16x8 pa1, bf16x8 pa2, bf16x8 pa3) {
#define TRRD(dst, off) asm volatile("ds_read_b64_tr_b16 %0, %1 offset:%2" : "=&v"(dst) : "v"(vb0), "i"(off) : "memory")
#define PV_R(d0, ks, l, h) do { TRRD(l, v_rd_off(d0, 0, 0) + (ks) * 4096); TRRD(h, v_rd_off(d0, 0, 0) + (ks) * 4096 + 2048); } while (0)
#define PV_M(d0, pa, l, h, n_) do { asm volatile("s_waitcnt lgkmcnt(" #n_ ")" ::: "memory"); SBAR();                                \
        o[d0] = __builtin_amdgcn_mfma_f32_32x32x16_bf16(pa, (bf16x8){l[0], l[1], l[2], l[3], h[0], h[1], h[2], h[3]}, o[d0], 0, 0, 0); SBAR(); } while (0)
    s16x4 l0, l1, l2, l3, h0, h1, h2, h3;
    PV_R(0, 0, l0, h0); PV_R(0, 1, l1, h1); PV_R(0, 2, l2, h2); PV_R(0, 3, l3, h3);
#define PV_G(d0) do { PV_M(d0, pa0, l0, h0, 6); PV_R(d0 + 1, 0, l0, h0); PV_M(d0, pa1, l1, h1, 6); PV_R(d0 + 1, 1, l1, h1);            \
                      PV_M(d0, pa2, l2, h2, 6); PV_R(d0 + 1, 2, l2, h2); PV_M(d0, pa3, l3, h3, 6); PV_R(d0 + 1, 3, l3, h3); } while (0)
    PV_G(0); PV_G(1); PV_G(2);
    PV_M(3, pa0, l0, h0, 6); PV_M(3, pa1, l1, h1, 4); PV_M(3, pa2, l2, h2, 2); PV_M(3, pa3, l3, h3, 0);
#undef PV_G
#undef PV_M
#undef PV_R
#undef TRRD
}

template <int KB>
__device__ __forceinline__ void qk_fin(f32x16& x0, f32x16& x1, f32x16& y0, f32x16& y1, float alY, float& l_reg, bf16x8& pa0, bf16x8& pa1, bf16x8& pa2, bf16x8& pa3,
                                       const char* K_lds, int r32, int hi, const bf16x8* qr) {
    x0 = f32x16{}; x1 = f32x16{};
    int kb[4];
#pragma unroll
    for (int dd = 0; dd < 4; ++dd) kb[dd] = (int)(uintptr_t)(K_lds + KSWZ(r32, (dd * 16 + hi * 8) * 2));
#define KRD(dst, d0_) do { asm volatile("ds_read_b128 %0, %1 offset:%2" : "=&v"(dst[0]) : "v"(kb[(d0_) & 3]), "i"(KB * SHM_K + ((d0_) >> 2) * 8192) : "memory");          \
                           asm volatile("ds_read_b128 %0, %1 offset:%2" : "=&v"(dst[1]) : "v"(kb[(d0_) & 3]), "i"(KB * SHM_K + ((d0_) >> 2) * 8192 + 32 * 128) : "memory"); } while (0)
#define KMM(f, d0_, n_) do { asm volatile("s_waitcnt lgkmcnt(" #n_ ")" ::: "memory"); SBAR();                                                              \
        x0 = __builtin_amdgcn_mfma_f32_32x32x16_bf16(f[0], qr[d0_], x0, 0, 0, 0); x1 = __builtin_amdgcn_mfma_f32_32x32x16_bf16(f[1], qr[d0_], x1, 0, 0, 0); SBAR(); } while (0)
#define EXPY(i) do { y1[2 * (i)] = __builtin_amdgcn_exp2f(y1[2 * (i)]); y1[2 * (i) + 1] = __builtin_amdgcn_exp2f(y1[2 * (i) + 1]); } while (0)
#define ADDY(Y, i) do { ps += Y[2 * (i)]; ps += Y[2 * (i) + 1]; } while (0)
#define CVA(P, B_) do { c0 = cvtpk(P[B_ + 0], P[B_ + 1]); c1 = cvtpk(P[B_ + 2], P[B_ + 3]); } while (0)
#define CVB(P, B_, OUT) do { const unsigned b0_ = cvtpk(P[B_ + 4], P[B_ + 5]), b1_ = cvtpk(P[B_ + 6], P[B_ + 7]);                                          \
        auto r0_ = __builtin_amdgcn_permlane32_swap(c0, b0_, false, false); auto r1_ = __builtin_amdgcn_permlane32_swap(c1, b1_, false, false);               \
        u32x4 w_ = {r0_[0], r1_[0], r0_[1], r1_[1]}; OUT = *reinterpret_cast<bf16x8*>(&w_); } while (0)
    bf16x8 fa[2], fb[2]; float ps = 0.f; unsigned c0, c1;
    KRD(fa, 0); KRD(fb, 1);
    KMM(fa, 0, 2); KRD(fa, 2); EXPY(0); ADDY(y0, 0); CVA(y0, 0); SBAR();
    KMM(fb, 1, 2); KRD(fb, 3); EXPY(1); ADDY(y0, 1); ADDY(y1, 0); CVB(y0, 0, pa0); SBAR();
    KMM(fa, 2, 2); KRD(fa, 4); EXPY(2); ADDY(y0, 2); ADDY(y1, 1); CVA(y0, 8); SBAR();
    KMM(fb, 3, 2); KRD(fb, 5); EXPY(3); ADDY(y0, 3); ADDY(y1, 2); CVB(y0, 8, pa1); SBAR();
    KMM(fa, 4, 2); KRD(fa, 6); EXPY(4); ADDY(y0, 4); ADDY(y1, 3); CVA(y1, 0); SBAR();
    KMM(fb, 5, 2); KRD(fb, 7); EXPY(5); ADDY(y0, 5); ADDY(y1, 4); CVB(y1, 0, pa2); SBAR();
    KMM(fa, 6, 2);             EXPY(6); ADDY(y0, 6); ADDY(y1, 5); CVA(y1, 8); SBAR();
    KMM(fb, 7, 0);             EXPY(7); ADDY(y0, 7); ADDY(y1, 6); SBAR();
    ADDY(y1, 7); CVB(y1, 8, pa3);
    { auto rr = __builtin_amdgcn_permlane32_swap(__float_as_uint(ps), __float_as_uint(ps), false, false); ps = __uint_as_float(rr[0]) + __uint_as_float(rr[1]); }
    l_reg = l_reg * alY + ps;
#undef KRD
#undef KMM
#undef EXPY
#undef ADDY
#undef CVA
#undef CVB
}
__device__ __forceinline__ void pv_par(f32x16* o, int vb0, bf16x8 pa0, bf16x8 pa1, bf16x8 pa2, bf16x8 pa3, f32x16& x0, f32x16& x1, float& m_reg, float& alpha, bool keep) {
#define TRRD(dst, off) asm volatile("ds_read_b64_tr_b16 %0, %1 offset:%2" : "=&v"(dst) : "v"(vb0), "i"(off) : "memory")
#define PV_R(d0, ks, l, h) do { TRRD(l, v_rd_off(d0, 0, 0) + (ks) * 4096); TRRD(h, v_rd_off(d0, 0, 0) + (ks) * 4096 + 2048); } while (0)
#define PV_M(d0, pa, l, h, n_) do { asm volatile("s_waitcnt lgkmcnt(" #n_ ")" ::: "memory"); SBAR();                                \
        o[d0] = __builtin_amdgcn_mfma_f32_32x32x16_bf16(pa, (bf16x8){l[0], l[1], l[2], l[3], h[0], h[1], h[2], h[3]}, o[d0], 0, 0, 0); SBAR(); } while (0)
#define MX8(t, X, b) do { t = fmaxf(fmaxf(X[b], X[b + 1]), X[b + 2]); t = fmaxf(fmaxf(t, X[b + 3]), X[b + 4]); t = fmaxf(fmaxf(t, X[b + 5]), X[b + 6]); t = fmaxf(t, X[b + 7]); } while (0)
#define FM4(j) do { x0[2 * (j)] = fmaf(x0[2 * (j)], C2, mnL); x0[2 * (j) + 1] = fmaf(x0[2 * (j) + 1], C2, mnL); x1[2 * (j)] = fmaf(x1[2 * (j)], C2, mnL); x1[2 * (j) + 1] = fmaf(x1[2 * (j) + 1], C2, mnL); } while (0)
#define EX0(e) x0[e] = __builtin_amdgcn_exp2f(x0[e])
    constexpr float C2 = 1.4426950408889634f * SCALE;
    s16x4 l0, l1, l2, l3, h0, h1, h2, h3; float t0, t1, t2, t3, pmax, mnL;
    PV_R(0, 0, l0, h0); PV_R(0, 1, l1, h1); PV_R(0, 2, l2, h2); PV_R(0, 3, l3, h3);
    PV_M(0, pa0, l0, h0, 6); PV_R(1, 0, l0, h0); MX8(t0, x0, 0); SBAR();
    PV_M(0, pa1, l1, h1, 6); PV_R(1, 1, l1, h1); MX8(t1, x0, 8); SBAR();
    PV_M(0, pa2, l2, h2, 6); PV_R(1, 2, l2, h2); MX8(t2, x1, 0); SBAR();
    PV_M(0, pa3, l3, h3, 6); PV_R(1, 3, l3, h3); MX8(t3, x1, 8); SBAR();
    PV_M(1, pa0, l0, h0, 6); PV_R(2, 0, l0, h0);
    { pmax = fmaxf(fmaxf(t0, t1), fmaxf(t2, t3)); auto rr = __builtin_amdgcn_permlane32_swap(__float_as_uint(pmax), __float_as_uint(pmax), false, false); pmax = fmaxf(__uint_as_float(rr[0]), __uint_as_float(rr[1])); pmax = keep ? pmax : -__builtin_inff(); } SBAR();
    PV_M(1, pa1, l1, h1, 6); PV_R(2, 1, l1, h1);
    { const bool ok = __all((pmax - m_reg) * SCALE <= THR) != 0;
      const float mn = ok ? m_reg : fmaxf(m_reg, pmax); alpha = __builtin_amdgcn_exp2f((m_reg - mn) * C2); m_reg = mn; mnL = keep ? -mn * C2 : -__builtin_inff(); } SBAR();
    PV_M(1, pa2, l2, h2, 6); PV_R(2, 2, l2, h2); FM4(0); SBAR();
    PV_M(1, pa3, l3, h3, 6); PV_R(2, 3, l3, h3); FM4(1); EX0(0); SBAR();
    PV_M(2, pa0, l0, h0, 6); PV_R(3, 0, l0, h0); FM4(2); EX0(1); SBAR();
    PV_M(2, pa1, l1, h1, 6); PV_R(3, 1, l1, h1); FM4(3); EX0(2); SBAR();
    PV_M(2, pa2, l2, h2, 6); PV_R(3, 2, l2, h2); FM4(4); EX0(3); SBAR();
    PV_M(2, pa3, l3, h3, 6); PV_R(3, 3, l3, h3); FM4(5); EX0(4); SBAR();
    PV_M(3, pa0, l0, h0, 6); FM4(6); EX0(5); SBAR();
    PV_M(3, pa1, l1, h1, 4); FM4(7); EX0(6); SBAR();
    PV_M(3, pa2, l2, h2, 2); EX0(7); EX0(8); EX0(9); SBAR();
    PV_M(3, pa3, l3, h3, 0); EX0(10); EX0(11); EX0(12); SBAR();
    EX0(13); EX0(14); EX0(15);
#undef TRRD
#undef PV_R
#undef PV_M
#undef MX8
#undef FM4
#undef EX0
}

struct BlockRef { int b, h, qb; };
struct Bases { const bf16* proj; bf16* mixed; float* ssq; const float* kpart; };
__device__ __forceinline__ const bf16* refQ(const Bases& B, const BlockRef& r) { return B.proj + ((size_t)(r.b * SEQ + r.qb * QB) * LDQ + r.h * D); }
__device__ __forceinline__ const bf16* refK(const Bases& B, const BlockRef& r) { return B.proj + (size_t)M_TOK * LDQ + ((size_t)(r.b * SEQ) * LDQ + r.h * D); }
__device__ __forceinline__ const bf16* refV(const Bases& B, const BlockRef& r) { return B.proj + (size_t)2 * M_TOK * LDQ + ((size_t)(r.b * SEQ) * LDQ + r.h * D); }
struct Seam { bf16x8 qr[8]; bf16x8 st_v0, st_v1, st_k0, st_k1; };

__device__ __forceinline__ void km_load(const float* kpart, int b, int h, int tid, f32x4& x, f32x4& y) {
    const int j = (tid >> 5) & 7, c = (tid & 31) * 4;
    const float* p = kpart + ((size_t)(b * 8 + j) * 1024 + h * D + c);
    x = *(const f32x4*)p; y = *(const f32x4*)(p + KPART_STRIDE);
}
__device__ __forceinline__ void km_write(char* lds, int tid, f32x4 x, f32x4 y) {
    const int j = (tid >> 5) & 7, c = (tid & 31) * 4; const f32x4 a = x + y;
    const unsigned h0 = cvtpk(a[0], a[1]), h1 = cvtpk(a[2], a[3]);
    const unsigned l0 = cvtpk(a[0] - __uint_as_float(h0 << 16), a[1] - __uint_as_float(h0 & 0xffff0000u)), l1 = cvtpk(a[2] - __uint_as_float(h1 << 16), a[3] - __uint_as_float(h1 & 0xffff0000u));
    typedef unsigned u32x2 __attribute__((ext_vector_type(2)));
    if (tid < 256) { *(u32x2*)(lds + KM_OFF + j * KM_PITCH + c * 2) = (u32x2){h0, h1}; *(u32x2*)(lds + KM_OFF + (8 + j) * KM_PITCH + c * 2) = (u32x2){l0, l1}; }
}
__device__ __forceinline__ unsigned moba_select(const bf16x8* qr, const char* lds, int own, int r32, int hi) {
    if (own == 0) return 0u;
    f32x16 g = f32x16{};
    const bool act = r32 < 16;
    const char* kmf = lds + KM_OFF + (r32 & 15) * KM_PITCH + hi * 16;
#pragma unroll
    for (int d0 = 0; d0 < 8; ++d0) {
        bf16x8 f = *(const bf16x8*)(kmf + d0 * 32);
        if (!act) f = (bf16x8){0, 0, 0, 0, 0, 0, 0, 0};
        g = __builtin_amdgcn_mfma_f32_32x32x16_bf16(f, qr[d0], g, 0, 0, 0);
    }
    float G[8];
#pragma unroll
    for (int i = 0; i < 4; ++i) { const float v = g[i] + g[4 + i];
        auto rr = __builtin_amdgcn_permlane32_swap(__float_as_uint(v), __float_as_uint(v), false, false);
        G[i] = __uint_as_float(rr[0]); G[4 + i] = __uint_as_float(rr[1]); }
    unsigned sel = 0u;
#pragma unroll
    for (int a = 0; a < 8; ++a) { int cnt = 0;
#pragma unroll
        for (int b = 0; b < 8; ++b) { if (b == a) continue;
            const bool beats = (b < a) ? (G[b] >= G[a]) : (G[b] > G[a]);
            cnt += (b < own && beats) ? 1 : 0; }
        sel |= (a < own && cnt < 3) ? (1u << a) : 0u; }
    return sel;
}

#define ROW(p, k0, rr) ((p) + (size_t)((k0) + (rr)) * LDQ + sc)
#define VMW() asm volatile("s_waitcnt vmcnt(0)" ::: "memory")
#define VMWN(n) asm volatile("s_waitcnt vmcnt(%0)" :: "i"(n) : "memory")
#define SLOAD_H(Kp, Vp, k0) do { S.st_v0 = load8(ROW(Vp, k0, sr)); S.st_v1 = load8(ROW(Vp, k0, 32 + sr));              \
                         S.st_k0 = load8(ROW(Kp, k0, sr)); S.st_k1 = load8(ROW(Kp, k0, 32 + sr)); } while (0)
#define SWRITE_HK(bf) do { *(bf16x8*)(K_lds + (bf) * SHM_K + kws) = S.st_k0; *(bf16x8*)(K_lds + (bf) * SHM_K + kws + 32 * 128) = S.st_k1; } while (0)
#define SWRITE_HV(bf) do { *(bf16x8*)(V_lds + (bf) * SHM_V + vst0) = S.st_v0; *(bf16x8*)(V_lds + (bf) * SHM_V + vst1) = S.st_v1; } while (0)
#define SWRITE_H(bf) do { SWRITE_HV(bf); SWRITE_HK(bf); } while (0)
__device__ __forceinline__ void moba_prime(const Bases& B, const BlockRef& cur, char* lds, Seam& S) {
    int tid_ = threadIdx.x; asm volatile("" : "+v"(tid_));
    const int tid = tid_, wid = __builtin_amdgcn_readfirstlane(tid >> 6), lane = tid & 63, r32 = lane & 31, hi = lane >> 5;
    const int sr = tid >> 4, sc = (tid & 15) * 8, kws = KSWZ(sr, sc * 2); char* K_lds = lds + NVB * SHM_V;
#pragma unroll
    for (int d0 = 0; d0 < 8; ++d0) S.qr[d0] = load8(refQ(B, cur) + (size_t)(wid * QBLK + r32) * LDQ + d0 * 16 + hi * 8);
    f32x4 kx, ky; km_load(B.kpart, cur.b, cur.h, tid, kx, ky);
    { const bf16* Kp = refK(B, cur); const bf16* Vp = refV(B, cur); SLOAD_H(Kp, Vp, 0); } VMW(); SWRITE_HK(0); km_write(lds, tid, kx, ky);
    __syncthreads();
}
template <bool ORDA> __device__ __forceinline__ void moba_block(const Bases& B, const BlockRef& cur, const BlockRef& nxt, char* lds, Seam& S) {
    int tid_ = threadIdx.x; asm volatile("" : "+v"(tid_));
    const int tid = tid_, wid = __builtin_amdgcn_readfirstlane(tid >> 6), lane = tid & 63, r32 = lane & 31, hi = lane >> 5;
    const int own = cur.qb, P0 = cur.qb * QB;
    const int NT = (P0 + QB) / KVBLK;
    const int qlo = P0 + wid * QBLK, qm = qlo + r32 - 4 * hi;
    char* V_lds = lds; char* K_lds = lds + NVB * SHM_V;
    float* ws = (float*)(lds + NVB * SHM_V + 2 * SHM_K) + wid * 64; float* li_l = ws, * al_l = ws + 32;
    float m_reg = -1e30f, l_reg = 0; f32x16 o[4] = {};
    const int sr = tid >> 4, sc = (tid & 15) * 8, vst0 = v_st(sr, sc), vst1 = v_st(32 + sr, sc), kws = KSWZ(sr, sc * 2);
    const int vb0 = (int)(uintptr_t)V_lds + v_rd_base(lane);
    const bf16* Kh = refK(B, cur); const bf16* Vh = refV(B, cur);
#define RESC(a) do { if (__any((a) < 1.f)) { if (hi == 0) al_l[r32] = (a); asm volatile("s_waitcnt lgkmcnt(0)" ::: "memory");              \
                     for (int d_ = 0; d_ < 4; ++d_) for (int r = 0; r < 16; ++r) o[d_][r] *= al_l[crow(r, hi)]; } } while (0)
#define KBASE(t) ((t) * KVBLK)
#define MASKT(P0_, P1_, t) do { const int kb_ = KBASE(t); const int jb_ = (t) >> 2;                                             \
        if (jb_ == own) { if (kb_ + KVBLK - 1 > qlo) mask_tile(P0_, P1_, qm - kb_); }                                          \
        else { const bool keep_ = ((selm >> jb_) & 1u) != 0u; if (!__all(keep_)) mask_all(P0_, P1_, keep_); } } while (0)
#define SEAM_K0() do { VMWN(8); SWRITE_HK(0); SBAR(); } while (0)
    f32x16 pA0, pA1, pB0, pB1; float mnA, mnB, alA, alB; bf16x8 pa0, pa1, pa2, pa3;
    SWRITE_HV(0); SBAR();
    if (NT > 1) { SLOAD_H(Kh, Vh, KBASE(1)); }
    SBAR();
    const unsigned selm = moba_select(S.qr, lds, own, r32, hi);
    SBAR(); qkt<0>(pA0, pA1, K_lds, r32, hi, S.qr);
    MASKT(pA0, pA1, 0); partialSM(pA0, pA1, m_reg, mnA, alA);
    if (NT > 1) { VMW(); SWRITE_H(1); }
    __syncthreads();
    int vp = 0;
#define HALF_STEP(PX0, PX1, alX, PY0, PY1, alY, t, KB, SB, CAUSAL) do {                                                       \
        const int vrd_ = vb0 + vp * SHM_V, vw_ = (vp == 0 ? 2 : vp - 1); const int jb_ = (t) >> 2;                            \
        SBAR(); qk_fin<KB>(PX0, PX1, PY0, PY1, alY, l_reg, pa0, pa1, pa2, pa3, K_lds, r32, hi, S.qr); SBAR();                 \
        if ((t) + 1 < NT) { SLOAD_H(Kh, Vh, KBASE((t) + 1)); SBAR(); }                                                        \
        if (CAUSAL) { mask_tile(PX0, PX1, qm - KBASE(t)); SBAR(); }           \
        const bool keep_ = (jb_ == own) || (((selm >> jb_) & 1u) != 0u);                                                      \
        pv_par(o, vrd_, pa0, pa1, pa2, pa3, PX0, PX1, m_reg, alX, keep_); SBAR();                                             \
        if ((t) + 1 < NT) { VMW(); SWRITE_HK(SB); *(bf16x8*)(V_lds + vw_ * SHM_V + vst0) = S.st_v0; *(bf16x8*)(V_lds + vw_ * SHM_V + vst1) = S.st_v1; } \
        RESC(alX); vp = (vp == 2 ? 0 : vp + 1); __syncthreads(); } while (0)
    int t = 1;
    for (; t + 1 < NT - 4; t += 2) {
        HALF_STEP(pB0, pB1, alB, pA0, pA1, alA, t, 1, 0, 0);
        HALF_STEP(pA0, pA1, alA, pB0, pB1, alB, t + 1, 0, 1, 0);
    }
    for (; t + 1 < NT; t += 2) {
        HALF_STEP(pB0, pB1, alB, pA0, pA1, alA, t, 1, 0, 1);
        HALF_STEP(pA0, pA1, alA, pB0, pB1, alB, t + 1, 0, 1, 1);
    }
    SBAR(); qkt_c<1>(pB0, pB1, K_lds, r32, hi, S.qr); SBAR();
    { const bf16* Kn = refK(B, nxt); const bf16* Vn = refV(B, nxt); SLOAD_H(Kn, Vn, 0); } SBAR();
#pragma unroll
    for (int d0 = 0; d0 < 8; ++d0) S.qr[d0] = load8(refQ(B, nxt) + (size_t)(wid * QBLK + r32) * LDQ + d0 * 16 + hi * 8);
    SBAR();
    finishSM(pA0, pA1, alA, l_reg, pa0, pa1, pa2, pa3); SBAR();
    pv_tile(o, vb0 + vp * SHM_V, pa0, pa1, pa2, pa3); vp = (vp == 2 ? 0 : vp + 1);
    MASKT(pB0, pB1, NT - 1); partialSM(pB0, pB1, m_reg, mnB, alB); __syncthreads(); RESC(alB);
    finishSM(pB0, pB1, alB, l_reg, pa0, pa1, pa2, pa3); SBAR(); pv_tile(o, vb0 + vp * SHM_V, pa0, pa1, pa2, pa3);
    SBAR(); SEAM_K0();
    if (hi == 0) li_l[r32] = l_reg; asm volatile("s_waitcnt lgkmcnt(0)" ::: "memory");
    int hi4 = 4 * hi; asm volatile("" : "+v"(hi4));
    float rli[16];
#pragma unroll
    for (int r = 0; r < 16; ++r) rli[r] = __builtin_amdgcn_rcpf(li_l[crow(r, 0) + hi4]);
    const size_t orow0 = (size_t)(cur.b * SEQ + P0 + wid * QBLK);
    unsigned char* Ob = (unsigned char*)B.mixed + orow0 * MIX_PITCH + cur.h * D; float* sqw = B.ssq + orow0 * 8 + cur.h;
    unsigned short* stg = (unsigned short*)(lds + LDS_BYTES) + wid * (QBLK * D);
#pragma unroll
    for (int r = 0; r < 16; ++r) { const int orow = crow(r, 0) + hi4;
#pragma unroll
        for (int d0 = 0; d0 < 4; ++d0) { const float v = o[d0][r] * rli[r]; stg[orow * D + d0 * 32 + r32] = (unsigned short)cvtpk(v, v); } }
    asm volatile("s_waitcnt lgkmcnt(0)" ::: "memory");
    int lrow = lane >> 4; asm volatile("" : "+v"(lrow));
    f32x4 kx, ky; km_load(B.kpart, nxt.b, nxt.h, tid, kx, ky);
#pragma unroll
    for (int i = 0; i < 8; ++i) { const int row = 4 * i + lrow, ch = lane & 15;
        const u32x4 w = *(const u32x4*)(stg + row * D + ch * 8);
        float a = 0.f; int q8[2] = {0, 0};
#pragma unroll
        for (int e = 0; e < 4; ++e) { const float lo = __uint_as_float(w[e] << 16), hi_ = __uint_as_float(w[e] & 0xffff0000u); a += lo * lo + hi_ * hi_;
            if (e & 1) q8[e >> 1] = __builtin_amdgcn_cvt_pk_fp8_f32(lo * AQ_SCALE, hi_ * AQ_SCALE, q8[e >> 1], true);
            else       q8[e >> 1] = __builtin_amdgcn_cvt_pk_fp8_f32(lo * AQ_SCALE, hi_ * AQ_SCALE, q8[e >> 1], false); }
        typedef int i32x2 __attribute__((ext_vector_type(2)));
        *(i32x2*)(Ob + (size_t)row * MIX_PITCH + ch * 8) = (i32x2){q8[0], q8[1]};
        a += __shfl_xor(a, 1); a += __shfl_xor(a, 2); a += __shfl_xor(a, 4); a += __shfl_xor(a, 8);
        if (ch == 0) sqw[row * 8] = a;
        SBAR(); }
    km_write(lds, tid, kx, ky);
    __syncthreads();
#undef RESC
#undef KBASE
#undef MASKT
#undef SEAM_K0
#undef HALF_STEP
}
#undef ROW
#undef VMW
#undef VMWN
#undef SLOAD_H
#undef SWRITE_HK
#undef SWRITE_HV
#undef SWRITE_H
#undef SBAR
#undef KSWZ
}

#ifndef PH_MASK
#define PH_MASK 0x7f
#endif
#ifndef DUP_MASK
#define DUP_MASK 0
#endif
#define NREP(k) (1 + ((DUP_MASK >> (k)) & 1))
constexpr int NWAVES = 8;
constexpr size_t MiB = 1u << 20;
constexpr size_t WS_CTL = 0, CTL_ZERO_BYTES = 1 * MiB;
constexpr size_t CTL_STATS1 = 0, CTL_STATS2 = 128 * 1024, CTL_C1 = 256 * 1024, CTL_C2 = 288 * 1024, CTL_BAR = 512 * 1024;
constexpr size_t WS_KPART = 1 * MiB;
constexpr size_t WS_SSQ = WS_KPART + 512 * 1024;
constexpr size_t WS_XS = 2 * MiB;
constexpr size_t WS_WIN = 4 * MiB;
constexpr size_t WS_WIN8 = 12 * MiB;
constexpr size_t WS_WO = 20 * MiB;
constexpr size_t WS_WUP = 28 * MiB;
constexpr size_t WS_WDN = 44 * MiB;
constexpr size_t WS_XB = 64 * MiB;
constexpr size_t WS_X8 = 128 * MiB;
constexpr size_t WS_PROJ = 160 * MiB;
constexpr size_t WS_R = 64 * MiB;
constexpr size_t WS_MIXED = 320 * MiB;
constexpr size_t WS_Z = 320 * MiB;
constexpr size_t WS_YB = 384 * MiB;
constexpr size_t WS_Y8 = 448 * MiB;
constexpr size_t WS_END = 480 * MiB;
constexpr size_t CTL_CNT = 768 * 1024, CTL_CNT_DUMMY = 832 * 1024;
constexpr size_t CTL_DUMMY = 640 * 1024;
constexpr int RING_BYTES = 131072, LDS_BYTES = 155648, MISC_OFF = LDS_BYTES - 64;

typedef unsigned short bf16;
typedef float f32x4 __attribute__((ext_vector_type(4)));
typedef unsigned v4u __attribute__((ext_vector_type(4)));
#define LAS __attribute__((address_space(3)))
#define LDS_WAIT() asm volatile("s_waitcnt lgkmcnt(0)" ::: "memory")
__device__ __forceinline__ unsigned pkbf(float lo, float hi) { unsigned r; asm volatile("v_cvt_pk_bf16_f32 %0, %1, %2" : "=v"(r) : "v"(lo), "v"(hi)); return r; }
__device__ __forceinline__ float wave_sum(float v) {
#pragma unroll
    for (int o = 1; o < 64; o <<= 1) v += __shfl_xor(v, o);
    return v;
}
__device__ __forceinline__ void p0_transpose_item(const float* W, int K, int N, bf16* WT, const float* gain, const float* bvec, float* c1, float* c2, LAS float* scr, int item, int lane, int pairgates = 0, int pitchB = 0, int boff = 0) {
    const int nblk = N / 64, kb = item / nblk, nb = item % nblk, k0 = 64 * kb, n0 = 64 * nb;
    const int nd0 = n0; (void)pairgates;
#pragma unroll
    for (int i = 0; i < 16; ++i) { const int kk = 4 * i + (lane >> 4), nn = 4 * (lane & 15);
        const f32x4 v = __builtin_nontemporal_load((const f32x4*)(W + (size_t)(k0 + kk) * N + n0 + nn));
        scr[kk * 65 + nn] = v[0]; scr[kk * 65 + nn + 1] = v[1]; scr[kk * 65 + nn + 2] = v[2]; scr[kk * 65 + nn + 3] = v[3]; }
    LDS_WAIT(); asm volatile("" ::: "memory");
    const int c = lane & 7;
    float gk[8], bk[8];
#pragma unroll
    for (int e = 0; e < 8; ++e) { gk[e] = gain ? gain[k0 + 8 * c + e] : 1.0f; bk[e] = bvec ? bvec[k0 + 8 * c + e] : 0.0f; }
#pragma unroll
    for (int j = 0; j < 8; ++j) { const int n = (lane >> 3) + 8 * j; const LAS float* s = scr + (8 * c) * 65 + n;
        float w[8];
#pragma unroll
        for (int e = 0; e < 8; ++e) w[e] = s[e * 65];
        v4u o; o.x = pkbf(w[0] * gk[0], w[1] * gk[1]); o.y = pkbf(w[2] * gk[2], w[3] * gk[3]); o.z = pkbf(w[4] * gk[4], w[5] * gk[5]); o.w = pkbf(w[6] * gk[6], w[7] * gk[7]);
        if (pitchB) *(v4u*)((unsigned char*)WT + (size_t)(nd0 + n) * pitchB + boff + 2 * (k0 + 8 * c)) = o; else *(v4u*)(WT + (size_t)(nd0 + n) * K + k0 + 8 * c) = o;
        if (c1) {
            float s1 = (__uint_as_float(o.x << 16) + __uint_as_float(o.x & 0xffff0000u)) + (__uint_as_float(o.y << 16) + __uint_as_float(o.y & 0xffff0000u))
                     + (__uint_as_float(o.z << 16) + __uint_as_float(o.z & 0xffff0000u)) + (__uint_as_float(o.w << 16) + __uint_as_float(o.w & 0xffff0000u));
            float s2 = 0.f;
#pragma unroll
            for (int e = 0; e < 8; ++e) s2 += w[e] * bk[e];
            s1 += __shfl_xor(s1, 1); s1 += __shfl_xor(s1, 2); s1 += __shfl_xor(s1, 4);
            s2 += __shfl_xor(s2, 1); s2 += __shfl_xor(s2, 2); s2 += __shfl_xor(s2, 4);
            if (c == 0) { (void)__hip_atomic_fetch_add(c1 + n0 + n, s1, __ATOMIC_RELAXED, __HIP_MEMORY_SCOPE_AGENT); (void)__hip_atomic_fetch_add(c2 + n0 + n, s2, __ATOMIC_RELAXED, __HIP_MEMORY_SCOPE_AGENT); }
        } }
    LDS_WAIT(); asm volatile("" ::: "memory");
}

#define XB_TMO      128
#define XB_XCNT(j)  (256  + 64 * (j))
#define XB_XSUB(j)  (1280 + 64 * (j))
#define XB_XGEN(j)  (2304 + 64 * (j))
#define XB_TOP      3328
#define XB_TOPGEN   3392
#define XCD_BAR_WORDS 3456
#define XB_SPIN_CAP (1u << 18)

__device__ __forceinline__ unsigned xb_ld(unsigned* p)              { return __hip_atomic_load(p, __ATOMIC_RELAXED, __HIP_MEMORY_SCOPE_AGENT); }
__device__ __forceinline__ unsigned xb_add(unsigned* p, unsigned v) { return __hip_atomic_fetch_add(p, v, __ATOMIC_RELAXED, __HIP_MEMORY_SCOPE_AGENT); }
__device__ __forceinline__ unsigned xb_xcc_id() { return (unsigned)__builtin_amdgcn_s_getreg((3 << 11) | 20) & 0xFu; }
#define XB_SPIN(cond, bar) do { unsigned _sp = 0; while (cond) { __builtin_amdgcn_s_sleep(1); \
    if ((++_sp & 255u) == 0u) { if (xb_ld(&(bar)[XB_TMO])) break; if (_sp > XB_SPIN_CAP) { atomicAdd(&(bar)[XB_TMO], 1u); break; } } } } while (0)

struct XcdBarrier {
    unsigned* bar; unsigned x;
    volatile LAS unsigned* st;
};

__device__ __forceinline__ XcdBarrier xcd_barrier_post(unsigned* bar, volatile LAS unsigned* st) {
    XcdBarrier b; b.bar = bar; b.x = xb_xcc_id(); b.st = st;
    if (threadIdx.x == 0) (void)xb_add(&bar[XB_XCNT(b.x)], 1u);
    return b;
}
__device__ __forceinline__ void xcd_barrier_complete(unsigned* bar, unsigned x, unsigned& nloc, unsigned& nx) {
    const unsigned G = gridDim.x * gridDim.y * gridDim.z;
    unsigned sum, cnt, mine, sp = 0u;
    for (;;) {
        sum = 0u; cnt = 0u; mine = 0u;
#pragma unroll
        for (unsigned j = 0; j < 16; ++j) { const unsigned c = xb_ld(&bar[XB_XCNT(j)]); sum += c; cnt += (c > 0u) ? 1u : 0u; mine = (j == x) ? c : mine; }
        if (sum == G) break;
        __builtin_amdgcn_s_sleep(1);
        if ((++sp & 255u) == 0u) { if (xb_ld(&bar[XB_TMO])) break; if (sp > XB_SPIN_CAP) { atomicAdd(&bar[XB_TMO], 1u); break; } }
    }
    nloc = mine > 0u ? mine : 1u; nx = cnt > 0u ? cnt : 1u;
}

__device__ __forceinline__ void xcd_barrier(const XcdBarrier& b) {
    asm volatile("s_waitcnt vmcnt(0)" ::: "memory");
    __syncthreads();
    if (threadIdx.x == 0) {
        unsigned* bar = b.bar;
        __builtin_amdgcn_s_waitcnt(0);
        unsigned nloc = b.st[0], nx = b.st[1];
        if (nloc == 0u) { xcd_barrier_complete(bar, b.x, nloc, nx); b.st[0] = nloc; b.st[1] = nx; }
        const unsigned old = xb_add(&bar[XB_XSUB(b.x)], 1u);
        const unsigned gen = old / nloc;
        if (old + 1u == (gen + 1u) * nloc) {
            __builtin_amdgcn_fence(__ATOMIC_RELEASE, "agent");
            asm volatile("s_waitcnt vmcnt(0)" ::: "memory");
            const unsigned og = xb_add(&bar[XB_TOP], 1u);
            const unsigned tg = og / nx;
            if (og + 1u == (tg + 1u) * nx) xb_add(&bar[XB_TOPGEN], 1u);
            else XB_SPIN(xb_ld(&bar[XB_TOPGEN]) == tg, bar);
            __builtin_amdgcn_fence(__ATOMIC_ACQUIRE, "agent");
            xb_add(&bar[XB_XGEN(b.x)], 1u);
            asm volatile("s_waitcnt vmcnt(0)" ::: "memory");
        } else {
            XB_SPIN(xb_ld(&bar[XB_XGEN(b.x)]) == gen, bar);
            __builtin_amdgcn_fence(__ATOMIC_ACQUIRE, "agent");
            asm volatile("s_waitcnt vmcnt(0)" ::: "memory");
        }
    }
    __syncthreads();
}

__device__ __forceinline__ void p0_transpose_item_i8(const float* W, int K, int N, unsigned char* WT, int nd0, const float* gain, const float* bvec, float* c1, float* c2, LAS float* scr, int item, int lane) {
    const int nblk = N / 64, kb = item / nblk, nb = item % nblk, k0 = 64 * kb, n0 = 64 * nb;
#pragma unroll
    for (int i = 0; i < 16; ++i) { const int kk = 4 * i + (lane >> 4), nn = 4 * (lane & 15);
        const f32x4 v = __builtin_nontemporal_load((const f32x4*)(W + (size_t)(k0 + kk) * N + n0 + nn));
        scr[kk * 65 + nn] = v[0]; scr[kk * 65 + nn + 1] = v[1]; scr[kk * 65 + nn + 2] = v[2]; scr[kk * 65 + nn + 3] = v[3]; }
    LDS_WAIT(); asm volatile("" ::: "memory");
    const int c = lane & 7;
    float gk[8], bk[8];
#pragma unroll
    for (int e = 0; e < 8; ++e) { gk[e] = (gain ? gain[k0 + 8 * c + e] : 1.0f) * WQ_SCALE; bk[e] = bvec ? bvec[k0 + 8 * c + e] : 0.0f; }
#pragma unroll
    for (int j = 0; j < 8; ++j) { const int n = (lane >> 3) + 8 * j; const LAS float* s = scr + (8 * c) * 65 + n;
        float w[8], s1 = 0.f, s2 = 0.f;
#pragma unroll
        for (int e = 0; e < 8; ++e) { w[e] = s[e * 65]; s2 += w[e] * bk[e]; w[e] = __builtin_rintf(__builtin_amdgcn_fmed3f(w[e] * gk[e], -127.f, 127.f)); s1 += w[e]; }
        typedef unsigned u32x2 __attribute__((ext_vector_type(2)));
        *(u32x2*)(WT + (size_t)(nd0 + n) * K + k0 + 8 * c) = (u32x2){pg8::pack_i8x4((f32x4){w[0], w[1], w[2], w[3]}), pg8::pack_i8x4((f32x4){w[4], w[5], w[6], w[7]})};
        if (c1) { s1 *= WQ_INV;
            s1 += __shfl_xor(s1, 1); s1 += __shfl_xor(s1, 2); s1 += __shfl_xor(s1, 4);
            s2 += __shfl_xor(s2, 1); s2 += __shfl_xor(s2, 2); s2 += __shfl_xor(s2, 4);
            if (c == 0) { (void)__hip_atomic_fetch_add(c1 + n0 + n, s1, __ATOMIC_RELAXED, __HIP_MEMORY_SCOPE_AGENT); (void)__hip_atomic_fetch_add(c2 + n0 + n, s2, __ATOMIC_RELAXED, __HIP_MEMORY_SCOPE_AGENT); } } }
    LDS_WAIT(); asm volatile("" ::: "memory");
}

__device__ __forceinline__ void p0_transpose_item_fp8(const float* W, int K, int N, unsigned char* WT, float scale, LAS float* scr, int item, int lane, const float* gain = nullptr, int pitchB = 0) {
    const int nblk = N / 64, kb = item / nblk, nb = item % nblk, k0 = 64 * kb, n0 = 64 * nb;
#pragma unroll
    for (int i = 0; i < 16; ++i) { const int kk = 4 * i + (lane >> 4), nn = 4 * (lane & 15);
        const f32x4 v = __builtin_nontemporal_load((const f32x4*)(W + (size_t)(k0 + kk) * N + n0 + nn));
        scr[kk * 65 + nn] = v[0]; scr[kk * 65 + nn + 1] = v[1]; scr[kk * 65 + nn + 2] = v[2]; scr[kk * 65 + nn + 3] = v[3]; }
    LDS_WAIT(); asm volatile("" ::: "memory");
    const int c = lane & 7;
#pragma unroll
    for (int j = 0; j < 8; ++j) { const int n = (lane >> 3) + 8 * j; const LAS float* s = scr + (8 * c) * 65 + n;
        float w[8];
#pragma unroll
        for (int e = 0; e < 8; ++e) w[e] = s[e * 65] * (gain ? gain[k0 + 8 * c + e] * scale : scale);
        int w0 = __builtin_amdgcn_cvt_pk_fp8_f32(w[0], w[1], 0, false); w0 = __builtin_amdgcn_cvt_pk_fp8_f32(w[2], w[3], w0, true);
        int w1 = __builtin_amdgcn_cvt_pk_fp8_f32(w[4], w[5], 0, false); w1 = __builtin_amdgcn_cvt_pk_fp8_f32(w[6], w[7], w1, true);
        typedef int i32x2 __attribute__((ext_vector_type(2)));
        *(i32x2*)(WT + (size_t)(n0 + n) * (pitchB ? pitchB : K) + k0 + 8 * c) = (i32x2){w0, w1}; }
    LDS_WAIT(); asm volatile("" ::: "memory");
}

__device__ __forceinline__ void p0_prologue(const float* x, const float* w_in, const float* w_o, const float* w_up, const float* w_down, const float* attn_g, const float* conv_g, const float* ln1_g, const float* ln1_b,
        bf16* WinT, unsigned char* Win8, bf16* WoT, unsigned char* Wup8, bf16* WdnT, bf16* XB, unsigned char* X8, float* xs, float* c1, float* c2, unsigned char* lds, int wave, int lane, int tid, int gw, int NGW, int G, int bx) {
        for (int row = gw; row < M_TOK; row += NGW) {
            f32x4 v[4][2]; float mx = 0.f;
#pragma unroll
            for (int j = 0; j < 4; ++j) { const float* p = x + (size_t)row * DM + (j * 64 + lane) * 8;
                v[j][0] = __builtin_nontemporal_load((const f32x4*)p); v[j][1] = __builtin_nontemporal_load((const f32x4*)(p + 4)); }
#pragma unroll
            for (int j = 0; j < 4; ++j)
#pragma unroll
                for (int h = 0; h < 2; ++h)
#pragma unroll
                    for (int e = 0; e < 4; ++e) mx = fmaxf(mx, fabsf(v[j][h][e]));
#pragma unroll
            for (int o = 1; o < 64; o <<= 1) mx = fmaxf(mx, __shfl_xor(mx, o));
            mx = fmaxf(mx, 1e-30f);
            const float inv = 127.0f / mx;
            if (lane == 0) xs[row] = mx * (1.0f / 127.0f);
#pragma unroll
            for (int j = 0; j < 4; ++j) { const size_t off = (size_t)row * DM + (j * 64 + lane) * 8;
                v4u o; o.x = pkbf(v[j][0][0], v[j][0][1]); o.y = pkbf(v[j][0][2], v[j][0][3]); o.z = pkbf(v[j][1][0], v[j][1][1]); o.w = pkbf(v[j][1][2], v[j][1][3]);
                *(v4u*)(XB + off) = o;
                typedef unsigned u32x2 __attribute__((ext_vector_type(2)));
                *(u32x2*)(X8 + off) = (u32x2){pg8::pack_i8x4(v[j][0] * inv), pg8::pack_i8x4(v[j][1] * inv)}; }
        }
        LAS float* scr = (LAS float*)((LAS unsigned char*)lds + wave * 16640);
        constexpr int I_IN = (DM / 64) * (NPROJ / 64), I_O = (DM / 64) * (DM / 64), I_UP = (DM / 64) * (FF / 64), I_DN = (FF / 64) * (DM / 64);
        constexpr int NITEMS = I_IN + I_O + I_UP + I_DN;
        for (int it = gw; it < NITEMS; it += NGW) {
            int r = it;
            if (r < I_UP) { const int nb = r % (FF / 64); p0_transpose_item_i8(w_up, DM, FF, Wup8, 64 * nb, ln1_g, ln1_b, c1, c2, scr, r, lane); continue; } r -= I_UP;
            if (r < I_IN) { const int n0 = 64 * (r % (NPROJ / 64));
                if (n0 < 2048) p0_transpose_item(w_in, DM, NPROJ, WinT, nullptr, nullptr, nullptr, nullptr, scr, r, lane);
                else { int nd0;
                    if (n0 < 4096) nd0 = n0 - 2048; else { const int isu = n0 >= 5120, ch = n0 - (isu ? 5120 : 4096); nd0 = 2048 + (ch >> 7) * 256 + isu * 128 + (ch & 127); }
                    p0_transpose_item_i8(w_in, DM, NPROJ, Win8, nd0, nullptr, nullptr, nullptr, nullptr, scr, r, lane); }
                continue; } r -= I_IN;
            if (r < I_O) { const int kb = r / (DM / 64);
                if (kb < 16) p0_transpose_item_fp8(w_o, DM, DM, (unsigned char*)WoT, WOA_SCALE, scr, r, lane, attn_g, MIX_PITCH);
                else p0_transpose_item(w_o, DM, DM, WoT, conv_g - AW, nullptr, nullptr, nullptr, scr, r, lane, 0, MIX_PITCH, -1024);
                continue; } r -= I_O;
            p0_transpose_item_fp8(w_down, FF, DM, (unsigned char*)WdnT, WDN_SCALE, scr, r, lane);
        }
}

__device__ __forceinline__ void conv_pass(const bf16* PROJ, bf16* MIXED, const float* conv_w, int vcu, int G) {
    int tid_ = threadIdx.x; asm volatile("" : "+v"(tid_));
    const int lane = tid_ & 63, gw = vcu * NWAVES + __builtin_amdgcn_readfirstlane(tid_ >> 6), NGW = G * NWAVES;
        const bf16* Bg = PROJ + (size_t)3 * M_TOK * 1024; const bf16* Zg = PROJ + (size_t)4 * M_TOK * 1024;
        for (int ch = gw; ch < M_TOK / 8; ch += NGW) {
            const int r0 = ch * 8;
            float w0[16], w1[16], w2[16], z1[16], z2[16];
#pragma unroll
            for (int hh = 0; hh < 2; ++hh)
#pragma unroll
                for (int e = 0; e < 8; ++e) { const int cc = hh * 512 + lane * 8 + e; w0[hh * 8 + e] = conv_w[cc]; w1[hh * 8 + e] = conv_w[1024 + cc]; w2[hh * 8 + e] = conv_w[2048 + cc]; z1[hh * 8 + e] = 0.f; z2[hh * 8 + e] = 0.f; }
            auto ldz = [&](int row, float* z) {
#pragma unroll
                for (int hh = 0; hh < 2; ++hh) { const v4u zv = __builtin_nontemporal_load((const v4u*)(Zg + (size_t)row * 1024 + hh * 512 + lane * 8));
#pragma unroll
                    for (int e = 0; e < 4; ++e) { z[hh * 8 + 2 * e] = __uint_as_float(zv[e] << 16); z[hh * 8 + 2 * e + 1] = __uint_as_float(zv[e] & 0xffff0000u); } } };
            if ((r0 & (SEQ - 1)) != 0) { ldz(r0 - 1, z1); ldz(r0 - 2, z2); }
            for (int i = 0; i < 8; ++i) { const int row = r0 + i;
                float z0[16], y[16]; ldz(row, z0);
                float ss = 0.f;
#pragma unroll
                for (int hh = 0; hh < 2; ++hh) { const v4u bv = __builtin_nontemporal_load((const v4u*)(Bg + (size_t)row * 1024 + hh * 512 + lane * 8));
#pragma unroll
                    for (int e = 0; e < 8; ++e) { const int k = hh * 8 + e; const float bb = (e & 1) ? __uint_as_float(bv[e >> 1] & 0xffff0000u) : __uint_as_float(bv[e >> 1] << 16);
                        y[k] = bb * (w0[k] * z2[k] + w1[k] * z1[k] + w2[k] * z0[k]); ss += y[k] * y[k]; } }
                const float rs = __builtin_amdgcn_rsqf(wave_sum(ss) * (1.0f / 1024.0f) + RMS_EPS);
#pragma unroll
                for (int hh = 0; hh < 2; ++hh) { v4u o;
#pragma unroll
                    for (int e = 0; e < 4; ++e) o[e] = pkbf(y[hh * 8 + 2 * e] * rs, y[hh * 8 + 2 * e + 1] * rs);
                    *(v4u*)((bf16*)((unsigned char*)MIXED + (size_t)row * MIX_PITCH + 1024) + hh * 512 + lane * 8) = o; }
#pragma unroll
                for (int k = 0; k < 16; ++k) { z2[k] = z1[k]; z1[k] = z0[k]; } }
        }
}

struct Args { const float* in[12]; float* out; unsigned char* ws; };

__global__ void __launch_bounds__(NWAVES * 64, 2) hymba_fwd(Args args) {
    extern __shared__ __attribute__((aligned(16))) unsigned char lds[];
    const int tid = threadIdx.x, lane = tid & 63, wave = __builtin_amdgcn_readfirstlane(tid >> 6);
    const int G = gridDim.x, bx = blockIdx.x;
    const int vcu = (G % 8 == 0) ? (bx % 8) * (G / 8) + bx / 8 : bx;
    const int gw = vcu * NWAVES + wave, NGW = G * NWAVES;
    unsigned char* ws = args.ws;
    const float* x = args.in[0]; const float* w_in = args.in[1]; const float* conv_w = args.in[2]; const float* attn_g = args.in[3]; const float* conv_g = args.in[4];
    const float* w_o = args.in[5]; const float* ln1_g = args.in[6]; const float* ln1_b = args.in[7]; const float* w_up = args.in[8]; const float* w_down = args.in[9];
    const float* ln2_g = args.in[10]; const float* ln2_b = args.in[11];
    float* stats1 = (float*)(ws + WS_CTL + CTL_STATS1); float* stats2 = (float*)(ws + WS_CTL + CTL_STATS2);
    float* c1 = (float*)(ws + WS_CTL + CTL_C1); float* c2 = (float*)(ws + WS_CTL + CTL_C2);
    float* dummy = (float*)(ws + WS_CTL + CTL_DUMMY);
    float* kpart = (float*)(ws + WS_KPART); float* ssq = (float*)(ws + WS_SSQ);
    bf16* WinT = (bf16*)(ws + WS_WIN); unsigned char* Win8 = ws + WS_WIN8; bf16* WoT = (bf16*)(ws + WS_WO); unsigned char* Wup8 = ws + WS_WUP; bf16* WdnT = (bf16*)(ws + WS_WDN); float* xs = (float*)(ws + WS_XS);
    bf16* XB = (bf16*)(ws + WS_XB); bf16* PROJ = (bf16*)(ws + WS_PROJ); bf16* RB = (bf16*)(ws + WS_R); bf16* MIXED = (bf16*)(ws + WS_MIXED); bf16* YB = (bf16*)(ws + WS_YB); unsigned char* Y8 = ws + WS_Y8; unsigned char* X8 = ws + WS_X8;
    PG8_LAS unsigned char* ldsp = (PG8_LAS unsigned char*)lds;
    volatile LAS unsigned* MISC = (volatile LAS unsigned*)((LAS unsigned char*)lds + MISC_OFF);
    if (tid < 16) MISC[tid] = 0u;
    __syncthreads();
    const XcdBarrier bar = xcd_barrier_post((unsigned*)(ws + WS_CTL + CTL_BAR), MISC + 8);
#define GRID_SYNC() xcd_barrier(bar)

    for (int rep = 0; rep < NREP(0) && (PH_MASK & 1); ++rep) { if (rep) GRID_SYNC();
        p0_prologue(x, w_in, w_o, w_up, w_down, attn_g, conv_g, ln1_g, ln1_b, WinT, Win8, WoT, Wup8, WdnT, XB, X8, xs, rep ? dummy : c1, rep ? dummy + 8192 : c2, lds, wave, lane, tid, gw, NGW, G, bx);
    }
    GRID_SYNC();

    for (int rep = 0; rep < NREP(1) && (PH_MASK & 2); ++rep) { if (rep) GRID_SYNC();
        { pg8::Gemm g{XB, WinT, M_TOK, 2048, DM}; pg8::StaticOrder S; S.init(M_TOK, 2048, G, bx);
          pg8::EpiProj E{PROJ, kpart};
          pg8::gemm_phase<pg8::EpiProj, pg8::StaticOrder, true, true>(ldsp, g, S, E); }
        { pg8::Gemm g{(const bf16*)X8, (const bf16*)Win8, M_TOK, 4096, DM / 2}; pg8::StaticOrder S; S.init(M_TOK, 4096, G, bx);
          pg8::EpiProjI8 E{PROJ, xs};
          pg8::gemm_phase<pg8::EpiProjI8, pg8::StaticOrder, true, true, 3>(ldsp, g, S, E); }
    }
    GRID_SYNC();

    for (int rep = 0; rep < NREP(2) && (PH_MASK & 4); ++rep) { if (rep) GRID_SYNC();
        if (vcu & 1) conv_pass(PROJ, MIXED, conv_w, vcu, G);
        att::Seam S; const att::Bases AB{PROJ, MIXED, ssq, kpart};
        int L = vcu, pass = 0;
        if (L < 256) {
            att::BlockRef cur{L >> 5, (L >> 2) & 7, L & 3};
            att::moba_prime(AB, cur, (char*)lds, S);
            for (;;) {
                const bool more_pass = pass == 0, more_item = L + G < 256, last = !more_pass && !more_item;
                int passn = pass + 1, Ln = L; if (!more_pass) { passn = 0; Ln = more_item ? L + G : L; }
                att::BlockRef nxt{Ln >> 5, (Ln >> 2) & 7, passn ? 7 - (Ln & 3) : (Ln & 3)}; if (last) nxt = cur;
                att::moba_block<true>(AB, cur, nxt, (char*)lds, S);
                if (last) break;
                cur = nxt; pass = passn; L = Ln;
            }
        }
        asm volatile("s_waitcnt vmcnt(0)" ::: "memory");
        if (!(vcu & 1)) conv_pass(PROJ, MIXED, conv_w, vcu, G);
    }
    GRID_SYNC();

    for (int rep = 0; rep < NREP(3) && (PH_MASK & 8); ++rep) { if (rep) GRID_SYNC();
        pg8::Gemm g{MIXED, WoT, M_TOK, DM, MIX_PITCH / 2}; pg8::StaticOrder S; S.init(M_TOK, DM, G, bx);
        pg8::EpiWo E{XB, YB, Y8, rep ? dummy : stats1, ssq};
        pg8::gemm_phase<pg8::EpiWo, pg8::StaticOrder, true, true, 6>(ldsp, g, S, E);
    }
    GRID_SYNC();

    for (int rep = 0; rep < NREP(4) && (PH_MASK & 16); ++rep) { if (rep) GRID_SYNC();
        pg8::Gemm g{(const bf16*)Y8, (const bf16*)Wup8, M_TOK, FF, DM / 2}; pg8::StaticOrder S; S.init(M_TOK, FF, G, bx);
        pg8::EpiUp E{stats1, c1, c2, (unsigned char*)RB};
        pg8::gemm_phase<pg8::EpiUp, pg8::StaticOrder, true, true, 3>(ldsp, g, S, E);
    }
    GRID_SYNC();

    for (int rep = 0; rep < NREP(5) && (PH_MASK & 32); ++rep) { if (rep) GRID_SYNC();
        pg8::Gemm g{RB, WdnT, M_TOK, DM, FF / 2}; pg8::PanelOrder S; S.init(M_TOK, DM, G, bx);
        pg8::EpiDownLN E{Y8, stats1, ln1_g, ln1_b, rep ? dummy : stats2, (unsigned*)(ws + WS_CTL + (rep ? CTL_CNT_DUMMY : CTL_CNT)), ln2_g, ln2_b, args.out};
        pg8::gemm_phase<pg8::EpiDownLN, pg8::PanelOrder, true, true, 2>(ldsp, g, S, E);
    }

    for (int xs = 0; xs < ((DUP_MASK >> 8) & 0xff); ++xs) GRID_SYNC();
    if ((DUP_MASK >> 7) & 1) { GRID_SYNC(); p0_prologue(x, w_in, w_o, w_up, w_down, attn_g, conv_g, ln1_g, ln1_b, WinT, Win8, WoT, Wup8, WdnT, XB, X8, xs, dummy, dummy + 8192, lds, wave, lane, tid, gw, NGW, G, bx); }
}

extern "C" void kernel_launch(void* const* d_in, const int* in_sizes, int n_in, void* d_out, int out_size, void* d_ws, size_t ws_size, hipStream_t stream) {
    static int grid = 0;
    if (grid == 0) {
        if (n_in != 12 || in_sizes[0] != M_TOK * DM || out_size != M_TOK * DM || ws_size < WS_END) {
            fprintf(stderr, "kernel_launch: shape/workspace mismatch (n_in %d, in0 %d, out %d, ws %zu; need ws >= %zu); nothing launched\n", n_in, n_in > 0 ? in_sizes[0] : -1, out_size, ws_size, (size_t)WS_END); grid = -1; return; }
        int dev = 0, cus = 0, per_cu = 0;
        if (hipGetDevice(&dev) != hipSuccess || hipDeviceGetAttribute(&cus, hipDeviceAttributeMultiprocessorCount, dev) != hipSuccess) { fprintf(stderr, "kernel_launch: device query failed\n"); grid = -1; return; }
        if (hipFuncSetAttribute((const void*)hymba_fwd, hipFuncAttributeMaxDynamicSharedMemorySize, LDS_BYTES) != hipSuccess) { fprintf(stderr, "kernel_launch: hipFuncSetAttribute failed\n"); grid = -1; return; }
        if (hipOccupancyMaxActiveBlocksPerMultiprocessor(&per_cu, (const void*)hymba_fwd, NWAVES * 64, LDS_BYTES) != hipSuccess || per_cu < 1) { fprintf(stderr, "kernel_launch: occupancy query says %d blocks per CU\n", per_cu); grid = -1; (void)hipGetLastError(); return; }
        grid = cus;
        if (grid > 256) grid = 256;
    }
    if (grid < 0) return;
    (void)hipMemsetAsync((char*)d_ws + WS_CTL, 0, CTL_ZERO_BYTES, stream);
    Args a{};
    for (int i = 0; i < 12; ++i) a.in[i] = (const float*)d_in[i];
    a.out = (float*)d_out; a.ws = (unsigned char*)d_ws;
    void* kargs[] = {&a};
    hipError_t e = hipLaunchCooperativeKernel((const void*)hymba_fwd, dim3(grid), dim3(NWAVES * 64), kargs, LDS_BYTES, stream);
    if (e != hipSuccess) fprintf(stderr, "kernel_launch: cooperative launch failed: %s (grid %d)\n", hipGetErrorString(e), grid);
}
```

```cpp
#include <hip/hip_runtime.h>
#include <hip/hip_cooperative_groups.h>
#include <cstdio>
#include <cstdint>
namespace cg = cooperative_groups;

constexpr int M_TOK = 16384, DM = 2048, SEQ = 2048, NBATCH = 8, AW = 1024, NPROJ = 6144, FF = 8192, NHEAD = 8, HD = 128, NBLK = 8;
constexpr float LN_EPS = 1e-5f, RMS_EPS = 1e-6f, ALPHA = 1.189207115002721f;
constexpr float WQ_SCALE = 1536.f, WQ_INV = 1.0f / 1536.f;
constexpr float AQ_SCALE = 16.f, WOA_SCALE = 512.f, P3_ATT_INV = 1.0f / (16.f * 512.f);
constexpr int MIX_PITCH = 3072;
constexpr float YQ_SCALE = 24.f, YQ_INV = 1.0f / 24.f;
constexpr float WDN_SCALE = 1024.f, WDN_INV_SCALE = 1.0f / 1024.f;

namespace pg8 {
#define PG8_LAS __attribute__((address_space(3)))
typedef unsigned short bf16_t;
typedef short bf16x8 __attribute__((ext_vector_type(8)));
typedef float f32x4 __attribute__((ext_vector_type(4)));
typedef unsigned u32x4 __attribute__((ext_vector_type(4)));
typedef int v4i_t __attribute__((ext_vector_type(4)));
constexpr int BM = 256, BK = 64, HALF = 128, HTB = HALF * BK * 2  , STAGE_BYTES = 8 * HTB, NXCD = 8, WGM = 8;

__host__ __device__ __forceinline__ int lds_byte(int r, int c) { const int st = (r >> 4) * 2 + (c >> 5), rr = r & 15, cc = c & 31, ob = rr * 64 + cc * 2; return st * 1024 + (ob ^ (((ob >> 9) & 1) << 5)); }
__host__ __device__ __forceinline__ void stage_rc(int b, int& R, int& C) { const int st = b / 1024, sb = b % 1024, swz = sb ^ (((sb >> 9) & 1) << 5); R = (st >> 1) * 16 + swz / 64; C = (st & 1) * 32 + (swz % 64) / 2; }
__host__ __device__ __forceinline__ int perm32(int rho) { const int n = rho >> 4, i = rho & 15; return 8 * (i >> 2) + 4 * n + (i & 3); }

struct Unit { int pm, pn; };
struct Gemm { const bf16_t* A; const bf16_t* Bt; int M, N, K; };

struct StaticOrder {
    int nM, nN, nwg, G, c;
    __host__ __device__ void init(int M, int N, int G_, int c_) { nM = M / BM; nN = N / BM; nwg = nM * nN; G = G_; c = c_; }
    __host__ __device__ bool next(int i, Unit& u) const {
        const long L = (long)i * G + c; if (L >= nwg) return false;
        int wgid = (int)L; { const int q = nwg / NXCD, r = nwg % NXCD, xcd = wgid % NXCD, off = wgid / NXCD; wgid = (xcd < r ? xcd * (q + 1) : r * (q + 1) + (xcd - r) * q) + off; }
        const int nig = WGM * nN, gid = wgid / nig, fm = gid * WGM, gsz = (nM - fm) < WGM ? (nM - fm) : WGM;
        u.pm = fm + ((wgid % nig) % gsz); u.pn = (wgid % nig) / gsz; return true;
    }
    __device__ __forceinline__ void a_ready(const Unit&) const {}
    __device__ __forceinline__ void done(const Unit&) const {}
};
__device__ __forceinline__ unsigned cvt_pk_bf16(float lo, float hi) { unsigned r; asm volatile("v_cvt_pk_bf16_f32 %0, %1, %2" : "=v"(r) : "v"(lo), "v"(hi)); return r; }
__device__ __forceinline__ float bf_lo(unsigned w) { return __uint_as_float(w << 16); }
__device__ __forceinline__ float bf_hi(unsigned w) { return __uint_as_float(w & 0xffff0000u); }
__device__ __forceinline__ float hsum4(f32x4 v) { return (v[0] + v[1]) + (v[2] + v[3]); }
__device__ __forceinline__ float hsq4(f32x4 v) { return (v[0] * v[0] + v[1] * v[1]) + (v[2] * v[2] + v[3] * v[3]); }
__device__ __forceinline__ unsigned pack_i8x4(f32x4 v) {
    const unsigned u0 = __float_as_uint(__builtin_amdgcn_fmed3f(v[0], -127.f, 127.f) + 12582912.f), u1 = __float_as_uint(__builtin_amdgcn_fmed3f(v[1], -127.f, 127.f) + 12582912.f);
    const unsigned u2 = __float_as_uint(__builtin_amdgcn_fmed3f(v[2], -127.f, 127.f) + 12582912.f), u3 = __float_as_uint(__builtin_amdgcn_fmed3f(v[3], -127.f, 127.f) + 12582912.f);
    const unsigned w01 = __builtin_amdgcn_perm(u1, u0, 0x0c0c0400u), w23 = __builtin_amdgcn_perm(u3, u2, 0x0c0c0400u);
    return __builtin_amdgcn_perm(w23, w01, 0x05040100u);
}
__device__ __forceinline__ f32x4 i32_to_f32(f32x4 a) { return __builtin_convertvector(__builtin_bit_cast(v4i_t, a), f32x4); }
__device__ __forceinline__ void atomic_addf(float* p, float v) { (void)__hip_atomic_fetch_add(p, v, __ATOMIC_RELAXED, __HIP_MEMORY_SCOPE_AGENT); }

struct EpiProj {
    static constexpr bool STAGED = false, PERM = true, AFTER_DRAIN = false, MID = false; static constexpr int MID_T = 0;
    bf16_t* O; float* kpart;
    __device__ __forceinline__ void mid(f32x4 (&)[2][2][4][2], PG8_LAS unsigned char*, int, int) const {}
    __device__ __forceinline__ void operator()(const f32x4 (&acc)[2][2][4][2], const Unit& u, int wr, int wc, int fr, int fq) const {
        const int t = u.pn >> 2, colt = (u.pn & 3) * BM;
        const int row0 = u.pm * BM + wr * 64 + fr;
        bf16_t* base = O + (size_t)t * ((size_t)M_TOK * 1024);
        const int col0 = colt + wc * 32 + 8 * fq;
#pragma unroll
        for (int ai = 0; ai < 2; ++ai)
#pragma unroll
            for (int m = 0; m < 4; ++m) { bf16_t* rowp = base + (size_t)(row0 + ai * HALF + m * 16) * 1024 + col0;
#pragma unroll
                for (int bj = 0; bj < 2; ++bj) { const f32x4 v0 = acc[ai][bj][m][0], v1 = acc[ai][bj][m][1];
                    u32x4 w; w.x = cvt_pk_bf16(v0[0], v0[1]); w.y = cvt_pk_bf16(v0[2], v0[3]); w.z = cvt_pk_bf16(v1[0], v1[1]); w.w = cvt_pk_bf16(v1[2], v1[3]);
                    *(u32x4*)(rowp + bj * HALF) = w; } }
        if (t == 1) {
#pragma unroll
            for (int bj = 0; bj < 2; ++bj)
#pragma unroll
                for (int n = 0; n < 2; ++n) { f32x4 s = (f32x4){0.f, 0.f, 0.f, 0.f};
#pragma unroll
                    for (int ai = 0; ai < 2; ++ai)
#pragma unroll
                        for (int m = 0; m < 4; ++m) s += acc[ai][bj][m][n];
#pragma unroll
                    for (int o = 1; o < 16; o <<= 1) { s[0] += __shfl_xor(s[0], o); s[1] += __shfl_xor(s[1], o); s[2] += __shfl_xor(s[2], o); s[3] += __shfl_xor(s[3], o); }
                    if (fr == 0) *(f32x4*)(kpart + ((size_t)wr * 64 + u.pm) * 1024 + col0 + bj * HALF + 4 * n) = s; }
        }
    }
};

struct EpiProjI8 {
    static constexpr bool STAGED = false, PERM = true, AFTER_DRAIN = false, MID = false, LDSX = false; static constexpr int MID_T = 0;
    bf16_t* O; const float* xs;
    __device__ __forceinline__ void mid(f32x4 (&)[2][2][4][2], PG8_LAS unsigned char*, int, int) const {}
    __device__ __forceinline__ void operator()(const f32x4 (&acc)[2][2][4][2], const Unit& u, int wr, int wc, int fr, int fq) const {
        const int row0 = u.pm * BM + wr * 64 + fr;
        float sc[2][4];
#pragma unroll
        for (int ai = 0; ai < 2; ++ai)
#pragma unroll
            for (int m = 0; m < 4; ++m) sc[ai][m] = xs[row0 + ai * HALF + m * 16] * WQ_INV;
        if (u.pn >= 8) {
            bf16_t* zb = O + (size_t)4 * ((size_t)M_TOK * 1024); const int ch0 = (u.pn - 8) * HALF + wc * 32 + 8 * fq;
#pragma unroll
            for (int ai = 0; ai < 2; ++ai)
#pragma unroll
                for (int m = 0; m < 4; ++m) { const float s2 = sc[ai][m] * sc[ai][m];
                    const f32x4 v0 = i32_to_f32(acc[ai][0][m][0]) * i32_to_f32(acc[ai][1][m][0]) * s2, v1 = i32_to_f32(acc[ai][0][m][1]) * i32_to_f32(acc[ai][1][m][1]) * s2;
                    u32x4 w; w.x = cvt_pk_bf16(v0[0], v0[1]); w.y = cvt_pk_bf16(v0[2], v0[3]); w.z = cvt_pk_bf16(v1[0], v1[1]); w.w = cvt_pk_bf16(v1[2], v1[3]);
                    *(u32x4*)(zb + (size_t)(row0 + ai * HALF + m * 16) * 1024 + ch0) = w; }
            return;
        }
        bf16_t* base = O + (size_t)(2 + (u.pn >> 2)) * ((size_t)M_TOK * 1024);
        const int col0 = (u.pn & 3) * BM + wc * 32 + 8 * fq;
#pragma unroll
        for (int ai = 0; ai < 2; ++ai)
#pragma unroll
            for (int m = 0; m < 4; ++m) { bf16_t* rowp = base + (size_t)(row0 + ai * HALF + m * 16) * 1024 + col0;
#pragma unroll
                for (int bj = 0; bj < 2; ++bj) { const f32x4 v0 = i32_to_f32(acc[ai][bj][m][0]) * sc[ai][m], v1 = i32_to_f32(acc[ai][bj][m][1]) * sc[ai][m];
                    u32x4 w; w.x = cvt_pk_bf16(v0[0], v0[1]); w.y = cvt_pk_bf16(v0[2], v0[3]); w.z = cvt_pk_bf16(v1[0], v1[1]); w.w = cvt_pk_bf16(v1[2], v1[3]);
                    *(u32x4*)(rowp + bj * HALF) = w; } }
    }
};

struct EpiWo {
    static constexpr bool STAGED = false, PERM = true, AFTER_DRAIN = false, MID = true; static constexpr int MID_T = 8;
    const bf16_t* xb; bf16_t* YB; unsigned char* Y8; float* stats; const float* ssq;
    __device__ __forceinline__ void pre(const Unit& u, PG8_LAS unsigned char* ldsx, int tid) const {
        if (tid < BM) { const int row = u.pm * BM + tid;
            const f32x4 a = *(const f32x4*)(ssq + (size_t)row * 8), b = *(const f32x4*)(ssq + (size_t)row * 8 + 4);
            ((PG8_LAS float*)ldsx)[tid] = __builtin_amdgcn_rsqf((hsum4(a) + hsum4(b)) * (1.0f / 1024.0f) + RMS_EPS) * P3_ATT_INV; }
    }
    __device__ __forceinline__ void mid(f32x4 (&acc)[2][2][4][2], PG8_LAS unsigned char* ldsx, int wr, int fr) const {
#pragma unroll
        for (int ai = 0; ai < 2; ++ai)
#pragma unroll
            for (int m = 0; m < 4; ++m) { const float ra = ((const PG8_LAS float*)ldsx)[ai * HALF + wr * 64 + m * 16 + fr];
#pragma unroll
                for (int bj = 0; bj < 2; ++bj)
#pragma unroll
                    for (int n = 0; n < 2; ++n) acc[ai][bj][m][n] *= ra; }
    }
    __device__ __forceinline__ void operator()(const f32x4 (&acc)[2][2][4][2], const Unit& u, int wr, int wc, int fr, int fq) const {
        const int row0 = u.pm * BM + wr * 64 + fr, col0 = u.pn * BM + wc * 32 + 8 * fq;
#pragma unroll
        for (int ai = 0; ai < 2; ++ai) {
        u32x4 xr[2][4][2];
#pragma unroll
            for (int m = 0; m < 4; ++m)
#pragma unroll
                for (int bj = 0; bj < 2; ++bj) xr[ai][m][bj] = __builtin_nontemporal_load((const u32x4*)(xb + (size_t)(row0 + ai * HALF + m * 16) * DM + col0 + bj * HALF));
#pragma unroll
            for (int m = 0; m < 4; ++m) { const int row = row0 + ai * HALF + m * 16; float s = 0.f, q = 0.f;
#pragma unroll
                for (int bj = 0; bj < 2; ++bj) { const u32x4 xw = xr[ai][m][bj];
                    const f32x4 x0 = (f32x4){bf_lo(xw.x), bf_hi(xw.x), bf_lo(xw.y), bf_hi(xw.y)}, x1 = (f32x4){bf_lo(xw.z), bf_hi(xw.z), bf_lo(xw.w), bf_hi(xw.w)};
                    const f32x4 v0 = acc[ai][bj][m][0] + x0 * ALPHA, v1 = acc[ai][bj][m][1] + x1 * ALPHA;
                    s += hsum4(v0) + hsum4(v1); q += hsq4(v0) + hsq4(v1);
                    u32x4 w; w.x = cvt_pk_bf16(v0[0], v0[1]); w.y = cvt_pk_bf16(v0[2], v0[3]); w.z = cvt_pk_bf16(v1[0], v1[1]); w.w = cvt_pk_bf16(v1[2], v1[3]);
                    const int col = col0 + bj * HALF;
                    typedef unsigned u32x2 __attribute__((ext_vector_type(2)));
                    *(u32x2*)(Y8 + (size_t)row * DM + col) = (u32x2){pack_i8x4(v0 * YQ_SCALE), pack_i8x4(v1 * YQ_SCALE)}; }
                s += __shfl_xor(s, 16); s += __shfl_xor(s, 32); q += __shfl_xor(q, 16); q += __shfl_xor(q, 32);
                if (fq == 0) { atomic_addf(stats + (size_t)row * 2, s); atomic_addf(stats + (size_t)row * 2 + 1, q); } }
        }
    }
};

struct EpiUp {
    static constexpr bool STAGED = true, PERM = true, AFTER_DRAIN = false, MID = false; static constexpr int MID_T = 0;
    const float* stats1; const float* c1; const float* c2; unsigned char* R;
    __device__ __forceinline__ void mid(f32x4 (&)[2][2][4][2], PG8_LAS unsigned char*, int, int) const {}
    __device__ __forceinline__ void operator()(const f32x4 (&)[2][2][4][2], const Unit&, int, int, int, int) const {}
    __device__ __forceinline__ void staged(const f32x4 (&acc)[2][2][4][2], const Unit& u, int wr, int wc, int fr, int fq, PG8_LAS unsigned char* stg, int tid) const {
        const int row0 = u.pm * BM + wr * 64 + fr, col0 = u.pn * BM + wc * 32 + 8 * fq;
        f32x4 k1[2][2], k2[2][2];
#pragma unroll
        for (int bj = 0; bj < 2; ++bj)
#pragma unroll
            for (int n = 0; n < 2; ++n) { k1[bj][n] = *(const f32x4*)(c1 + col0 + bj * HALF + 4 * n); k2[bj][n] = *(const f32x4*)(c2 + col0 + bj * HALF + 4 * n); }
        typedef float f32x2 __attribute__((ext_vector_type(2))); f32x2 st[2][4];
#pragma unroll
        for (int ai = 0; ai < 2; ++ai)
#pragma unroll
            for (int m = 0; m < 4; ++m) st[ai][m] = *(const f32x2*)(stats1 + (size_t)(row0 + ai * HALF + m * 16) * 2);
        int w0 = 0, w1 = 0;
        constexpr int PITCH = 272, BUF = 32 * PITCH;
        const int wofs = (wr * 16 + fr) * PITCH + wc * 32 + 8 * fq, rrow = tid >> 4, rofs = rrow * PITCH + (tid & 15) * 16;
        unsigned char* gout = R + (size_t)(u.pm * BM + (rrow >> 4) * 64 + (rrow & 15)) * FF + u.pn * BM + (tid & 15) * 16;
#pragma unroll
        for (int ai = 0; ai < 2; ++ai)
#pragma unroll
            for (int m = 0; m < 4; ++m) { PG8_LAS unsigned char* buf = stg + ((ai * 4 + m) & 1) * BUF;
                const float sm = st[ai][m].x, sq = st[ai][m].y;
                const float mu = sm * (1.0f / DM), var = sq * (1.0f / DM) - mu * mu, rstd = __builtin_amdgcn_rsqf(var + LN_EPS), rs = rstd * (YQ_INV * WQ_INV), nm = -rstd * mu;
#pragma unroll
                for (int bj = 0; bj < 2; ++bj) {
                    f32x4 v0 = i32_to_f32(acc[ai][bj][m][0]) * rs + (k1[bj][0] * nm + k2[bj][0]), v1 = i32_to_f32(acc[ai][bj][m][1]) * rs + (k1[bj][1] * nm + k2[bj][1]);
#pragma unroll
                    for (int e = 0; e < 4; ++e) { v0[e] = __builtin_amdgcn_fmed3f(v0[e], 0.f, 21.166f); v1[e] = __builtin_amdgcn_fmed3f(v1[e], 0.f, 21.166f); }
                    v0 = v0 * v0; v1 = v1 * v1;
                    w0 = __builtin_amdgcn_cvt_pk_fp8_f32(v0[0], v0[1], w0, false); w0 = __builtin_amdgcn_cvt_pk_fp8_f32(v0[2], v0[3], w0, true);
                    w1 = __builtin_amdgcn_cvt_pk_fp8_f32(v1[0], v1[1], w1, false); w1 = __builtin_amdgcn_cvt_pk_fp8_f32(v1[2], v1[3], w1, true);
                    typedef int i32x2 __attribute__((ext_vector_type(2)));
                    *(PG8_LAS i32x2*)(buf + wofs + bj * HALF) = (i32x2){w0, w1}; }
                asm volatile("s_waitcnt lgkmcnt(0)" ::: "memory"); __builtin_amdgcn_s_barrier();
                const u32x4 v = *(const PG8_LAS u32x4*)(buf + rofs);
                *(u32x4*)(gout + (size_t)(ai * HALF + m * 16) * FF) = v; }
    }
};

struct EpiDownLN {
    static constexpr bool STAGED = false, PERM = true, AFTER_DRAIN = false, MID = false; static constexpr int MID_T = 0;
    const unsigned char* Y8; const float* stats1; const float* g1; const float* b1; float* stats2; unsigned* cnt; const float* g2; const float* b2; float* out;
    __device__ __forceinline__ void mid(f32x4 (&)[2][2][4][2], PG8_LAS unsigned char*, int, int) const {}
    __device__ __forceinline__ void operator()(f32x4 (&acc)[2][2][4][2], const Unit& u, int wr, int wc, int fr, int fq) const {
        const int row0 = u.pm * BM + wr * 64 + fr, col0 = u.pn * BM + wc * 32 + 8 * fq;
        typedef float f32x2 __attribute__((ext_vector_type(2)));
        {
        f32x4 gv[2][2], bv[2][2];
#pragma unroll
        for (int bj = 0; bj < 2; ++bj)
#pragma unroll
            for (int n = 0; n < 2; ++n) { gv[bj][n] = *(const f32x4*)(g1 + col0 + bj * HALF + 4 * n); bv[bj][n] = *(const f32x4*)(b1 + col0 + bj * HALF + 4 * n); }
#pragma unroll
        for (int aim = 0; aim < 4; ++aim) { const int ai = aim >> 1;
            typedef unsigned u32x2 __attribute__((ext_vector_type(2))); u32x2 yr[4][2];
#pragma unroll
            for (int m = 2 * (aim & 1); m < 2 * (aim & 1) + 2; ++m)
#pragma unroll
                for (int bj = 0; bj < 2; ++bj) { const int row = row0 + ai * HALF + m * 16, col = col0 + bj * HALF;
                    yr[m][bj] = __builtin_nontemporal_load((const u32x2*)(Y8 + (size_t)row * DM + col)); }
#pragma unroll
            for (int m = 2 * (aim & 1); m < 2 * (aim & 1) + 2; ++m) { const int row = row0 + ai * HALF + m * 16;
                const f32x2 stv = *(const f32x2*)(stats1 + (size_t)row * 2); const float sm = stv.x, sq = stv.y;
                const float mu = sm * (1.0f / DM), var = sq * (1.0f / DM) - mu * mu, rstd = __builtin_amdgcn_rsqf(var + LN_EPS);
                float s = 0.f, q = 0.f;
#pragma unroll
                for (int bj = 0; bj < 2; ++bj) { const u32x2 yb = yr[m][bj];
                    f32x4 y0 = (f32x4){(float)(int)(signed char)(yb.x), (float)(int)(signed char)(yb.x >> 8), (float)(int)(signed char)(yb.x >> 16), (float)((int)yb.x >> 24)} * YQ_INV;
                    f32x4 y1 = (f32x4){(float)(int)(signed char)(yb.y), (float)(int)(signed char)(yb.y >> 8), (float)(int)(signed char)(yb.y >> 16), (float)((int)yb.y >> 24)} * YQ_INV;
                    const f32x4 h0 = (y0 - mu) * rstd * gv[bj][0] + bv[bj][0], h1 = (y1 - mu) * rstd * gv[bj][1] + bv[bj][1];
                    const f32x4 v0 = acc[ai][bj][m][0] * WDN_INV_SCALE + h0 * ALPHA, v1 = acc[ai][bj][m][1] * WDN_INV_SCALE + h1 * ALPHA;
                    s += hsum4(v0) + hsum4(v1); q += hsq4(v0) + hsq4(v1);
                    acc[ai][bj][m][0] = v0; acc[ai][bj][m][1] = v1; }
                s += __shfl_xor(s, 16); s += __shfl_xor(s, 32); q += __shfl_xor(q, 16); q += __shfl_xor(q, 32);
                if (fq == 0) { atomic_addf(stats2 + (size_t)row * 2, s); atomic_addf(stats2 + (size_t)row * 2 + 1, q); } }
        }
        }
        asm volatile("s_waitcnt vmcnt(0)" ::: "memory");
        unsigned* pc = cnt + 64 * u.pm;
        if (fr == 0 && fq == 0) (void)__hip_atomic_fetch_add(pc, 1u, __ATOMIC_RELAXED, __HIP_MEMORY_SCOPE_AGENT);
        { unsigned spins = 0;
          while ((unsigned)__builtin_amdgcn_readfirstlane(__hip_atomic_load(pc, __ATOMIC_RELAXED, __HIP_MEMORY_SCOPE_AGENT)) < 64u) { __builtin_amdgcn_s_sleep(2); if (++spins > (1u << 20)) break; } }
        f32x4 gg[2][2], bb[2][2];
#pragma unroll
        for (int bj = 0; bj < 2; ++bj)
#pragma unroll
            for (int n = 0; n < 2; ++n) { gg[bj][n] = *(const f32x4*)(g2 + col0 + bj * HALF + 4 * n); bb[bj][n] = *(const f32x4*)(b2 + col0 + bj * HALF + 4 * n); }
#pragma unroll
        for (int ai = 0; ai < 2; ++ai)
#pragma unroll
            for (int m = 0; m < 4; ++m) { const int row = row0 + ai * HALF + m * 16;
                const float sm = __hip_atomic_load(stats2 + (size_t)row * 2, __ATOMIC_RELAXED, __HIP_MEMORY_SCOPE_AGENT), sq = __hip_atomic_load(stats2 + (size_t)row * 2 + 1, __ATOMIC_RELAXED, __HIP_MEMORY_SCOPE_AGENT);
                const float mu = sm * (1.0f / DM), var = sq * (1.0f / DM) - mu * mu, rstd = __builtin_amdgcn_rsqf(var + LN_EPS);
#pragma unroll
                for (int bj = 0; bj < 2; ++bj) { float* op = out + (size_t)row * DM + col0 + bj * HALF;
                    *(f32x4*)op = (acc[ai][bj][m][0] - mu) * rstd * gg[bj][0] + bb[bj][0];
                    *(f32x4*)(op + 4) = (acc[ai][bj][m][1] - mu) * rstd * gg[bj][1] + bb[bj][1]; } }
    }
};
struct PanelOrder {
    int G, vcu, ntile;
    __host__ __device__ void init(int M, int N, int G_, int c) { G = G_; vcu = (G_ % 8 == 0) ? (c % 8) * (G_ / 8) + c / 8 : c; ntile = (M / BM) * (N / BM); }
    __host__ __device__ bool next(int i, Unit& u) const { const int idx = i * G + vcu; if (idx >= ntile) return false; u.pm = idx >> 3; u.pn = idx & 7; return true; }
    __device__ __forceinline__ void a_ready(const Unit&) const {}
    __device__ __forceinline__ void done(const Unit&) const {}
};

template <class Epi, class Sched, bool ALIGN_EPI = false, bool SP2 = false, int FP8M = 0, int F8T1 = 0>
__device__ __forceinline__ void gemm_phase(PG8_LAS unsigned char* lds, const Gemm g, const Sched& S, const Epi& E) {
    int tid_ = threadIdx.x; asm volatile("" : "+v"(tid_));
    const int tid = tid_, wid = __builtin_amdgcn_readfirstlane(tid >> 6), lane = tid & 63, wr = wid >> 2, wc = wid & 3, fr = lane & 15, fq = lane >> 4;
    const int K = g.K, nt = K / BK;
    unsigned voffA[2], voffB[2];
#pragma unroll
    for (int i = 0; i < 2; ++i) { int R, C; stage_rc(tid * 16 + i * 8192, R, C); const int Rb = Epi::PERM ? ((R & ~31) + perm32(R & 31)) : R;
        voffA[i] = (unsigned)(R * K + C) * 2u; voffB[i] = (unsigned)(Rb * K + C) * 2u; }
    const size_t kstep = (size_t)(BK * 2);
    const size_t hstep = (size_t)HALF * K * 2;
    const size_t tstep = 2 * hstep;
    const unsigned ldsw = (unsigned)wid * 1024u;
    const int aoff = lds_byte(wr * 64 + fr, fq * 8), boff = lds_byte(wc * 32 + fr, fq * 8);
#define PG8_SA(b, h) (((b) * 2 + (h)) * HTB)
#define PG8_SB(b, h) ((4 + (b) * 2 + (h)) * HTB)
#define PG8_STAGE(bufoff, gbase, voff) do { _Pragma("unroll") for (int _i = 0; _i < 2; ++_i) \
        __builtin_amdgcn_global_load_lds((const unsigned*)((const char*)(gbase) + (voff)[_i]), (PG8_LAS unsigned*)(lds + (bufoff) + ldsw + _i * 8192), 16, 0, 0); } while (0)
#define PG8_LDA(dst, b, h) do { _Pragma("unroll") for (int m = 0; m < 4; ++m) _Pragma("unroll") for (int k = 0; k < 2; ++k) dst[m][k] = *(const PG8_LAS bf16x8*)(lds + PG8_SA(b, h) + aoff + m * 2048 + k * 1024); } while (0)
#define PG8_LDB(dst, b, h) do { _Pragma("unroll") for (int n = 0; n < 2; ++n) _Pragma("unroll") for (int k = 0; k < 2; ++k) dst[n][k] = *(const PG8_LAS bf16x8*)(lds + PG8_SB(b, h) + boff + n * 2048 + k * 1024); } while (0)
#define PG8_CAT(x0, x1) __builtin_shufflevector(__builtin_bit_cast(v4i_t, x0), __builtin_bit_cast(v4i_t, x1), 0, 1, 2, 3, 4, 5, 6, 7)
#define PG8_MMA_F8(ai, bj, At, Bt) do { __builtin_amdgcn_s_setprio(1); _Pragma("unroll") for (int m = 0; m < 4; ++m) _Pragma("unroll") for (int n = 0; n < 2; ++n) \
        asm volatile("v_mfma_scale_f32_16x16x128_f8f6f4 %0, %1, %2, %0, %3, %3 op_sel_hi:[0,0,0]" : "+v"(acc[ai][bj][m][n]) : "v"(PG8_CAT(Bt[n][0], Bt[n][1])), "v"(PG8_CAT(At[m][0], At[m][1])), "v"(scl8)); \
        __builtin_amdgcn_s_setprio(0); } while (0)
#define PG8_MMA_B16A(ai, bj, At, Bt) do { __builtin_amdgcn_s_setprio(1); _Pragma("unroll") for (int m = 0; m < 4; ++m) _Pragma("unroll") for (int n = 0; n < 2; ++n) _Pragma("unroll") for (int k = 0; k < 2; ++k) \
        asm volatile("v_mfma_f32_16x16x32_bf16 %0, %1, %2, %0" : "+v"(acc[ai][bj][m][n]) : "v"(Bt[n][k]), "v"(At[m][k]));   \
        __builtin_amdgcn_s_setprio(0); } while (0)
#define PG8_MMA_B16(ai, bj, At, Bt) do { __builtin_amdgcn_s_setprio(1); _Pragma("unroll") for (int m = 0; m < 4; ++m) _Pragma("unroll") for (int n = 0; n < 2; ++n) _Pragma("unroll") for (int k = 0; k < 2; ++k) \
        acc[ai][bj][m][n] = __builtin_amdgcn_mfma_f32_16x16x32_bf16(Bt[n][k], At[m][k], acc[ai][bj][m][n], 0, 0, 0); __builtin_amdgcn_s_setprio(0); } while (0)
#define PG8_MMA_I8(ai, bj, At, Bt) do { __builtin_amdgcn_s_setprio(1); _Pragma("unroll") for (int m = 0; m < 4; ++m) _Pragma("unroll") for (int n = 0; n < 2; ++n) _Pragma("unroll") for (int k = 0; k < 2; ++k) \
        acc[ai][bj][m][n] = __builtin_bit_cast(f32x4, __builtin_amdgcn_mfma_i32_16x16x64_i8(__builtin_bit_cast(v4i_t, Bt[n][k]), __builtin_bit_cast(v4i_t, At[m][k]), __builtin_bit_cast(v4i_t, acc[ai][bj][m][n]), 0, 0, 0)); \
        __builtin_amdgcn_s_setprio(0); } while (0)
#define PG8_MMA(ai, bj, At, Bt) PG8_MMA_B16(ai, bj, At, Bt)
#define PG8_WAIT_V(n) asm volatile("s_waitcnt vmcnt(" #n ")" ::: "memory")
#define PG8_WAIT_L(n) asm volatile("s_waitcnt lgkmcnt(" #n ")" ::: "memory")
#define PG8_BAR __builtin_amdgcn_s_barrier()
#define PG8_SCHED __builtin_amdgcn_sched_barrier(0)
#define PG8_ITER_SP2(MMA_) do { \
            PG8_LDB(B0, 0, 0); PG8_LDB(B1, 0, 1); PG8_SCHED; PG8_LDA(At, 0, 0); PG8_STAGE(PG8_SA(1, 1), a1 + hstep, voffA); \
            PG8_WAIT_V(8); PG8_WAIT_L(0); PG8_BAR; MMA_(0, 0, At, B0); MMA_(0, 1, At, B1); PG8_BAR; PG8_SCHED; \
            PG8_LDA(At, 0, 1); PG8_STAGE(PG8_SB(0, 0), b2, voffB); PG8_STAGE(PG8_SB(0, 1), b2 + hstep, voffB); PG8_STAGE(PG8_SA(0, 0), a2, voffA); \
            PG8_WAIT_V(8); PG8_WAIT_L(0); PG8_BAR; MMA_(1, 0, At, B0); MMA_(1, 1, At, B1); PG8_BAR; PG8_SCHED; \
            PG8_LDB(B0, 1, 0); PG8_LDB(B1, 1, 1); PG8_SCHED; PG8_LDA(At, 1, 0); PG8_STAGE(PG8_SA(0, 1), a2 + hstep, voffA); \
            PG8_WAIT_V(8); PG8_WAIT_L(0); PG8_BAR; MMA_(0, 0, At, B0); MMA_(0, 1, At, B1); PG8_BAR; PG8_SCHED; \
            PG8_LDA(At, 1, 1); PG8_STAGE(PG8_SB(1, 0), b3, voffB); PG8_STAGE(PG8_SB(1, 1), b3 + hstep, voffB); PG8_STAGE(PG8_SA(1, 0), a3, voffA); \
            PG8_WAIT_V(8); PG8_WAIT_L(0); PG8_BAR; MMA_(1, 0, At, B0); MMA_(1, 1, At, B1); PG8_BAR; PG8_SCHED; \
            } while (0)
    Unit cur, nxt; int ui = 0;
    if (!S.next(0, cur)) return;
    f32x4 acc[2][2][4][2];
#pragma unroll
    for (int a = 0; a < 2; ++a)
#pragma unroll
        for (int b = 0; b < 2; ++b)
#pragma unroll
            for (int m = 0; m < 4; ++m)
#pragma unroll
                for (int n = 0; n < 2; ++n) acc[a][b][m][n] = (f32x4){0.f, 0.f, 0.f, 0.f};
    bf16x8 At[4][2], B0[2][2], B1[2][2];
    int scl8 = 0x7f7f7f7f; asm volatile("" : "+v"(scl8));
    const char* cA = (const char*)g.A + (size_t)cur.pm * tstep; const char* cB = (const char*)g.Bt + (size_t)cur.pn * tstep;
    S.a_ready(cur);
    if constexpr (Epi::MID) E.pre(cur, lds + STAGE_BYTES, tid);
    if constexpr (SP2) {
        PG8_STAGE(PG8_SB(0, 0), cB, voffB); PG8_STAGE(PG8_SB(0, 1), cB + hstep, voffB); PG8_STAGE(PG8_SA(0, 0), cA, voffA); PG8_STAGE(PG8_SA(0, 1), cA + hstep, voffA);
        if (wr == 1) PG8_BAR;
        PG8_WAIT_V(2); PG8_BAR;
        PG8_STAGE(PG8_SB(1, 0), cB + kstep, voffB); PG8_STAGE(PG8_SA(1, 0), cA + kstep, voffA); PG8_STAGE(PG8_SB(1, 1), cB + hstep + kstep, voffB);
        PG8_WAIT_V(6); PG8_BAR;
    } else {
        PG8_STAGE(PG8_SB(0, 0), cB, voffB); PG8_STAGE(PG8_SA(0, 0), cA, voffA); PG8_STAGE(PG8_SB(0, 1), cB + hstep, voffB); PG8_STAGE(PG8_SA(0, 1), cA + hstep, voffA);
        if (wr == 1) PG8_BAR;
        PG8_WAIT_V(4); PG8_BAR;
        PG8_STAGE(PG8_SB(1, 0), cB + kstep, voffB); PG8_STAGE(PG8_SA(1, 0), cA + kstep, voffA); PG8_STAGE(PG8_SB(1, 1), cB + hstep + kstep, voffB);
        PG8_WAIT_V(6); PG8_BAR;
    }
    for (;;) {
        const bool has_next = S.next(ui + 1, nxt);
        const char* nA = has_next ? (const char*)g.A + (size_t)nxt.pm * tstep : cA; const char* nB = has_next ? (const char*)g.Bt + (size_t)nxt.pn * tstep : cB;
        constexpr int SPLIT = Epi::MID ? Epi::MID_T : (FP8M == 1 ? F8T1 : 0);
        if constexpr (SPLIT > 0 && SP2) {
            for (int t = 0; t < SPLIT; t += 2) {
                const char* a1 = cA + (size_t)(t + 1) * kstep; const char* a2 = cA + (size_t)(t + 2) * kstep; const char* b2 = cB + (size_t)(t + 2) * kstep;
                const char* a3 = a2 + kstep; const char* b3 = b2 + kstep;
                if constexpr (FP8M == 1) PG8_ITER_SP2(PG8_MMA_B16A); else if constexpr (FP8M == 2 || FP8M == 6) PG8_ITER_SP2(PG8_MMA_F8); else if constexpr (FP8M == 3) PG8_ITER_SP2(PG8_MMA_I8); else PG8_ITER_SP2(PG8_MMA_B16);
            }
            if constexpr (FP8M == 1) asm volatile("s_nop 15" ::: "memory");
            if constexpr (FP8M == 6) { asm volatile("s_nop 15\n\ts_nop 15" ::: "memory"); PG8_SCHED; }
            if constexpr (Epi::MID) E.mid(acc, lds + STAGE_BYTES, wr, fr);
        }
        for (int t = SPLIT; t < nt; t += 2) {
            const bool last = (t == nt - 2);
            const char* a1 = cA + (size_t)(t + 1) * kstep;
            const char* a2 = last ? nA : cA + (size_t)(t + 2) * kstep; const char* b2 = last ? nB : cB + (size_t)(t + 2) * kstep;
            const char* a3 = a2 + kstep; const char* b3 = b2 + kstep;
            if (last && has_next) S.a_ready(nxt);
            if constexpr (SP2) {
            if constexpr (FP8M == 1) PG8_ITER_SP2(PG8_MMA_F8);
            else if constexpr (FP8M == 2) PG8_ITER_SP2(PG8_MMA_F8);
            else if constexpr (FP8M == 3) PG8_ITER_SP2(PG8_MMA_I8);
            else PG8_ITER_SP2(PG8_MMA_B16);
            } else {
            PG8_LDB(B0, 0, 0); PG8_SCHED; PG8_LDA(At, 0, 0); PG8_STAGE(PG8_SA(1, 1), a1 + hstep, voffA);
            PG8_WAIT_L(8); PG8_BAR; PG8_WAIT_L(0); PG8_MMA(0, 0, At, B0); PG8_BAR; PG8_SCHED;
            PG8_LDB(B1, 0, 1); PG8_STAGE(PG8_SB(0, 0), b2, voffB);
            PG8_BAR; PG8_WAIT_L(0); PG8_MMA(0, 1, At, B1); PG8_BAR;
            PG8_LDA(At, 0, 1); PG8_STAGE(PG8_SA(0, 0), a2, voffA);
            PG8_BAR; PG8_WAIT_L(0); PG8_MMA(1, 0, At, B0); PG8_BAR; PG8_SCHED;
            PG8_STAGE(PG8_SB(0, 1), b2 + hstep, voffB);
            PG8_WAIT_V(6); PG8_BAR; PG8_MMA(1, 1, At, B1); PG8_BAR;
            PG8_LDB(B0, 1, 0); PG8_SCHED; PG8_LDA(At, 1, 0); PG8_STAGE(PG8_SA(0, 1), a2 + hstep, voffA);
            PG8_WAIT_L(8); PG8_BAR; PG8_WAIT_L(0); PG8_MMA(0, 0, At, B0); PG8_BAR; PG8_SCHED;
            PG8_LDB(B1, 1, 1); PG8_STAGE(PG8_SB(1, 0), b3, voffB);
            PG8_BAR; PG8_WAIT_L(0); PG8_MMA(0, 1, At, B1); PG8_BAR;
            PG8_LDA(At, 1, 1); PG8_STAGE(PG8_SA(1, 0), a3, voffA);
            PG8_BAR; PG8_WAIT_L(0); PG8_MMA(1, 0, At, B0); PG8_BAR; PG8_SCHED;
            PG8_STAGE(PG8_SB(1, 1), b3 + hstep, voffB);
            PG8_WAIT_V(6); PG8_BAR; PG8_MMA(1, 1, At, B1); PG8_BAR;
            }
        }
        if constexpr (ALIGN_EPI) { if (wr == 0) PG8_BAR; }
        if constexpr (FP8M == 1 || FP8M == 2) { asm volatile("s_nop 15\n\ts_nop 15" ::: "memory"); PG8_SCHED; }
        if constexpr (Epi::STAGED) { E.staged(acc, cur, wr, wc, fr, fq, lds + STAGE_BYTES, tid); S.done(cur); }
        else if constexpr (!Epi::AFTER_DRAIN) { E(acc, cur, wr, wc, fr, fq); S.done(cur); }
        if (!has_next) break;
#pragma unroll
        for (int a = 0; a < 2; ++a)
#pragma unroll
            for (int b = 0; b < 2; ++b)
#pragma unroll
                for (int m = 0; m < 4; ++m)
#pragma unroll
                    for (int n = 0; n < 2; ++n) acc[a][b][m][n] = (f32x4){0.f, 0.f, 0.f, 0.f};
        cur = nxt; cA = nA; cB = nB; ++ui;
        if constexpr (Epi::MID) E.pre(cur, lds + STAGE_BYTES, tid);
        if constexpr (ALIGN_EPI) { if (wr == 1) PG8_BAR; }
    }
    PG8_WAIT_V(0);
    if constexpr (!ALIGN_EPI) { if (wr == 0) PG8_BAR; }
    PG8_BAR;
    if constexpr (Epi::AFTER_DRAIN) { E.fused(acc, cur, wr, wc, fr, fq, lds, wid, lane); S.done(cur); }
#undef PG8_SA
#undef PG8_SB
#undef PG8_STAGE
#undef PG8_LDA
#undef PG8_LDB
#undef PG8_MMA
#undef PG8_MMA_F8
#undef PG8_MMA_I8
#undef PG8_MMA_B16
#undef PG8_MMA_B16A
#undef PG8_ITER_SP2
#undef PG8_CAT
#undef PG8_WAIT_V
#undef PG8_WAIT_L
#undef PG8_BAR
#undef PG8_SCHED
}
}

#ifndef PG8_SP2
#define PG8_SP2 true
#endif
#ifndef PG8_ALIGN
#define PG8_ALIGN true
#endif
namespace att {
typedef unsigned short bf16;
typedef short bf16x8 __attribute__((ext_vector_type(8)));
typedef short s16x4 __attribute__((ext_vector_type(4)));
typedef float f32x16 __attribute__((ext_vector_type(16)));
typedef float f32x4 __attribute__((ext_vector_type(4)));
typedef unsigned u32x4 __attribute__((ext_vector_type(4)));
constexpr int D = 128, NW = 8, QBLK = 32, KVBLK = 64, QB = NW * QBLK, LDQ = 1024, LDO = 2048;
constexpr int SHM_V = KVBLK * D * 2, SHM_K = KVBLK * D * 2;
constexpr int NVB = 3;
constexpr int LDS_BYTES = NVB * SHM_V + 2 * SHM_K + NW * 64 * 4;
constexpr int KM_OFF = LDS_BYTES + NW * QBLK * D * 2, KM_PITCH = 272;
constexpr float SCALE = 0.08838834764831845f, THR = 8.f;
constexpr size_t KPART_STRIDE = (size_t)64 * 1024;

#define KSWZ(row, colB) ((((colB) >> 7) * 8192) + (row) * 128 + (((((colB) >> 4) & 7) ^ (((row) >> 1) & 7)) << 4))
#define SBAR() __builtin_amdgcn_sched_barrier(0)
__device__ __forceinline__ int v_st(int k, int c) { const int kk = (k & ~0xC) | ((k & 4) << 1) | ((k & 8) >> 1); return ((kk >> 3) * 4 + (c >> 5)) * 512 + ((kk & 7) * 32 + (c & 31)) * 2; }
__device__ __forceinline__ int v_rd_base(int lane) { return ((lane & 3) << 3) | (((lane >> 2) & 3) << 6) | (((lane >> 4) & 1) << 5) | (((lane >> 5) & 1) << 8); }
constexpr int v_rd_off(int d0, int ks, int half) { return d0 * 512 + ks * 4096 + half * 2048; }
__device__ __forceinline__ int crow(int r, int hi) { return (r & 3) + 8 * (r >> 2) + 4 * hi; }
__device__ __forceinline__ unsigned cvtpk(float lo, float hi) { unsigned r; asm volatile("v_cvt_pk_bf16_f32 %0, %1, %2" : "=v"(r) : "v"(lo), "v"(hi)); return r; }
__device__ __forceinline__ bf16x8 pack8(f32x4 a, f32x4 b) { u32x4 w = {cvtpk(a[0], a[1]), cvtpk(a[2], a[3]), cvtpk(b[0], b[1]), cvtpk(b[2], b[3])}; return *reinterpret_cast<bf16x8*>(&w); }
__device__ __forceinline__ bf16x8 load8(const bf16* p) { return *reinterpret_cast<const bf16x8*>(p); }
__device__ __forceinline__ void mask_tile(f32x16& p0, f32x16& p1, int dq) {
#define MT1(P, r, c_) do { float t_ = P[r]; asm volatile("v_cmp_le_i32 vcc, %1, %2\n\tv_cndmask_b32 %0, %3, %0, vcc" : "+v"(t_) : "n"(c_), "v"(dq), "v"(NEG) : "vcc"); P[r] = t_; } while (0)
    float NEG = -__builtin_inff(); asm volatile("" : "+v"(NEG));
    MT1(p0, 0, 0); MT1(p0, 1, 1); MT1(p0, 2, 2); MT1(p0, 3, 3); MT1(p0, 4, 8); MT1(p0, 5, 9); MT1(p0, 6, 10); MT1(p0, 7, 11);
    MT1(p0, 8, 16); MT1(p0, 9, 17); MT1(p0, 10, 18); MT1(p0, 11, 19); MT1(p0, 12, 24); MT1(p0, 13, 25); MT1(p0, 14, 26); MT1(p0, 15, 27);
    MT1(p1, 0, 32); MT1(p1, 1, 33); MT1(p1, 2, 34); MT1(p1, 3, 35); MT1(p1, 4, 40); MT1(p1, 5, 41); MT1(p1, 6, 42); MT1(p1, 7, 43);
    MT1(p1, 8, 48); MT1(p1, 9, 49); MT1(p1, 10, 50); MT1(p1, 11, 51); MT1(p1, 12, 56); MT1(p1, 13, 57); MT1(p1, 14, 58); MT1(p1, 15, 59);
#undef MT1
}
__device__ __forceinline__ void mask_all(f32x16& p0, f32x16& p1, bool keep) {
    const float NEG = -__builtin_inff();
#pragma unroll
    for (int r = 0; r < 16; ++r) { p0[r] = keep ? p0[r] : NEG; p1[r] = keep ? p1[r] : NEG; }
}
__device__ __forceinline__ void partialSM(f32x16& p0, f32x16& p1, float& m_reg, float& mn, float& alpha) {
    float pmax = p0[0];
#pragma unroll
    for (int r = 1; r < 16; ++r) pmax = fmaxf(pmax, p0[r]);
#pragma unroll
    for (int r = 0; r < 16; ++r) pmax = fmaxf(pmax, p1[r]);
    { auto rr = __builtin_amdgcn_permlane32_swap(__float_as_uint(pmax), __float_as_uint(pmax), false, false);
      pmax = fmaxf(__uint_as_float(rr[0]), __uint_as_float(rr[1])); }
    constexpr float C2 = 1.4426950408889634f * SCALE;
    if (__builtin_expect(__all((pmax - m_reg) * SCALE <= THR), 1)) { mn = m_reg; alpha = 1.f; }
    else { mn = fmaxf(m_reg, pmax); alpha = __builtin_amdgcn_exp2f((m_reg - mn) * C2); m_reg = mn; }
    const float mnL = -mn * C2;
#pragma unroll
    for (int r = 0; r < 16; ++r) p0[r] = fmaf(p0[r], C2, mnL);
#pragma unroll
    for (int r = 0; r < 16; ++r) p1[r] = fmaf(p1[r], C2, mnL);
#pragma unroll
    for (int r = 0; r < 16; ++r) p0[r] = __builtin_amdgcn_exp2f(p0[r]);
}
__device__ __forceinline__ void finishSM(f32x16& p0, f32x16& p1, float alpha, float& l_reg, bf16x8& pa0, bf16x8& pa1, bf16x8& pa2, bf16x8& pa3) {
#pragma unroll
    for (int r = 0; r < 16; ++r) p1[r] = __builtin_amdgcn_exp2f(p1[r]);
    float ps = 0;
#pragma unroll
    for (int r = 0; r < 16; ++r) ps += p0[r];
#pragma unroll
    for (int r = 0; r < 16; ++r) ps += p1[r];
    { auto rr = __builtin_amdgcn_permlane32_swap(__float_as_uint(ps), __float_as_uint(ps), false, false);
      ps = __uint_as_float(rr[0]) + __uint_as_float(rr[1]); }
    l_reg = l_reg * alpha + ps;
#define PK4(P, B_, OUT) do { unsigned a0 = cvtpk(P[B_+0], P[B_+1]), a1 = cvtpk(P[B_+2], P[B_+3]);                          \
        unsigned b0 = cvtpk(P[B_+4], P[B_+5]), b1 = cvtpk(P[B_+6], P[B_+7]);                                             \
        auto r0 = __builtin_amdgcn_permlane32_swap(a0, b0, false, false); auto r1 = __builtin_amdgcn_permlane32_swap(a1, b1, false, false); \
        u32x4 w = {r0[0], r1[0], r0[1], r1[1]}; OUT = *reinterpret_cast<bf16x8*>(&w); } while (0)
    PK4(p0, 0, pa0); PK4(p0, 8, pa1); PK4(p1, 0, pa2); PK4(p1, 8, pa3);
#undef PK4
}
template <int KB>
__device__ __forceinline__ void qkt(f32x16& p0, f32x16& p1, const char* K_lds, int r32, int hi, const bf16x8* qr) {
    p0 = f32x16{}; p1 = f32x16{};
    int kb[4];
#pragma unroll
    for (int dd = 0; dd < 4; ++dd) kb[dd] = (int)(uintptr_t)(K_lds + KSWZ(r32, (dd * 16 + hi * 8) * 2));
#define KRD(dst, d0_) do { asm volatile("ds_read_b128 %0, %1 offset:%2" : "=&v"(dst[0]) : "v"(kb[(d0_) & 3]), "i"(KB * SHM_K + ((d0_) >> 2) * 8192) : "memory");          \
                           asm volatile("ds_read_b128 %0, %1 offset:%2" : "=&v"(dst[1]) : "v"(kb[(d0_) & 3]), "i"(KB * SHM_K + ((d0_) >> 2) * 8192 + 32 * 128) : "memory"); } while (0)
#define KMM(f, d0_, n_) do { asm volatile("s_waitcnt lgkmcnt(" #n_ ")" ::: "memory"); SBAR();                                                              \
        p0 = __builtin_amdgcn_mfma_f32_32x32x16_bf16(f[0], qr[d0_], p0, 0, 0, 0); p1 = __builtin_amdgcn_mfma_f32_32x32x16_bf16(f[1], qr[d0_], p1, 0, 0, 0); SBAR(); } while (0)
    bf16x8 fa[2], fb[2];
    KRD(fa, 0); KRD(fb, 1);
    KMM(fa, 0, 2); KRD(fa, 2);
    KMM(fb, 1, 2); KRD(fb, 3);
    KMM(fa, 2, 2); KRD(fa, 4);
    KMM(fb, 3, 2); KRD(fb, 5);
    KMM(fa, 4, 2); KRD(fa, 6);
    KMM(fb, 5, 2); KRD(fb, 7);
    KMM(fa, 6, 2);
    KMM(fb, 7, 0);
#undef KRD
#undef KMM
}
template <int KB>
__device__ __forceinline__ void qkt_c(f32x16& p0, f32x16& p1, const char* K_lds, int r32, int hi, const bf16x8* qr) {
    p0 = f32x16{}; p1 = f32x16{};
    const char* kb[4];
#pragma unroll
    for (int dd = 0; dd < 4; ++dd) kb[dd] = K_lds + KB * SHM_K + KSWZ(r32, (dd * 16 + hi * 8) * 2);
#pragma unroll
    for (int d0 = 0; d0 < 8; ++d0) { const char* a = kb[d0 & 3] + (d0 >> 2) * 8192;
        bf16x8 b0 = *reinterpret_cast<const bf16x8*>(a);
        bf16x8 b1 = *reinterpret_cast<const bf16x8*>(a + 32 * 128);
        p0 = __builtin_amdgcn_mfma_f32_32x32x16_bf16(b0, qr[d0], p0, 0, 0, 0);
        p1 = __builtin_amdgcn_mfma_f32_32x32x16_bf16(b1, qr[d0], p1, 0, 0, 0); }
}
__device__ __forceinline__ void pv_tile(f32x16* o, int vb0, bf16x8 pa0, bf16x8 pa1, bf16x8 pa2, bf16x8 pa3) {
#define TRRD(dst, off) asm volatile("ds_read_b64_tr_b16 %0, %1 offset:%2" : "=&v"(dst) : "v"(vb0), "i"(off) : "memory")
#define PV_R(d0, ks, l, h) do { TRRD(l, v_rd_off(d0, 0, 0) + (ks) * 4096); TRRD(h, v_rd_off(d0, 0, 0) + (ks) * 4096 + 2048); } while (0)
#define PV_M(d0, pa, l, h, n_) do { asm volatile("s_waitcnt lgkmcnt(" #n_ ")" ::: "memory"); SBAR();                                \
        o[d0] = __builtin_amdgcn_mfma_f32_32x32x16_bf16(pa, (bf16x8){l[0], l[1], l[2], l[3], h[0], h[1], h[2], h[3]}, o[d0], 0, 0, 0); SBAR(); } while (0)
    s16x4 l0, l1, l2, l3, h0, h1, h2, h3;
    PV_R(0, 0, l0, h0); PV_R(0, 1, l1, h1); PV_R(0, 2, l2, h2); PV_R(0, 3, l3, h3);
#define PV_G(d0) do { PV_M(d0, pa0, l0, h0, 6); PV_R(d0 + 1, 0, l0, h0); PV_M(d0, pa1, l1, h1, 6); PV_R(d0 + 1, 1, l1, h1);            \
                      PV_M(d0, pa2, l2, h2, 6); PV_R(d0 + 1, 2, l2, h2); PV_M(d0, pa3, l3, h3, 6); PV_R(d0 + 1, 3, l3, h3); } while (0)
    PV_G(0); PV_G(1); PV_G(2);
    PV_M(3, pa0, l0, h0, 6); PV_M(3, pa1, l1, h1, 4); PV_M(3, pa2, l2, h2, 2); PV_M(3, pa3, l3, h3, 0);
#undef PV_G
#undef PV_M
#undef PV_R
#undef TRRD
}

template <int KB>
__device__ __forceinline__ void qk_fin(f32x16& x0, f32x16& x1, f32x16& y0, f32x16& y1, float alY, float& l_reg, bf16x8& pa0, bf16x8& pa1, bf16x8& pa2, bf16x8& pa3,
                                       const char* K_lds, int r32, int hi, const bf16x8* qr) {
    x0 = f32x16{}; x1 = f32x16{};
    int kb[4];
#pragma unroll
    for (int dd = 0; dd < 4; ++dd) kb[dd] = (int)(uintptr_t)(K_lds + KSWZ(r32, (dd * 16 + hi * 8) * 2));
#define KRD(dst, d0_) do { asm volatile("ds_read_b128 %0, %1 offset:%2" : "=&v"(dst[0]) : "v"(kb[(d0_) & 3]), "i"(KB * SHM_K + ((d0_) >> 2) * 8192) : "memory");          \
                           asm volatile("ds_read_b128 %0, %1 offset:%2" : "=&v"(dst[1]) : "v"(kb[(d0_) & 3]), "i"(KB * SHM_K + ((d0_) >> 2) * 8192 + 32 * 128) : "memory"); } while (0)
#define KMM(f, d0_, n_) do { asm volatile("s_waitcnt lgkmcnt(" #n_ ")" ::: "memory"); SBAR();                                                              \
        x0 = __builtin_amdgcn_mfma_f32_32x32x16_bf16(f[0], qr[d0_], x0, 0, 0, 0); x1 = __builtin_amdgcn_mfma_f32_32x32x16_bf16(f[1], qr[d0_], x1, 0, 0, 0); SBAR(); } while (0)
#define EXPY(i) do { y1[2 * (i)] = __builtin_amdgcn_exp2f(y1[2 * (i)]); y1[2 * (i) + 1] = __builtin_amdgcn_exp2f(y1[2 * (i) + 1]); } while (0)
#define ADDY(Y, i) do { ps += Y[2 * (i)]; ps += Y[2 * (i) + 1]; } while (0)
#define CVA(P, B_) do { c0 = cvtpk(P[B_ + 0], P[B_ + 1]); c1 = cvtpk(P[B_ + 2], P[B_ + 3]); } while (0)
#define CVB(P, B_, OUT) do { const unsigned b0_ = cvtpk(P[B_ + 4], P[B_ + 5]), b1_ = cvtpk(P[B_ + 6], P[B_ + 7]);                                          \
        auto r0_ = __builtin_amdgcn_permlane32_swap(c0, b0_, false, false); auto r1_ = __builtin_amdgcn_permlane32_swap(c1, b1_, false, false);               \
        u32x4 w_ = {r0_[0], r1_[0], r0_[1], r1_[1]}; OUT = *reinterpret_cast<bf16x8*>(&w_); } while (0)
    bf16x8 fa[2], fb[2]; float ps = 0.f; unsigned c0, c1;
    KRD(fa, 0); KRD(fb, 1);
    KMM(fa, 0, 2); KRD(fa, 2); EXPY(0); ADDY(y0, 0); CVA(y0, 0); SBAR();
    KMM(fb, 1, 2); KRD(fb, 3); EXPY(1); ADDY(y0, 1); ADDY(y1, 0); CVB(y0, 0, pa0); SBAR();
    KMM(fa, 2, 2); KRD(fa, 4); EXPY(2); ADDY(y0, 2); ADDY(y1, 1); CVA(y0, 8); SBAR();
    KMM(fb, 3, 2); KRD(fb, 5); EXPY(3); ADDY(y0, 3); ADDY(y1, 2); CVB(y0, 8, pa1); SBAR();
    KMM(fa, 4, 2); KRD(fa, 6); EXPY(4); ADDY(y0, 4); ADDY(y1, 3); CVA(y1, 0); SBAR();
    KMM(fb, 5, 2); KRD(fb, 7); EXPY(5); ADDY(y0, 5); ADDY(y1, 4); CVB(y1, 0, pa2); SBAR();
    KMM(fa, 6, 2);             EXPY(6); ADDY(y0, 6); ADDY(y1, 5); CVA(y1, 8); SBAR();
    KMM(fb, 7, 0);             EXPY(7); ADDY(y0, 7); ADDY(y1, 6); SBAR();
    ADDY(y1, 7); CVB(y1, 8, pa3);
    { auto rr = __builtin_amdgcn_permlane32_swap(__float_as_uint(ps), __float_as_uint(ps), false, false); ps = __uint_as_float(rr[0]) + __uint_as_float(rr[1]); }
    l_reg = l_reg * alY + ps;
#undef KRD
#undef KMM
#undef EXPY
#undef ADDY
#undef CVA
#undef CVB
}
__device__ __forceinline__ void pv_par(f32x16* o, int vb0, bf16x8 pa0, bf16x8 pa1, bf16x8 pa2, bf16x8 pa3, f32x16& x0, f32x16& x1, float& m_reg, float& alpha, bool keep) {
#define TRRD(dst, off) asm volatile("ds_read_b64_tr_b16 %0, %1 offset:%2" : "=&v"(dst) : "v"(vb0), "i"(off) : "memory")
#define PV_R(d0, ks, l, h) do { TRRD(l, v_rd_off(d0, 0, 0) + (ks) * 4096); TRRD(h, v_rd_off(d0, 0, 0) + (ks) * 4096 + 2048); } while (0)
#define PV_M(d0, pa, l, h, n_) do { asm volatile("s_waitcnt lgkmcnt(" #n_ ")" ::: "memory"); SBAR();                                \
        o[d0] = __builtin_amdgcn_mfma_f32_32x32x16_bf16(pa, (bf16x8){l[0], l[1], l[2], l[3], h[0], h[1], h[2], h[3]}, o[d0], 0, 0, 0); SBAR(); } while (0)
#define MX8(t, X, b) do { t = fmaxf(fmaxf(X[b], X[b + 1]), X[b + 2]); t = fmaxf(fmaxf(t, X[b + 3]), X[b + 4]); t = fmaxf(fmaxf(t, X[b + 5]), X[b + 6]); t = fmaxf(t, X[b + 7]); } while (0)
#define FM4(j) do { x0[2 * (j)] = fmaf(x0[2 * (j)], C2, mnL); x0[2 * (j) + 1] = fmaf(x0[2 * (j) + 1], C2, mnL); x1[2 * (j)] = fmaf(x1[2 * (j)], C2, mnL); x1[2 * (j) + 1] = fmaf(x1[2 * (j) + 1], C2, mnL); } while (0)
#define EX0(e) x0[e] = __builtin_amdgcn_exp2f(x0[e])
    constexpr float C2 = 1.4426950408889634f * SCALE;
    s16x4 l0, l1, l2, l3, h0, h1, h2, h3; float t0, t1, t2, t3, pmax, mnL;
    PV_R(0, 0, l0, h0); PV_R(0, 1, l1, h1); PV_R(0, 2, l2, h2); PV_R(0, 3, l3, h3);
    PV_M(0, pa0, l0, h0, 6); PV_R(1, 0, l0, h0); MX8(t0, x0, 0); SBAR();
    PV_M(0, pa1, l1, h1, 6); PV_R(1, 1, l1, h1); MX8(t1, x0, 8); SBAR();
    PV_M(0, pa2, l2, h2, 6); PV_R(1, 2, l2, h2); MX8(t2, x1, 0); SBAR();
    PV_M(0, pa3, l3, h3, 6); PV_R(1, 3, l3, h3); MX8(t3, x1, 8); SBAR();
    PV_M(1, pa0, l0, h0, 6); PV_R(2, 0, l0, h0);
    { pmax = fmaxf(fmaxf(t0, t1), fmaxf(t2, t3)); auto rr = __builtin_amdgcn_permlane32_swap(__float_as_uint(pmax), __float_as_uint(pmax), false, false); pmax = fmaxf(__uint_as_float(rr[0]), __uint_as_float(rr[1])); pmax = keep ? pmax : -__builtin_inff(); } SBAR();
    PV_M(1, pa1, l1, h1, 6); PV_R(2, 1, l1, h1);
    { const bool ok = __all((pmax - m_reg) * SCALE <= THR) != 0;
      const float mn = ok ? m_reg : fmaxf(m_reg, pmax); alpha = __builtin_amdgcn_exp2f((m_reg - mn) * C2); m_reg = mn; mnL = keep ? -mn * C2 : -__builtin_inff(); } SBAR();
    PV_M(1, pa2, l2, h2, 6); PV_R(2, 2, l2, h2); FM4(0); SBAR();
    PV_M(1, pa3, l3, h3, 6); PV_R(2, 3, l3, h3); FM4(1); EX0(0); SBAR();
    PV_M(2, pa0, l0, h0, 6); PV_R(3, 0, l0, h0); FM4(2); EX0(1); SBAR();
    PV_M(2, pa1, l1, h1, 6); PV_R(3, 1, l1, h1); FM4(3); EX0(2); SBAR();
    PV_M(2, pa2, l2, h2, 6); PV_R(3, 2, l2, h2); FM4(4); EX0(3); SBAR();
    PV_M(2, pa3, l3, h3, 6); PV_R(3, 3, l3, h3); FM4(5); EX0(4); SBAR();
    PV_M(3, pa0, l0, h0, 6); FM4(6); EX0(5); SBAR();
    PV_M(3, pa1, l1, h1, 4); FM4(7); EX0(6); SBAR();
    PV_M(3, pa2, l2, h2, 2); EX0(7); EX0(8); EX0(9); SBAR();
    PV_M(3, pa3, l3, h3, 0); EX0(10); EX0(11); EX0(12); SBAR();
    EX0(13); EX0(14); EX0(15);
#undef TRRD
#undef PV_R
#undef PV_M
#undef MX8
#undef FM4
#undef EX0
}

struct BlockRef { int b, h, qb; };
struct Bases { const bf16* proj; bf16* mixed; float* ssq; const float* kpart; };
__device__ __forceinline__ const bf16* refQ(const Bases& B, const BlockRef& r) { return B.proj + ((size_t)(r.b * SEQ + r.qb * QB) * LDQ + r.h * D); }
__device__ __forceinline__ const bf16* refK(const Bases& B, const BlockRef& r) { return B.proj + (size_t)M_TOK * LDQ + ((size_t)(r.b * SEQ) * LDQ + r.h * D); }
__device__ __forceinline__ const bf16* refV(const Bases& B, const BlockRef& r) { return B.proj + (size_t)2 * M_TOK * LDQ + ((size_t)(r.b * SEQ) * LDQ + r.h * D); }
struct Seam { bf16x8 qr[8]; bf16x8 st_v0, st_v1, st_k0, st_k1; };

__device__ __forceinline__ void km_load(const float* kpart, int b, int h, int tid, f32x4& x, f32x4& y) {
    const int j = (tid >> 5) & 7, c = (tid & 31) * 4;
    const float* p = kpart + ((size_t)(b * 8 + j) * 1024 + h * D + c);
    x = *(const f32x4*)p; y = *(const f32x4*)(p + KPART_STRIDE);
}
__device__ __forceinline__ void km_write(char* lds, int tid, f32x4 x, f32x4 y) {
    const int j = (tid >> 5) & 7, c = (tid & 31) * 4; const f32x4 a = x + y;
    const unsigned h0 = cvtpk(a[0], a[1]), h1 = cvtpk(a[2], a[3]);
    const unsigned l0 = cvtpk(a[0] - __uint_as_float(h0 << 16), a[1] - __uint_as_float(h0 & 0xffff0000u)), l1 = cvtpk(a[2] - __uint_as_float(h1 << 16), a[3] - __uint_as_float(h1 & 0xffff0000u));
    typedef unsigned u32x2 __attribute__((ext_vector_type(2)));
    if (tid < 256) { *(u32x2*)(lds + KM_OFF + j * KM_PITCH + c * 2) = (u32x2){h0, h1}; *(u32x2*)(lds + KM_OFF + (8 + j) * KM_PITCH + c * 2) = (u32x2){l0, l1}; }
}
__device__ __forceinline__ unsigned moba_select(const bf16x8* qr, const char* lds, int own, int r32, int hi) {
    if (own == 0) return 0u;
    f32x16 g = f32x16{};
    const bool act = r32 < 16;
    const char* kmf = lds + KM_OFF + (r32 & 15) * KM_PITCH + hi * 16;
#pragma unroll
    for (int d0 = 0; d0 < 8; ++d0) {
        bf16x8 f = *(const bf16x8*)(kmf + d0 * 32);
        if (!act) f = (bf16x8){0, 0, 0, 0, 0, 0, 0, 0};
        g = __builtin_amdgcn_mfma_f32_32x32x16_bf16(f, qr[d0], g, 0, 0, 0);
    }
    float G[8];
#pragma unroll
    for (int i = 0; i < 4; ++i) { const float v = g[i] + g[4 + i];
        auto rr = __builtin_amdgcn_permlane32_swap(__float_as_uint(v), __float_as_uint(v), false, false);
        G[i] = __uint_as_float(rr[0]); G[4 + i] = __uint_as_float(rr[1]); }
    unsigned sel = 0u;
#pragma unroll
    for (int a = 0; a < 8; ++a) { int cnt = 0;
#pragma unroll
        for (int b = 0; b < 8; ++b) { if (b == a) continue;
            const bool beats = (b < a) ? (G[b] >= G[a]) : (G[b] > G[a]);
            cnt += (b < own && beats) ? 1 : 0; }
        sel |= (a < own && cnt < 3) ? (1u << a) : 0u; }
    return sel;
}

#define ROW(p, k0, rr) ((p) + (size_t)((k0) + (rr)) * LDQ + sc)
#define VMW() asm volatile("s_waitcnt vmcnt(0)" ::: "memory")
#define VMWN(n) asm volatile("s_waitcnt vmcnt(%0)" :: "i"(n) : "memory")
#define SLOAD_H(Kp, Vp, k0) do { S.st_v0 = load8(ROW(Vp, k0, sr)); S.st_v1 = load8(ROW(Vp, k0, 32 + sr));              \
                         S.st_k0 = load8(ROW(Kp, k0, sr)); S.st_k1 = load8(ROW(Kp, k0, 32 + sr)); } while (0)
#define SWRITE_HK(bf) do { *(bf16x8*)(K_lds + (bf) * SHM_K + kws) = S.st_k0; *(bf16x8*)(K_lds + (bf) * SHM_K + kws + 32 * 128) = S.st_k1; } while (0)
#define SWRITE_HV(bf) do { *(bf16x8*)(V_lds + (bf) * SHM_V + vst0) = S.st_v0; *(bf16x8*)(V_lds + (bf) * SHM_V + vst1) = S.st_v1; } while (0)
#define SWRITE_H(bf) do { SWRITE_HV(bf); SWRITE_HK(bf); } while (0)
__device__ __forceinline__ void moba_prime(const Bases& B, const BlockRef& cur, char* lds, Seam& S) {
    int tid_ = threadIdx.x; asm volatile("" : "+v"(tid_));
    const int tid = tid_, wid = __builtin_amdgcn_readfirstlane(tid >> 6), lane = tid & 63, r32 = lane & 31, hi = lane >> 5;
    const int sr = tid >> 4, sc = (tid & 15) * 8, kws = KSWZ(sr, sc * 2); char* K_lds = lds + NVB * SHM_V;
#pragma unroll
    for (int d0 = 0; d0 < 8; ++d0) S.qr[d0] = load8(refQ(B, cur) + (size_t)(wid * QBLK + r32) * LDQ + d0 * 16 + hi * 8);
    f32x4 kx, ky; km_load(B.kpart, cur.b, cur.h, tid, kx, ky);
    { const bf16* Kp = refK(B, cur); const bf16* Vp = refV(B, cur); SLOAD_H(Kp, Vp, 0); } VMW(); SWRITE_HK(0); km_write(lds, tid, kx, ky);
    __syncthreads();
}
template <bool ORDA> __device__ __forceinline__ void moba_block(const Bases& B, const BlockRef& cur, const BlockRef& nxt, char* lds, Seam& S) {
    int tid_ = threadIdx.x; asm volatile("" : "+v"(tid_));
    const int tid = tid_, wid = __builtin_amdgcn_readfirstlane(tid >> 6), lane = tid & 63, r32 = lane & 31, hi = lane >> 5;
    const int own = cur.qb, P0 = cur.qb * QB;
    const int NT = (P0 + QB) / KVBLK;
    const int qlo = P0 + wid * QBLK, qm = qlo + r32 - 4 * hi;
    char* V_lds = lds; char* K_lds = lds + NVB * SHM_V;
    float* ws = (float*)(lds + NVB * SHM_V + 2 * SHM_K) + wid * 64; float* li_l = ws, * al_l = ws + 32;
    float m_reg = -1e30f, l_reg = 0; f32x16 o[4] = {};
    const int sr = tid >> 4, sc = (tid & 15) * 8, vst0 = v_st(sr, sc), vst1 = v_st(32 + sr, sc), kws = KSWZ(sr, sc * 2);
    const int vb0 = (int)(uintptr_t)V_lds + v_rd_base(lane);
    const bf16* Kh = refK(B, cur); const bf16* Vh = refV(B, cur);
#define RESC(a) do { if (__any((a) < 1.f)) { if (hi == 0) al_l[r32] = (a); asm volatile("s_waitcnt lgkmcnt(0)" ::: "memory");              \
                     for (int d_ = 0; d_ < 4; ++d_) for (int r = 0; r < 16; ++r) o[d_][r] *= al_l[crow(r, hi)]; } } while (0)
#define KBASE(t) ((t) * KVBLK)
#define MASKT(P0_, P1_, t) do { const int kb_ = KBASE(t); const int jb_ = (t) >> 2;                                             \
        if (jb_ == own) { if (kb_ + KVBLK - 1 > qlo) mask_tile(P0_, P1_, qm - kb_); }                                          \
        else { const bool keep_ = ((selm >> jb_) & 1u) != 0u; if (!__all(keep_)) mask_all(P0_, P1_, keep_); } } while (0)
#define SEAM_K0() do { VMWN(8); SWRITE_HK(0); SBAR(); } while (0)
    f32x16 pA0, pA1, pB0, pB1; float mnA, mnB, alA, alB; bf16x8 pa0, pa1, pa2, pa3;
    SWRITE_HV(0); SBAR();
    if (NT > 1) { SLOAD_H(Kh, Vh, KBASE(1)); }
    SBAR();
    const unsigned selm = moba_select(S.qr, lds, own, r32, hi);
    SBAR(); qkt<0>(pA0, pA1, K_lds, r32, hi, S.qr);
    MASKT(pA0, pA1, 0); partialSM(pA0, pA1, m_reg, mnA, alA);
    if (NT > 1) { VMW(); SWRITE_H(1); }
    __syncthreads();
    int vp = 0;
#define HALF_STEP(PX0, PX1, alX, PY0, PY1, alY, t, KB, SB, CAUSAL) do {                                                       \
        const int vrd_ = vb0 + vp * SHM_V, vw_ = (vp == 0 ? 2 : vp - 1); const int jb_ = (t) >> 2;                            \
        SBAR(); qk_fin<KB>(PX0, PX1, PY0, PY1, alY, l_reg, pa0, pa1, pa2, pa3, K_lds, r32, hi, S.qr); SBAR();                 \
        if ((t) + 1 < NT) { SLOAD_H(Kh, Vh, KBASE((t) + 1)); SBAR(); }                                                        \
        if (CAUSAL) { mask_tile(PX0, PX1, qm - KBASE(t)); SBAR(); }           \
        const bool keep_ = (jb_ == own) || (((selm >> jb_) & 1u) != 0u);                                                      \
        pv_par(o, vrd_, pa0, pa1, pa2, pa3, PX0, PX1, m_reg, alX, keep_); SBAR();                                             \
        if ((t) + 1 < NT) { VMW(); SWRITE_HK(SB); *(bf16x8*)(V_lds + vw_ * SHM_V + vst0) = S.st_v0; *(bf16x8*)(V_lds + vw_ * SHM_V + vst1) = S.st_v1; } \
        RESC(alX); vp = (vp == 2 ? 0 : vp + 1); __syncthreads(); } while (0)
    int t = 1;
    for (; t + 1 < NT - 4; t += 2) {
        HALF_STEP(pB0, pB1, alB, pA0, pA1, alA, t, 1, 0, 0);
        HALF_STEP(pA0, pA1, alA, pB0, pB1, alB, t + 1, 0, 1, 0);
    }
    for (; t + 1 < NT; t += 2) {
        HALF_STEP(pB0, pB1, alB, pA0, pA1, alA, t, 1, 0, 1);
        HALF_STEP(pA0, pA1, alA, pB0, pB1, alB, t + 1, 0, 1, 1);
    }
    SBAR(); qkt_c<1>(pB0, pB1, K_lds, r32, hi, S.qr); SBAR();
    { const bf16* Kn = refK(B, nxt); const bf16* Vn = refV(B, nxt); SLOAD_H(Kn, Vn, 0); } SBAR();
#pragma unroll
    for (int d0 = 0; d0 < 8; ++d0) S.qr[d0] = load8(refQ(B, nxt) + (size_t)(wid * QBLK + r32) * LDQ + d0 * 16 + hi * 8);
    SBAR();
    finishSM(pA0, pA1, alA, l_reg, pa0, pa1, pa2, pa3); SBAR();
    pv_tile(o, vb0 + vp * SHM_V, pa0, pa1, pa2, pa3); vp = (vp == 2 ? 0 : vp + 1);
    MASKT(pB0, pB1, NT - 1); partialSM(pB0, pB1, m_reg, mnB, alB); __syncthreads(); RESC(alB);
    finishSM(pB0, pB1, alB, l_reg, pa0, pa1, pa2, pa3); SBAR(); pv_tile(o, vb0 + vp * SHM_V, pa0, pa1, pa2, pa3);
    SBAR(); SEAM_K0();
    if (hi == 0) li_l[r32] = l_reg; asm volatile("s_waitcnt lgkmcnt(0)" ::: "memory");
    int hi4 = 4 * hi; asm volatile("" : "+v"(hi4));
    float rli[16];
#pragma unroll
    for (int r = 0; r < 16; ++r) rli[r] = __builtin_amdgcn_rcpf(li_l[crow(r, 0) + hi4]);
    const size_t orow0 = (size_t)(cur.b * SEQ + P0 + wid * QBLK);
    unsigned char* Ob = (unsigned char*)B.mixed + orow0 * MIX_PITCH + cur.h * D; float* sqw = B.ssq + orow0 * 8 + cur.h;
    unsigned short* stg = (unsigned short*)(lds + LDS_BYTES) + wid * (QBLK * D);
#pragma unroll
    for (int r = 0; r < 16; ++r) { const int orow = crow(r, 0) + hi4;
#pragma unroll
        for (int d0 = 0; d0 < 4; ++d0) { const float v = o[d0][r] * rli[r]; stg[orow * D + d0 * 32 + r32] = (unsigned short)cvtpk(v, v); } }
    asm volatile("s_waitcnt lgkmcnt(0)" ::: "memory");
    int lrow = lane >> 4; asm volatile("" : "+v"(lrow));
    f32x4 kx, ky; km_load(B.kpart, nxt.b, nxt.h, tid, kx, ky);
#pragma unroll
    for (int i = 0; i < 8; ++i) { const int row = 4 * i + lrow, ch = lane & 15;
        const u32x4 w = *(const u32x4*)(stg + row * D + ch * 8);
        float a = 0.f; int q8[2] = {0, 0};
#pragma unroll
        for (int e = 0; e < 4; ++e) { const float lo = __uint_as_float(w[e] << 16), hi_ = __uint_as_float(w[e] & 0xffff0000u); a += lo * lo + hi_ * hi_;
            if (e & 1) q8[e >> 1] = __builtin_amdgcn_cvt_pk_fp8_f32(lo * AQ_SCALE, hi_ * AQ_SCALE, q8[e >> 1], true);
            else       q8[e >> 1] = __builtin_amdgcn_cvt_pk_fp8_f32(lo * AQ_SCALE, hi_ * AQ_SCALE, q8[e >> 1], false); }
        typedef int i32x2 __attribute__((ext_vector_type(2)));
        *(i32x2*)(Ob + (size_t)row * MIX_PITCH + ch * 8) = (i32x2){q8[0], q8[1]};
        a += __shfl_xor(a, 1); a += __shfl_xor(a, 2); a += __shfl_xor(a, 4); a += __shfl_xor(a, 8);
        if (ch == 0) sqw[row * 8] = a;
        SBAR(); }
    km_write(lds, tid, kx, ky);
    __syncthreads();
#undef RESC
#undef KBASE
#undef MASKT
#undef SEAM_K0
#undef HALF_STEP
}
#undef ROW
#undef VMW
#undef VMWN
#undef SLOAD_H
#undef SWRITE_HK
#undef SWRITE_HV
#undef SWRITE_H
#undef SBAR
#undef KSWZ
}

#ifndef PH_MASK
#define PH_MASK 0x7f
#endif
#ifndef DUP_MASK
#define DUP_MASK 0
#endif
#define NREP(k) (1 + ((DUP_MASK >> (k)) & 1))
constexpr int NWAVES = 8;
constexpr size_t MiB = 1u << 20;
constexpr size_t WS_CTL = 0, CTL_ZERO_BYTES = 1 * MiB;
constexpr size_t CTL_STATS1 = 0, CTL_STATS2 = 128 * 1024, CTL_C1 = 256 * 1024, CTL_C2 = 288 * 1024, CTL_BAR = 512 * 1024;
constexpr size_t WS_KPART = 1 * MiB;
constexpr size_t WS_SSQ = WS_KPART + 512 * 1024;
constexpr size_t WS_XS = 2 * MiB;
constexpr size_t WS_WIN = 4 * MiB;
constexpr size_t WS_WIN8 = 12 * MiB;
constexpr size_t WS_WO = 20 * MiB;
constexpr size_t WS_WUP = 28 * MiB;
constexpr size_t WS_WDN = 44 * MiB;
constexpr size_t WS_XB = 64 * MiB;
constexpr size_t WS_X8 = 128 * MiB;
constexpr size_t WS_PROJ = 160 * MiB;
constexpr size_t WS_R = 64 * MiB;
constexpr size_t WS_MIXED = 320 * MiB;
constexpr size_t WS_Z = 320 * MiB;
constexpr size_t WS_YB = 384 * MiB;
constexpr size_t WS_Y8 = 448 * MiB;
constexpr size_t WS_END = 480 * MiB;
constexpr size_t CTL_CNT = 768 * 1024, CTL_CNT_DUMMY = 832 * 1024;
constexpr size_t CTL_DUMMY = 640 * 1024;
constexpr int RING_BYTES = 131072, LDS_BYTES = 155648, MISC_OFF = LDS_BYTES - 64;

typedef unsigned short bf16;
typedef float f32x4 __attribute__((ext_vector_type(4)));
typedef unsigned v4u __attribute__((ext_vector_type(4)));
#define LAS __attribute__((address_space(3)))
#define LDS_WAIT() asm volatile("s_waitcnt lgkmcnt(0)" ::: "memory")
__device__ __forceinline__ unsigned pkbf(float lo, float hi) { unsigned r; asm volatile("v_cvt_pk_bf16_f32 %0, %1, %2" : "=v"(r) : "v"(lo), "v"(hi)); return r; }
__device__ __forceinline__ float wave_sum(float v) {
#pragma unroll
    for (int o = 1; o < 64; o <<= 1) v += __shfl_xor(v, o);
    return v;
}
__device__ __forceinline__ void p0_transpose_item(const float* W, int K, int N, bf16* WT, const float* gain, const float* bvec, float* c1, float* c2, LAS float* scr, int item, int lane, int pairgates = 0, int pitchB = 0, int boff = 0) {
    const int nblk = N / 64, kb = item / nblk, nb = item % nblk, k0 = 64 * kb, n0 = 64 * nb;
    const int nd0 = n0; (void)pairgates;
#pragma unroll
    for (int i = 0; i < 16; ++i) { const int kk = 4 * i + (lane >> 4), nn = 4 * (lane & 15);
        const f32x4 v = __builtin_nontemporal_load((const f32x4*)(W + (size_t)(k0 + kk) * N + n0 + nn));
        scr[kk * 65 + nn] = v[0]; scr[kk * 65 + nn + 1] = v[1]; scr[kk * 65 + nn + 2] = v[2]; scr[kk * 65 + nn + 3] = v[3]; }
    LDS_WAIT(); asm volatile("" ::: "memory");
    const int c = lane & 7;
    float gk[8], bk[8];
#pragma unroll
    for (int e = 0; e < 8; ++e) { gk[e] = gain ? gain[k0 + 8 * c + e] : 1.0f; bk[e] = bvec ? bvec[k0 + 8 * c + e] : 0.0f; }
#pragma unroll
    for (int j = 0; j < 8; ++j) { const int n = (lane >> 3) + 8 * j; const LAS float* s = scr + (8 * c) * 65 + n;
        float w[8];
#pragma unroll
        for (int e = 0; e < 8; ++e) w[e] = s[e * 65];
        v4u o; o.x = pkbf(w[0] * gk[0], w[1] * gk[1]); o.y = pkbf(w[2] * gk[2], w[3] * gk[3]); o.z = pkbf(w[4] * gk[4], w[5] * gk[5]); o.w = pkbf(w[6] * gk[6], w[7] * gk[7]);
        if (pitchB) *(v4u*)((unsigned char*)WT + (size_t)(nd0 + n) * pitchB + boff + 2 * (k0 + 8 * c)) = o; else *(v4u*)(WT + (size_t)(nd0 + n) * K + k0 + 8 * c) = o;
        if (c1) {
            float s1 = (__uint_as_float(o.x << 16) + __uint_as_float(o.x & 0xffff0000u)) + (__uint_as_float(o.y << 16) + __uint_as_float(o.y & 0xffff0000u))
                     + (__uint_as_float(o.z << 16) + __uint_as_float(o.z & 0xffff0000u)) + (__uint_as_float(o.w << 16) + __uint_as_float(o.w & 0xffff0000u));
            float s2 = 0.f;
#pragma unroll
            for (int e = 0; e < 8; ++e) s2 += w[e] * bk[e];
            s1 += __shfl_xor(s1, 1); s1 += __shfl_xor(s1, 2); s1 += __shfl_xor(s1, 4);
            s2 += __shfl_xor(s2, 1); s2 += __shfl_xor(s2, 2); s2 += __shfl_xor(s2, 4);
            if (c == 0) { (void)__hip_atomic_fetch_add(c1 + n0 + n, s1, __ATOMIC_RELAXED, __HIP_MEMORY_SCOPE_AGENT); (void)__hip_atomic_fetch_add(c2 + n0 + n, s2, __ATOMIC_RELAXED, __HIP_MEMORY_SCOPE_AGENT); }
        } }
    LDS_WAIT(); asm volatile("" ::: "memory");
}

#define XB_TMO      128
#define XB_XCNT(j)  (256  + 64 * (j))
#define XB_XSUB(j)  (1280 + 64 * (j))
#define XB_XGEN(j)  (2304 + 64 * (j))
#define XB_TOP      3328
#define XB_TOPGEN   3392
#define XCD_BAR_WORDS 3456
#define XB_SPIN_CAP (1u << 18)

__device__ __forceinline__ unsigned xb_ld(unsigned* p)              { return __hip_atomic_load(p, __ATOMIC_RELAXED, __HIP_MEMORY_SCOPE_AGENT); }
__device__ __forceinline__ unsigned xb_add(unsigned* p, unsigned v) { return __hip_atomic_fetch_add(p, v, __ATOMIC_RELAXED, __HIP_MEMORY_SCOPE_AGENT); }
__device__ __forceinline__ unsigned xb_xcc_id() { return (unsigned)__builtin_amdgcn_s_getreg((3 << 11) | 20) & 0xFu; }
#define XB_SPIN(cond, bar) do { unsigned _sp = 0; while (cond) { __builtin_amdgcn_s_sleep(1); \
    if ((++_sp & 255u) == 0u) { if (xb_ld(&(bar)[XB_TMO])) break; if (_sp > XB_SPIN_CAP) { atomicAdd(&(bar)[XB_TMO], 1u); break; } } } } while (0)

struct XcdBarrier {
    unsigned* bar; unsigned x;
    volatile LAS unsigned* st;
};

__device__ __forceinline__ XcdBarrier xcd_barrier_post(unsigned* bar, volatile LAS unsigned* st) {
    XcdBarrier b; b.bar = bar; b.x = xb_xcc_id(); b.st = st;
    if (threadIdx.x == 0) (void)xb_add(&bar[XB_XCNT(b.x)], 1u);
    return b;
}
__device__ __forceinline__ void xcd_barrier_complete(unsigned* bar, unsigned x, unsigned& nloc, unsigned& nx) {
    const unsigned G = gridDim.x * gridDim.y * gridDim.z;
    unsigned sum, cnt, mine, sp = 0u;
    for (;;) {
        sum = 0u; cnt = 0u; mine = 0u;
#pragma unroll
        for (unsigned j = 0; j < 16; ++j) { const unsigned c = xb_ld(&bar[XB_XCNT(j)]); sum += c; cnt += (c > 0u) ? 1u : 0u; mine = (j == x) ? c : mine; }
        if (sum == G) break;
        __builtin_amdgcn_s_sleep(1);
        if ((++sp & 255u) == 0u) { if (xb_ld(&bar[XB_TMO])) break; if (sp > XB_SPIN_CAP) { atomicAdd(&bar[XB_TMO], 1u); break; } }
    }
    nloc = mine > 0u ? mine : 1u; nx = cnt > 0u ? cnt : 1u;
}

__device__ __forceinline__ void xcd_barrier(const XcdBarrier& b) {
    asm volatile("s_waitcnt vmcnt(0)" ::: "memory");
    __syncthreads();
    if (threadIdx.x == 0) {
        unsigned* bar = b.bar;
        __builtin_amdgcn_s_waitcnt(0);
        unsigned nloc = b.st[0], nx = b.st[1];
        if (nloc == 0u) { xcd_barrier_complete(bar, b.x, nloc, nx); b.st[0] = nloc; b.st[1] = nx; }
        const unsigned old = xb_add(&bar[XB_XSUB(b.x)], 1u);
        const unsigned gen = old / nloc;
        if (old + 1u == (gen + 1u) * nloc) {
            __builtin_amdgcn_fence(__ATOMIC_RELEASE, "agent");
            asm volatile("s_waitcnt vmcnt(0)" ::: "memory");
            const unsigned og = xb_add(&bar[XB_TOP], 1u);
            const unsigned tg = og / nx;
            if (og + 1u == (tg + 1u) * nx) xb_add(&bar[XB_TOPGEN], 1u);
            else XB_SPIN(xb_ld(&bar[XB_TOPGEN]) == tg, bar);
            __builtin_amdgcn_fence(__ATOMIC_ACQUIRE, "agent");
            xb_add(&bar[XB_XGEN(b.x)], 1u);
            asm volatile("s_waitcnt vmcnt(0)" ::: "memory");
        } else {
            XB_SPIN(xb_ld(&bar[XB_XGEN(b.x)]) == gen, bar);
            __builtin_amdgcn_fence(__ATOMIC_ACQUIRE, "agent");
            asm volatile("s_waitcnt vmcnt(0)" ::: "memory");
        }
    }
    __syncthreads();
}

__device__ __forceinline__ void p0_transpose_item_i8(const float* W, int K, int N, unsigned char* WT, int nd0, const float* gain, const float* bvec, float* c1, float* c2, LAS float* scr, int item, int lane) {
    const int nblk = N / 64, kb = item / nblk, nb = item % nblk, k0 = 64 * kb, n0 = 64 * nb;
#pragma unroll
    for (int i = 0; i < 16; ++i) { const int kk = 4 * i + (lane >> 4), nn = 4 * (lane & 15);
        const f32x4 v = __builtin_nontemporal_load((const f32x4*)(W + (size_t)(k0 + kk) * N + n0 + nn));
        scr[kk * 65 + nn] = v[0]; scr[kk * 65 + nn + 1] = v[1]; scr[kk * 65 + nn + 2] = v[2]; scr[kk * 65 + nn + 3] = v[3]; }
    LDS_WAIT(); asm volatile("" ::: "memory");
    const int c = lane & 7;
    float gk[8], bk[8];
#pragma unroll
    for (int e = 0; e < 8; ++e) { gk[e] = (gain ? gain[k0 + 8 * c + e] : 1.0f) * WQ_SCALE; bk[e] = bvec ? bvec[k0 + 8 * c + e] : 0.0f; }
#pragma unroll
    for (int j = 0; j < 8; ++j) { const int n = (lane >> 3) + 8 * j; const LAS float* s = scr + (8 * c) * 65 + n;
        float w[8], s1 = 0.f, s2 = 0.f;
#pragma unroll
        for (int e = 0; e < 8; ++e) { w[e] = s[e * 65]; s2 += w[e] * bk[e]; w[e] = __builtin_rintf(__builtin_amdgcn_fmed3f(w[e] * gk[e], -127.f, 127.f)); s1 += w[e]; }
        typedef unsigned u32x2 __attribute__((ext_vector_type(2)));
        *(u32x2*)(WT + (size_t)(nd0 + n) * K + k0 + 8 * c) = (u32x2){pg8::pack_i8x4((f32x4){w[0], w[1], w[2], w[3]}), pg8::pack_i8x4((f32x4){w[4], w[5], w[6], w[7]})};
        if (c1) { s1 *= WQ_INV;
            s1 += __shfl_xor(s1, 1); s1 += __shfl_xor(s1, 2); s1 += __shfl_xor(s1, 4);
            s2 += __shfl_xor(s2, 1); s2 += __shfl_xor(s2, 2); s2 += __shfl_xor(s2, 4);
            if (c == 0) { (void)__hip_atomic_fetch_add(c1 + n0 + n, s1, __ATOMIC_RELAXED, __HIP_MEMORY_SCOPE_AGENT); (void)__hip_atomic_fetch_add(c2 + n0 + n, s2, __ATOMIC_RELAXED, __HIP_MEMORY_SCOPE_AGENT); } } }
    LDS_WAIT(); asm volatile("" ::: "memory");
}

__device__ __forceinline__ void p0_transpose_item_fp8(const float* W, int K, int N, unsigned char* WT, float scale, LAS float* scr, int item, int lane, const float* gain = nullptr, int pitchB = 0) {
    const int nblk = N / 64, kb = item / nblk, nb = item % nblk, k0 = 64 * kb, n0 = 64 * nb;
#pragma unroll
    for (int i = 0; i < 16; ++i) { const int kk = 4 * i + (lane >> 4), nn = 4 * (lane & 15);
        const f32x4 v = __builtin_nontemporal_load((const f32x4*)(W + (size_t)(k0 + kk) * N + n0 + nn));
        scr[kk * 65 + nn] = v[0]; scr[kk * 65 + nn + 1] = v[1]; scr[kk * 65 + nn + 2] = v[2]; scr[kk * 65 + nn + 3] = v[3]; }
    LDS_WAIT(); asm volatile("" ::: "memory");
    const int c = lane & 7;
#pragma unroll
    for (int j = 0; j < 8; ++j) { const int n = (lane >> 3) + 8 * j; const LAS float* s = scr + (8 * c) * 65 + n;
        float w[8];
#pragma unroll
        for (int e = 0; e < 8; ++e) w[e] = s[e * 65] * (gain ? gain[k0 + 8 * c + e] * scale : scale);
        int w0 = __builtin_amdgcn_cvt_pk_fp8_f32(w[0], w[1], 0, false); w0 = __builtin_amdgcn_cvt_pk_fp8_f32(w[2], w[3], w0, true);
        int w1 = __builtin_amdgcn_cvt_pk_fp8_f32(w[4], w[5], 0, false); w1 = __builtin_amdgcn_cvt_pk_fp8_f32(w[6], w[7], w1, true);
        typedef int i32x2 __attribute__((ext_vector_type(2)));
        *(i32x2*)(WT + (size_t)(n0 + n) * (pitchB ? pitchB : K) + k0 + 8 * c) = (i32x2){w0, w1}; }
    LDS_WAIT(); asm volatile("" ::: "memory");
}

__device__ __forceinline__ void p0_prologue(const float* x, const float* w_in, const float* w_o, const float* w_up, const float* w_down, const float* attn_g, const float* conv_g, const float* ln1_g, const float* ln1_b,
        bf16* WinT, unsigned char* Win8, bf16* WoT, unsigned char* Wup8, bf16* WdnT, bf16* XB, unsigned char* X8, float* xs, float* c1, float* c2, unsigned char* lds, int wave, int lane, int tid, int gw, int NGW, int G, int bx) {
        for (int row = gw; row < M_TOK; row += NGW) {
            f32x4 v[4][2]; float mx = 0.f;
#pragma unroll
            for (int j = 0; j < 4; ++j) { const float* p = x + (size_t)row * DM + (j * 64 + lane) * 8;
                v[j][0] = __builtin_nontemporal_load((const f32x4*)p); v[j][1] = __builtin_nontemporal_load((const f32x4*)(p + 4)); }
#pragma unroll
            for (int j = 0; j < 4; ++j)
#pragma unroll
                for (int h = 0; h < 2; ++h)
#pragma unroll
                    for (int e = 0; e < 4; ++e) mx = fmaxf(mx, fabsf(v[j][h][e]));
#pragma unroll
            for (int o = 1; o < 64; o <<= 1) mx = fmaxf(mx, __shfl_xor(mx, o));
            mx = fmaxf(mx, 1e-30f);
            const float inv = 127.0f / mx;
            if (lane == 0) xs[row] = mx * (1.0f / 127.0f);
#pragma unroll
            for (int j = 0; j < 4; ++j) { const size_t off = (size_t)row * DM + (j * 64 + lane) * 8;
                v4u o; o.x = pkbf(v[j][0][0], v[j][0][1]); o.y = pkbf(v[j][0][2], v[j][0][3]); o.z = pkbf(v[j][1][0], v[j][1][1]); o.w = pkbf(v[j][1][2], v[j][1][3]);
                *(v4u*)(XB + off) = o;
                typedef unsigned u32x2 __attribute__((ext_vector_type(2)));
                *(u32x2*)(X8 + off) = (u32x2){pg8::pack_i8x4(v[j][0] * inv), pg8::pack_i8x4(v[j][1] * inv)}; }
        }
        LAS float* scr = (LAS float*)((LAS unsigned char*)lds + wave * 16640);
        constexpr int I_IN = (DM / 64) * (NPROJ / 64), I_O = (DM / 64) * (DM / 64), I_UP = (DM / 64) * (FF / 64), I_DN = (FF / 64) * (DM / 64);
        constexpr int NITEMS = I_IN + I_O + I_UP + I_DN;
        for (int it = gw; it < NITEMS; it += NGW) {
            int r = it;
            if (r < I_UP) { const int nb = r % (FF / 64); p0_transpose_item_i8(w_up, DM, FF, Wup8, 64 * nb, ln1_g, ln1_b, c1, c2, scr, r, lane); continue; } r -= I_UP;
            if (r < I_IN) { const int n0 = 64 * (r % (NPROJ / 64));
                if (n0 < 2048) p0_transpose_item(w_in, DM, NPROJ, WinT, nullptr, nullptr, nullptr, nullptr, scr, r, lane);
                else { int nd0;
                    if (n0 < 4096) nd0 = n0 - 2048; else { const int isu = n0 >= 5120, ch = n0 - (isu ? 5120 : 4096); nd0 = 2048 + (ch >> 7) * 256 + isu * 128 + (ch & 127); }
                    p0_transpose_item_i8(w_in, DM, NPROJ, Win8, nd0, nullptr, nullptr, nullptr, nullptr, scr, r, lane); }
                continue; } r -= I_IN;
            if (r < I_O) { const int kb = r / (DM / 64);
                if (kb < 16) p0_transpose_item_fp8(w_o, DM, DM, (unsigned char*)WoT, WOA_SCALE, scr, r, lane, attn_g, MIX_PITCH);
                else p0_transpose_item(w_o, DM, DM, WoT, conv_g - AW, nullptr, nullptr, nullptr, scr, r, lane, 0, MIX_PITCH, -1024);
                continue; } r -= I_O;
            p0_transpose_item_fp8(w_down, FF, DM, (unsigned char*)WdnT, WDN_SCALE, scr, r, lane);
        }
}

__device__ __forceinline__ void conv_pass(const bf16* PROJ, bf16* MIXED, const float* conv_w, int vcu, int G) {
    int tid_ = threadIdx.x; asm volatile("" : "+v"(tid_));
    const int lane = tid_ & 63, gw = vcu * NWAVES + __builtin_amdgcn_readfirstlane(tid_ >> 6), NGW = G * NWAVES;
        const bf16* Bg = PROJ + (size_t)3 * M_TOK * 1024; const bf16* Zg = PROJ + (size_t)4 * M_TOK * 1024;
        for (int ch = gw; ch < M_TOK / 8; ch += NGW) {
            const int r0 = ch * 8;
            float w0[16], w1[16], w2[16], z1[16], z2[16];
#pragma unroll
            for (int hh = 0; hh < 2; ++hh)
#pragma unroll
                for (int e = 0; e < 8; ++e) { const int cc = hh * 512 + lane * 8 + e; w0[hh * 8 + e] = conv_w[cc]; w1[hh * 8 + e] = conv_w[1024 + cc]; w2[hh * 8 + e] = conv_w[2048 + cc]; z1[hh * 8 + e] = 0.f; z2[hh * 8 + e] = 0.f; }
            auto ldz = [&](int row, float* z) {
#pragma unroll
                for (int hh = 0; hh < 2; ++hh) { const v4u zv = __builtin_nontemporal_load((const v4u*)(Zg + (size_t)row * 1024 + hh * 512 + lane * 8));
#pragma unroll
                    for (int e = 0; e < 4; ++e) { z[hh * 8 + 2 * e] = __uint_as_float(zv[e] << 16); z[hh * 8 + 2 * e + 1] = __uint_as_float(zv[e] & 0xffff0000u); } } };
            if ((r0 & (SEQ - 1)) != 0) { ldz(r0 - 1, z1); ldz(r0 - 2, z2); }
            for (int i = 0; i < 8; ++i) { const int row = r0 + i;
                float z0[16], y[16]; ldz(row, z0);
                float ss = 0.f;
#pragma unroll
                for (int hh = 0; hh < 2; ++hh) { const v4u bv = __builtin_nontemporal_load((const v4u*)(Bg + (size_t)row * 1024 + hh * 512 + lane * 8));
#pragma unroll
                    for (int e = 0; e < 8; ++e) { const int k = hh * 8 + e; const float bb = (e & 1) ? __uint_as_float(bv[e >> 1] & 0xffff0000u) : __uint_as_float(bv[e >> 1] << 16);
                        y[k] = bb * (w0[k] * z2[k] + w1[k] * z1[k] + w2[k] * z0[k]); ss += y[k] * y[k]; } }
                const float rs = __builtin_amdgcn_rsqf(wave_sum(ss) * (1.0f / 1024.0f) + RMS_EPS);
#pragma unroll
                for (int hh = 0; hh < 2; ++hh) { v4u o;
#pragma unroll
                    for (int e = 0; e < 4; ++e) o[e] = pkbf(y[hh * 8 + 2 * e] * rs, y[hh * 8 + 2 * e + 1] * rs);
                    *(v4u*)((bf16*)((unsigned char*)MIXED + (size_t)row * MIX_PITCH + 1024) + hh * 512 + lane * 8) = o; }
#pragma unroll
                for (int k = 0; k < 16; ++k) { z2[k] = z1[k]; z1[k] = z0[k]; } }
        }
}

struct Args { const float* in[12]; float* out; unsigned char* ws; };

__global__ void __launch_bounds__(NWAVES * 64, 2) hymba_fwd(Args args) {
    extern __shared__ __attribute__((aligned(16))) unsigned char lds[];
    const int tid = threadIdx.x, lane = tid & 63, wave = __builtin_amdgcn_readfirstlane(tid >> 6);
    const int G = gridDim.x, bx = blockIdx.x;
    const int vcu = (G % 8 == 0) ? (bx % 8) * (G / 8) + bx / 8 : bx;
    const int gw = vcu * NWAVES + wave, NGW = G * NWAVES;
    unsigned char* ws = args.ws;
    const float* x = args.in[0]; const float* w_in = args.in[1]; const float* conv_w = args.in[2]; const float* attn_g = args.in[3]; const float* conv_g = args.in[4];
    const float* w_o = args.in[5]; const float* ln1_g = args.in[6]; const float* ln1_b = args.in[7]; const float* w_up = args.in[8]; const float* w_down = args.in[9];
    const float* ln2_g = args.in[10]; const float* ln2_b = args.in[11];
    float* stats1 = (float*)(ws + WS_CTL + CTL_STATS1); float* stats2 = (float*)(ws + WS_CTL + CTL_STATS2);
    float* c1 = (float*)(ws + WS_CTL + CTL_C1); float* c2 = (float*)(ws + WS_CTL + CTL_C2);
    float* dummy = (float*)(ws + WS_CTL + CTL_DUMMY);
    float* kpart = (float*)(ws + WS_KPART); float* ssq = (float*)(ws + WS_SSQ);
    bf16* WinT = (bf16*)(ws + WS_WIN); unsigned char* Win8 = ws + WS_WIN8; bf16* WoT = (bf16*)(ws + WS_WO); unsigned char* Wup8 = ws + WS_WUP; bf16* WdnT = (bf16*)(ws + WS_WDN); float* xs = (float*)(ws + WS_XS);
    bf16* XB = (bf16*)(ws + WS_XB); bf16* PROJ = (bf16*)(ws + WS_PROJ); bf16* RB = (bf16*)(ws + WS_R); bf16* MIXED = (bf16*)(ws + WS_MIXED); bf16* YB = (bf16*)(ws + WS_YB); unsigned char* Y8 = ws + WS_Y8; unsigned char* X8 = ws + WS_X8;
    PG8_LAS unsigned char* ldsp = (PG8_LAS unsigned char*)lds;
    volatile LAS unsigned* MISC = (volatile LAS unsigned*)((LAS unsigned char*)lds + MISC_OFF);
    if (tid < 16) MISC[tid] = 0u;
    __syncthreads();
    const XcdBarrier bar = xcd_barrier_post((unsigned*)(ws + WS_CTL + CTL_BAR), MISC + 8);
#define GRID_SYNC() xcd_barrier(bar)

    for (int rep = 0; rep < NREP(0) && (PH_MASK & 1); ++rep) { if (rep) GRID_SYNC();
        p0_prologue(x, w_in, w_o, w_up, w_down, attn_g, conv_g, ln1_g, ln1_b, WinT, Win8, WoT, Wup8, WdnT, XB, X8, xs, rep ? dummy : c1, rep ? dummy + 8192 : c2, lds, wave, lane, tid, gw, NGW, G, bx);
    }
    GRID_SYNC();

    for (int rep = 0; rep < NREP(1) && (PH_MASK & 2); ++rep) { if (rep) GRID_SYNC();
        { pg8::Gemm g{XB, WinT, M_TOK, 2048, DM}; pg8::StaticOrder S; S.init(M_TOK, 2048, G, bx);
          pg8::EpiProj E{PROJ, kpart};
          pg8::gemm_phase<pg8::EpiProj, pg8::StaticOrder, true, true>(ldsp, g, S, E); }
        { pg8::Gemm g{(const bf16*)X8, (const bf16*)Win8, M_TOK, 4096, DM / 2}; pg8::StaticOrder S; S.init(M_TOK, 4096, G, bx);
          pg8::EpiProjI8 E{PROJ, xs};
          pg8::gemm_phase<pg8::EpiProjI8, pg8::StaticOrder, true, true, 3>(ldsp, g, S, E); }
    }
    GRID_SYNC();

    for (int rep = 0; rep < NREP(2) && (PH_MASK & 4); ++rep) { if (rep) GRID_SYNC();
        if (vcu & 1) conv_pass(PROJ, MIXED, conv_w, vcu, G);
        att::Seam S; const att::Bases AB{PROJ, MIXED, ssq, kpart};
        int L = vcu, pass = 0;
        if (L < 256) {
            att::BlockRef cur{L >> 5, (L >> 2) & 7, L & 3};
            att::moba_prime(AB, cur, (char*)lds, S);
            for (;;) {
                const bool more_pass = pass == 0, more_item = L + G < 256, last = !more_pass && !more_item;
                int passn = pass + 1, Ln = L; if (!more_pass) { passn = 0; Ln = more_item ? L + G : L; }
                att::BlockRef nxt{Ln >> 5, (Ln >> 2) & 7, passn ? 7 - (Ln & 3) : (Ln & 3)}; if (last) nxt = cur;
                att::moba_block<true>(AB, cur, nxt, (char*)lds, S);
                if (last) break;
                cur = nxt; pass = passn; L = Ln;
            }
        }
        asm volatile("s_waitcnt vmcnt(0)" ::: "memory");
        if (!(vcu & 1)) conv_pass(PROJ, MIXED, conv_w, vcu, G);
    }
    GRID_SYNC();

    for (int rep = 0; rep < NREP(3) && (PH_MASK & 8); ++rep) { if (rep) GRID_SYNC();
        pg8::Gemm g{MIXED, WoT, M_TOK, DM, MIX_PITCH / 2}; pg8::StaticOrder S; S.init(M_TOK, DM, G, bx);
        pg8::EpiWo E{XB, YB, Y8, rep ? dummy : stats1, ssq};
        pg8::gemm_phase<pg8::EpiWo, pg8::StaticOrder, true, true, 6>(ldsp, g, S, E);
    }
    GRID_SYNC();

    for (int rep = 0; rep < NREP(4) && (PH_MASK & 16); ++rep) { if (rep) GRID_SYNC();
        pg8::Gemm g{(const bf16*)Y8, (const bf16*)Wup8, M_TOK, FF, DM / 2}; pg8::StaticOrder S; S.init(M_TOK, FF, G, bx);
        pg8::EpiUp E{stats1, c1, c2, (unsigned char*)RB};
        pg8::gemm_phase<pg8::EpiUp, pg8::StaticOrder, true, true, 3>(ldsp, g, S, E);
    }
    GRID_SYNC();

    for (int rep = 0; rep < NREP(5) && (PH_MASK & 32); ++rep) { if (rep) GRID_SYNC();
        pg8::Gemm g{RB, WdnT, M_TOK, DM, FF / 2}; pg8::PanelOrder S; S.init(M_TOK, DM, G, bx);
        pg8::EpiDownLN E{Y8, stats1, ln1_g, ln1_b, rep ? dummy : stats2, (unsigned*)(ws + WS_CTL + (rep ? CTL_CNT_DUMMY : CTL_CNT)), ln2_g, ln2_b, args.out};
        pg8::gemm_phase<pg8::EpiDownLN, pg8::PanelOrder, true, true, 2>(ldsp, g, S, E);
    }

    for (int xs = 0; xs < ((DUP_MASK >> 8) & 0xff); ++xs) GRID_SYNC();
    if ((DUP_MASK >> 7) & 1) { GRID_SYNC(); p0_prologue(x, w_in, w_o, w_up, w_down, attn_g, conv_g, ln1_g, ln1_b, WinT, Win8, WoT, Wup8, WdnT, XB, X8, xs, dummy, dummy + 8192, lds, wave, lane, tid, gw, NGW, G, bx); }
}

extern "C" void kernel_launch(void* const* d_in, const int* in_sizes, int n_in, void* d_out, int out_size, void* d_ws, size_t ws_size, hipStream_t stream) {
    static int grid = 0;
    if (grid == 0) {
        if (n_in != 12 || in_sizes[0] != M_TOK * DM || out_size != M_TOK * DM || ws_size < WS_END) {
            fprintf(stderr, "kernel_launch: shape/workspace mismatch (n_in %d, in0 %d, out %d, ws %zu; need ws >= %zu); nothing launched\n", n_in, n_in > 0 ? in_sizes[0] : -1, out_size, ws_size, (size_t)WS_END); grid = -1; return; }
        int dev = 0, cus = 0, per_cu = 0;
        if (hipGetDevice(&dev) != hipSuccess || hipDeviceGetAttribute(&cus, hipDeviceAttributeMultiprocessorCount, dev) != hipSuccess) { fprintf(stderr, "kernel_launch: device query failed\n"); grid = -1; return; }
        if (hipFuncSetAttribute((const void*)hymba_fwd, hipFuncAttributeMaxDynamicSharedMemorySize, LDS_BYTES) != hipSuccess) { fprintf(stderr, "kernel_launch: hipFuncSetAttribute failed\n"); grid = -1; return; }
        if (hipOccupancyMaxActiveBlocksPerMultiprocessor(&per_cu, (const void*)hymba_fwd, NWAVES * 64, LDS_BYTES) != hipSuccess || per_cu < 1) { fprintf(stderr, "kernel_launch: occupancy query says %d blocks per CU\n", per_cu); grid = -1; (void)hipGetLastError(); return; }
        grid = cus;
        if (grid > 256) grid = 256;
    }
    if (grid < 0) return;
    (void)hipMemsetAsync((char*)d_ws + WS_CTL, 0, CTL_ZERO_BYTES, stream);
    Args a{};
    for (int i = 0; i < 12; ++i) a.in[i] = (const float*)d_in[i];
    a.out = (float*)d_out; a.ws = (unsigned char*)d_ws;
    void* kargs[] = {&a};
    hipError_t e = hipLaunchCooperativeKernel((const void*)hymba_fwd, dim3(grid), dim3(NWAVES * 64), kargs, LDS_BYTES, stream);
    if (e != hipSuccess) fprintf(stderr, "kernel_launch: cooperative launch failed: %s (grid %d)\n", hipGetErrorString(e), grid);
}
```

```cpp
#include <hip/hip_runtime.h>
#include <hip/hip_cooperative_groups.h>
#include <cstdio>
#include <cstdint>
namespace cg = cooperative_groups;

constexpr int M_TOK = 16384, DM = 2048, SEQ = 2048, NBATCH = 8, AW = 1024, NPROJ = 6144, FF = 8192, NHEAD = 8, HD = 128, NBLK = 8;
constexpr float LN_EPS = 1e-5f, RMS_EPS = 1e-6f, ALPHA = 1.189207115002721f;
constexpr float WQ_SCALE = 1536.f, WQ_INV = 1.0f / 1536.f;
constexpr float AQ_SCALE = 16.f, WOA_SCALE = 512.f, P3_ATT_INV = 1.0f / (16.f * 512.f);
constexpr int MIX_PITCH = 3072;
constexpr float YQ_SCALE = 24.f, YQ_INV = 1.0f / 24.f;
constexpr float WDN_SCALE = 1024.f, WDN_INV_SCALE = 1.0f / 1024.f;

namespace pg8 {
#define PG8_LAS __attribute__((address_space(3)))
typedef unsigned short bf16_t;
typedef short bf16x8 __attribute__((ext_vector_type(8)));
typedef float f32x4 __attribute__((ext_vector_type(4)));
typedef unsigned u32x4 __attribute__((ext_vector_type(4)));
typedef int v4i_t __attribute__((ext_vector_type(4)));
constexpr int BM = 256, BK = 64, HALF = 128, HTB = HALF * BK * 2  , STAGE_BYTES = 8 * HTB, NXCD = 8, WGM = 8;

__host__ __device__ __forceinline__ int lds_byte(int r, int c) { const int st = (r >> 4) * 2 + (c >> 5), rr = r & 15, cc = c & 31, ob = rr * 64 + cc * 2; return st * 1024 + (ob ^ (((ob >> 9) & 1) << 5)); }
__host__ __device__ __forceinline__ void stage_rc(int b, int& R, int& C) { const int st = b / 1024, sb = b % 1024, swz = sb ^ (((sb >> 9) & 1) << 5); R = (st >> 1) * 16 + swz / 64; C = (st & 1) * 32 + (swz % 64) / 2; }
__host__ __device__ __forceinline__ int perm32(int rho) { const int n = rho >> 4, i = rho & 15; return 8 * (i >> 2) + 4 * n + (i & 3); }

struct Unit { int pm, pn; };
struct Gemm { const bf16_t* A; const bf16_t* Bt; int M, N, K; };

struct StaticOrder {
    int nM, nN, nwg, G, c;
    __host__ __device__ void init(int M, int N, int G_, int c_) { nM = M / BM; nN = N / BM; nwg = nM * nN; G = G_; c = c_; }
    __host__ __device__ bool next(int i, Unit& u) const {
        const long L = (long)i * G + c; if (L >= nwg) return false;
        int wgid = (int)L; { const int q = nwg / NXCD, r = nwg % NXCD, xcd = wgid % NXCD, off = wgid / NXCD; wgid = (xcd < r ? xcd * (q + 1) : r * (q + 1) + (xcd - r) * q) + off; }
        const int nig = WGM * nN, gid = wgid / nig, fm = gid * WGM, gsz = (nM - fm) < WGM ? (nM - fm) : WGM;
        u.pm = fm + ((wgid % nig) % gsz); u.pn = (wgid % nig) / gsz; return true;
    }
    __device__ __forceinline__ void a_ready(const Unit&) const {}
    __device__ __forceinline__ void done(const Unit&) const {}
};
__device__ __forceinline__ unsigned cvt_pk_bf16(float lo, float hi) { unsigned r; asm volatile("v_cvt_pk_bf16_f32 %0, %1, %2" : "=v"(r) : "v"(lo), "v"(hi)); return r; }
__device__ __forceinline__ float bf_lo(unsigned w) { return __uint_as_float(w << 16); }
__device__ __forceinline__ float bf_hi(unsigned w) { return __uint_as_float(w & 0xffff0000u); }
__device__ __forceinline__ float hsum4(f32x4 v) { return (v[0] + v[1]) + (v[2] + v[3]); }
__device__ __forceinline__ float hsq4(f32x4 v) { return (v[0] * v[0] + v[1] * v[1]) + (v[2] * v[2] + v[3] * v[3]); }
__device__ __forceinline__ unsigned pack_i8x4(f32x4 v) {
    const unsigned u0 = __float_as_uint(__builtin_amdgcn_fmed3f(v[0], -127.f, 127.f) + 12582912.f), u1 = __float_as_uint(__builtin_amdgcn_fmed3f(v[1], -127.f, 127.f) + 12582912.f);
    const unsigned u2 = __float_as_uint(__builtin_amdgcn_fmed3f(v[2], -127.f, 127.f) + 12582912.f), u3 = __float_as_uint(__builtin_amdgcn_fmed3f(v[3], -127.f, 127.f) + 12582912.f);
    const unsigned w01 = __builtin_amdgcn_perm(u1, u0, 0x0c0c0400u), w23 = __builtin_amdgcn_perm(u3, u2, 0x0c0c0400u);
    return __builtin_amdgcn_perm(w23, w01, 0x05040100u);
}
__device__ __forceinline__ f32x4 i32_to_f32(f32x4 a) { return __builtin_convertvector(__builtin_bit_cast(v4i_t, a), f32x4); }
__device__ __forceinline__ void atomic_addf(float* p, float v) { (void)__hip_atomic_fetch_add(p, v, __ATOMIC_RELAXED, __HIP_MEMORY_SCOPE_AGENT); }

struct EpiProj {
    static constexpr int NS = 0; static constexpr bool STAGED = false, PERM = true, AFTER_DRAIN = false, MID = false; static constexpr int MID_T = 0;
    bf16_t* O; float* kpart;
    __device__ __forceinline__ void mid(f32x4 (&)[2][2][4][2], PG8_LAS unsigned char*, int, int) const {}
    __device__ __forceinline__ void operator()(const f32x4 (&acc)[2][2][4][2], const Unit& u, int wr, int wc, int fr, int fq) const {
        const int t = u.pn >> 2, colt = (u.pn & 3) * BM;
        const int row0 = u.pm * BM + wr * 64 + fr;
        bf16_t* base = O + (size_t)t * ((size_t)M_TOK * 1024);
        const int col0 = colt + wc * 32 + 8 * fq;
#pragma unroll
        for (int ai = 0; ai < 2; ++ai)
#pragma unroll
            for (int m = 0; m < 4; ++m) { bf16_t* rowp = base + (size_t)(row0 + ai * HALF + m * 16) * 1024 + col0;
#pragma unroll
                for (int bj = 0; bj < 2; ++bj) { const f32x4 v0 = acc[ai][bj][m][0], v1 = acc[ai][bj][m][1];
                    u32x4 w; w.x = cvt_pk_bf16(v0[0], v0[1]); w.y = cvt_pk_bf16(v0[2], v0[3]); w.z = cvt_pk_bf16(v1[0], v1[1]); w.w = cvt_pk_bf16(v1[2], v1[3]);
                    *(u32x4*)(rowp + bj * HALF) = w; } }
        if (t == 1) {
#pragma unroll
            for (int bj = 0; bj < 2; ++bj)
#pragma unroll
                for (int n = 0; n < 2; ++n) { f32x4 s = (f32x4){0.f, 0.f, 0.f, 0.f};
#pragma unroll
                    for (int ai = 0; ai < 2; ++ai)
#pragma unroll
                        for (int m = 0; m < 4; ++m) s += acc[ai][bj][m][n];
#pragma unroll
                    for (int o = 1; o < 16; o <<= 1) { s[0] += __shfl_xor(s[0], o); s[1] += __shfl_xor(s[1], o); s[2] += __shfl_xor(s[2], o); s[3] += __shfl_xor(s[3], o); }
                    if (fr == 0) *(f32x4*)(kpart + ((size_t)wr * 64 + u.pm) * 1024 + col0 + bj * HALF + 4 * n) = s; }
        }
    }
};

struct EpiProjI8 {
    static constexpr int NS = 0; static constexpr bool STAGED = false, PERM = true, AFTER_DRAIN = false, MID = false, LDSX = false; static constexpr int MID_T = 0;
    bf16_t* O; const float* xs;
    __device__ __forceinline__ void mid(f32x4 (&)[2][2][4][2], PG8_LAS unsigned char*, int, int) const {}
    __device__ __forceinline__ void operator()(const f32x4 (&acc)[2][2][4][2], const Unit& u, int wr, int wc, int fr, int fq) const {
        const int row0 = u.pm * BM + wr * 64 + fr;
        float sc[2][4];
#pragma unroll
        for (int ai = 0; ai < 2; ++ai)
#pragma unroll
            for (int m = 0; m < 4; ++m) sc[ai][m] = xs[row0 + ai * HALF + m * 16] * WQ_INV;
        if (u.pn >= 8) {
            bf16_t* zb = O + (size_t)4 * ((size_t)M_TOK * 1024); const int ch0 = (u.pn - 8) * HALF + wc * 32 + 8 * fq;
#pragma unroll
            for (int ai = 0; ai < 2; ++ai)
#pragma unroll
                for (int m = 0; m < 4; ++m) { const float s2 = sc[ai][m] * sc[ai][m];
                    const f32x4 v0 = i32_to_f32(acc[ai][0][m][0]) * i32_to_f32(acc[ai][1][m][0]) * s2, v1 = i32_to_f32(acc[ai][0][m][1]) * i32_to_f32(acc[ai][1][m][1]) * s2;
                    u32x4 w; w.x = cvt_pk_bf16(v0[0], v0[1]); w.y = cvt_pk_bf16(v0[2], v0[3]); w.z = cvt_pk_bf16(v1[0], v1[1]); w.w = cvt_pk_bf16(v1[2], v1[3]);
                    *(u32x4*)(zb + (size_t)(row0 + ai * HALF + m * 16) * 1024 + ch0) = w; }
            return;
        }
        bf16_t* base = O + (size_t)(2 + (u.pn >> 2)) * ((size_t)M_TOK * 1024);
        const int col0 = (u.pn & 3) * BM + wc * 32 + 8 * fq;
#pragma unroll
        for (int ai = 0; ai < 2; ++ai)
#pragma unroll
            for (int m = 0; m < 4; ++m) { bf16_t* rowp = base + (size_t)(row0 + ai * HALF + m * 16) * 1024 + col0;
#pragma unroll
                for (int bj = 0; bj < 2; ++bj) { const f32x4 v0 = i32_to_f32(acc[ai][bj][m][0]) * sc[ai][m], v1 = i32_to_f32(acc[ai][bj][m][1]) * sc[ai][m];
                    u32x4 w; w.x = cvt_pk_bf16(v0[0], v0[1]); w.y = cvt_pk_bf16(v0[2], v0[3]); w.z = cvt_pk_bf16(v1[0], v1[1]); w.w = cvt_pk_bf16(v1[2], v1[3]);
                    *(u32x4*)(rowp + bj * HALF) = w; } }
    }
};

struct EpiWo {
    static constexpr int NS = 0; static constexpr bool STAGED = false, PERM = true, AFTER_DRAIN = false, MID = true; static constexpr int MID_T = 8;
    const bf16_t* xb; bf16_t* YB; unsigned char* Y8; float* stats; const float* ssq;
    __device__ __forceinline__ void pre(const Unit& u, PG8_LAS unsigned char* ldsx, int tid) const {
        if (tid < BM) { const int row = u.pm * BM + tid;
            const f32x4 a = *(const f32x4*)(ssq + (size_t)row * 8), b = *(const f32x4*)(ssq + (size_t)row * 8 + 4);
            ((PG8_LAS float*)ldsx)[tid] = __builtin_amdgcn_rsqf((hsum4(a) + hsum4(b)) * (1.0f / 1024.0f) + RMS_EPS) * P3_ATT_INV; }
    }
    __device__ __forceinline__ void mid(f32x4 (&acc)[2][2][4][2], PG8_LAS unsigned char* ldsx, int wr, int fr) const {
#pragma unroll
        for (int ai = 0; ai < 2; ++ai)
#pragma unroll
            for (int m = 0; m < 4; ++m) { const float ra = ((const PG8_LAS float*)ldsx)[ai * HALF + wr * 64 + m * 16 + fr];
#pragma unroll
                for (int bj = 0; bj < 2; ++bj)
#pragma unroll
                    for (int n = 0; n < 2; ++n) acc[ai][bj][m][n] *= ra; }
    }
    __device__ __forceinline__ void operator()(const f32x4 (&acc)[2][2][4][2], const Unit& u, int wr, int wc, int fr, int fq) const {
        const int row0 = u.pm * BM + wr * 64 + fr, col0 = u.pn * BM + wc * 32 + 8 * fq;
#pragma unroll
        for (int ai = 0; ai < 2; ++ai) {
        u32x4 xr[2][4][2];
#pragma unroll
            for (int m = 0; m < 4; ++m)
#pragma unroll
                for (int bj = 0; bj < 2; ++bj) xr[ai][m][bj] = __builtin_nontemporal_load((const u32x4*)(xb + (size_t)(row0 + ai * HALF + m * 16) * DM + col0 + bj * HALF));
#pragma unroll
            for (int m = 0; m < 4; ++m) { const int row = row0 + ai * HALF + m * 16; float s = 0.f, q = 0.f;
#pragma unroll
                for (int bj = 0; bj < 2; ++bj) { const u32x4 xw = xr[ai][m][bj];
                    const f32x4 x0 = (f32x4){bf_lo(xw.x), bf_hi(xw.x), bf_lo(xw.y), bf_hi(xw.y)}, x1 = (f32x4){bf_lo(xw.z), bf_hi(xw.z), bf_lo(xw.w), bf_hi(xw.w)};
                    const f32x4 v0 = acc[ai][bj][m][0] + x0 * ALPHA, v1 = acc[ai][bj][m][1] + x1 * ALPHA;
                    s += hsum4(v0) + hsum4(v1); q += hsq4(v0) + hsq4(v1);
                    u32x4 w; w.x = cvt_pk_bf16(v0[0], v0[1]); w.y = cvt_pk_bf16(v0[2], v0[3]); w.z = cvt_pk_bf16(v1[0], v1[1]); w.w = cvt_pk_bf16(v1[2], v1[3]);
                    const int col = col0 + bj * HALF;
                    typedef unsigned u32x2 __attribute__((ext_vector_type(2)));
                    *(u32x2*)(Y8 + (size_t)row * DM + col) = (u32x2){pack_i8x4(v0 * YQ_SCALE), pack_i8x4(v1 * YQ_SCALE)}; }
                s += __shfl_xor(s, 16); s += __shfl_xor(s, 32); q += __shfl_xor(q, 16); q += __shfl_xor(q, 32);
                if (fq == 0) { atomic_addf(stats + (size_t)row * 2, s); atomic_addf(stats + (size_t)row * 2 + 1, q); } }
        }
    }
};

struct EpiUp {
    static constexpr int NS = 8;
    static constexpr bool STAGED = true, PERM = true, AFTER_DRAIN = false, MID = false; static constexpr int MID_T = 0;
    const float* stats1; const float* c1; const float* c2; unsigned char* R;
    __device__ __forceinline__ void mid(f32x4 (&)[2][2][4][2], PG8_LAS unsigned char*, int, int) const {}
    __device__ __forceinline__ void operator()(const f32x4 (&)[2][2][4][2], const Unit&, int, int, int, int) const {}
    __device__ __forceinline__ void staged(const f32x4 (&acc)[2][2][4][2], const Unit& u, int wr, int wc, int fr, int fq, PG8_LAS unsigned char* stg, int tid) const {
        const int row0 = u.pm * BM + wr * 64 + fr, col0 = u.pn * BM + wc * 32 + 8 * fq;
        f32x4 k1[2][2], k2[2][2];
#pragma unroll
        for (int bj = 0; bj < 2; ++bj)
#pragma unroll
            for (int n = 0; n < 2; ++n) { k1[bj][n] = *(const f32x4*)(c1 + col0 + bj * HALF + 4 * n); k2[bj][n] = *(const f32x4*)(c2 + col0 + bj * HALF + 4 * n); }
        typedef float f32x2 __attribute__((ext_vector_type(2))); f32x2 st[2][4];
#pragma unroll
        for (int ai = 0; ai < 2; ++ai)
#pragma unroll
            for (int m = 0; m < 4; ++m) st[ai][m] = *(const f32x2*)(stats1 + (size_t)(row0 + ai * HALF + m * 16) * 2);
        int w0 = 0, w1 = 0;
        constexpr int PITCH = 272, BUF = 32 * PITCH;
        const int wofs = (wr * 16 + fr) * PITCH + wc * 32 + 8 * fq, rrow = tid >> 4, rofs = rrow * PITCH + (tid & 15) * 16;
        unsigned char* gout = R + (size_t)(u.pm * BM + (rrow >> 4) * 64 + (rrow & 15)) * FF + u.pn * BM + (tid & 15) * 16;
#pragma unroll
        for (int ai = 0; ai < 2; ++ai)
#pragma unroll
            for (int m = 0; m < 4; ++m) { PG8_LAS unsigned char* buf = stg + ((ai * 4 + m) & 1) * BUF;
                const float sm = st[ai][m].x, sq = st[ai][m].y;
                const float mu = sm * (1.0f / DM), var = sq * (1.0f / DM) - mu * mu, rstd = __builtin_amdgcn_rsqf(var + LN_EPS), rs = rstd * (YQ_INV * WQ_INV), nm = -rstd * mu;
#pragma unroll
                for (int bj = 0; bj < 2; ++bj) {
                    f32x4 v0 = i32_to_f32(acc[ai][bj][m][0]) * rs + (k1[bj][0] * nm + k2[bj][0]), v1 = i32_to_f32(acc[ai][bj][m][1]) * rs + (k1[bj][1] * nm + k2[bj][1]);
#pragma unroll
                    for (int e = 0; e < 4; ++e) { v0[e] = __builtin_amdgcn_fmed3f(v0[e], 0.f, 21.166f); v1[e] = __builtin_amdgcn_fmed3f(v1[e], 0.f, 21.166f); }
                    v0 = v0 * v0; v1 = v1 * v1;
                    w0 = __builtin_amdgcn_cvt_pk_fp8_f32(v0[0], v0[1], w0, false); w0 = __builtin_amdgcn_cvt_pk_fp8_f32(v0[2], v0[3], w0, true);
                    w1 = __builtin_amdgcn_cvt_pk_fp8_f32(v1[0], v1[1], w1, false); w1 = __builtin_amdgcn_cvt_pk_fp8_f32(v1[2], v1[3], w1, true);
                    typedef int i32x2 __attribute__((ext_vector_type(2)));
                    *(PG8_LAS i32x2*)(buf + wofs + bj * HALF) = (i32x2){w0, w1}; }
                asm volatile("s_waitcnt lgkmcnt(0)" ::: "memory"); __builtin_amdgcn_s_barrier();
                const u32x4 v = *(const PG8_LAS u32x4*)(buf + rofs);
                *(u32x4*)(gout + (size_t)(ai * HALF + m * 16) * FF) = v; }
    }
};

struct EpiDownLN {
    static constexpr int NS = 0; static constexpr bool STAGED = false, PERM = true, AFTER_DRAIN = false, MID = false; static constexpr int MID_T = 0;
    const unsigned char* Y8; const float* stats1; const float* g1; const float* b1; float* stats2; unsigned* cnt; const float* g2; const float* b2; float* out;
    __device__ __forceinline__ void mid(f32x4 (&)[2][2][4][2], PG8_LAS unsigned char*, int, int) const {}
    __device__ __forceinline__ void operator()(f32x4 (&acc)[2][2][4][2], const Unit& u, int wr, int wc, int fr, int fq) const {
        const int row0 = u.pm * BM + wr * 64 + fr, col0 = u.pn * BM + wc * 32 + 8 * fq;
        typedef float f32x2 __attribute__((ext_vector_type(2)));
        {
        f32x4 gv[2][2], bv[2][2];
#pragma unroll
        for (int bj = 0; bj < 2; ++bj)
#pragma unroll
            for (int n = 0; n < 2; ++n) { gv[bj][n] = *(const f32x4*)(g1 + col0 + bj * HALF + 4 * n); bv[bj][n] = *(const f32x4*)(b1 + col0 + bj * HALF + 4 * n); }
#pragma unroll
        for (int aim = 0; aim < 4; ++aim) { const int ai = aim >> 1;
            typedef unsigned u32x2 __attribute__((ext_vector_type(2))); u32x2 yr[4][2];
#pragma unroll
            for (int m = 2 * (aim & 1); m < 2 * (aim & 1) + 2; ++m)
#pragma unroll
                for (int bj = 0; bj < 2; ++bj) { const int row = row0 + ai * HALF + m * 16, col = col0 + bj * HALF;
                    yr[m][bj] = __builtin_nontemporal_load((const u32x2*)(Y8 + (size_t)row * DM + col)); }
#pragma unroll
            for (int m = 2 * (aim & 1); m < 2 * (aim & 1) + 2; ++m) { const int row = row0 + ai * HALF + m * 16;
                const f32x2 stv = *(const f32x2*)(stats1 + (size_t)row * 2); const float sm = stv.x, sq = stv.y;
                const float mu = sm * (1.0f / DM), var = sq * (1.0f / DM) - mu * mu, rstd = __builtin_amdgcn_rsqf(var + LN_EPS);
                float s = 0.f, q = 0.f;
#pragma unroll
                for (int bj = 0; bj < 2; ++bj) { const u32x2 yb = yr[m][bj];
                    f32x4 y0 = (f32x4){(float)(int)(signed char)(yb.x), (float)(int)(signed char)(yb.x >> 8), (float)(int)(signed char)(yb.x >> 16), (float)((int)yb.x >> 24)} * YQ_INV;
                    f32x4 y1 = (f32x4){(float)(int)(signed char)(yb.y), (float)(int)(signed char)(yb.y >> 8), (float)(int)(signed char)(yb.y >> 16), (float)((int)yb.y >> 24)} * YQ_INV;
                    const f32x4 h0 = (y0 - mu) * rstd * gv[bj][0] + bv[bj][0], h1 = (y1 - mu) * rstd * gv[bj][1] + bv[bj][1];
                    const f32x4 v0 = acc[ai][bj][m][0] * WDN_INV_SCALE + h0 * ALPHA, v1 = acc[ai][bj][m][1] * WDN_INV_SCALE + h1 * ALPHA;
                    s += hsum4(v0) + hsum4(v1); q += hsq4(v0) + hsq4(v1);
                    acc[ai][bj][m][0] = v0; acc[ai][bj][m][1] = v1; }
                s += __shfl_xor(s, 16); s += __shfl_xor(s, 32); q += __shfl_xor(q, 16); q += __shfl_xor(q, 32);
                if (fq == 0) { atomic_addf(stats2 + (size_t)row * 2, s); atomic_addf(stats2 + (size_t)row * 2 + 1, q); } }
        }
        }
        asm volatile("s_waitcnt vmcnt(0)" ::: "memory");
        unsigned* pc = cnt + 64 * u.pm;
        if (fr == 0 && fq == 0) (void)__hip_atomic_fetch_add(pc, 1u, __ATOMIC_RELAXED, __HIP_MEMORY_SCOPE_AGENT);
        { unsigned spins = 0;
          while ((unsigned)__builtin_amdgcn_readfirstlane(__hip_atomic_load(pc, __ATOMIC_RELAXED, __HIP_MEMORY_SCOPE_AGENT)) < 64u) { __builtin_amdgcn_s_sleep(2); if (++spins > (1u << 20)) break; } }
        f32x4 gg[2][2], bb[2][2];
#pragma unroll
        for (int bj = 0; bj < 2; ++bj)
#pragma unroll
            for (int n = 0; n < 2; ++n) { gg[bj][n] = *(const f32x4*)(g2 + col0 + bj * HALF + 4 * n); bb[bj][n] = *(const f32x4*)(b2 + col0 + bj * HALF + 4 * n); }
#pragma unroll
        for (int ai = 0; ai < 2; ++ai)
#pragma unroll
            for (int m = 0; m < 4; ++m) { const int row = row0 + ai * HALF + m * 16;
                const float sm = __hip_atomic_load(stats2 + (size_t)row * 2, __ATOMIC_RELAXED, __HIP_MEMORY_SCOPE_AGENT), sq = __hip_atomic_load(stats2 + (size_t)row * 2 + 1, __ATOMIC_RELAXED, __HIP_MEMORY_SCOPE_AGENT);
                const float mu = sm * (1.0f / DM), var = sq * (1.0f / DM) - mu * mu, rstd = __builtin_amdgcn_rsqf(var + LN_EPS);
#pragma unroll
                for (int bj = 0; bj < 2; ++bj) { float* op = out + (size_t)row * DM + col0 + bj * HALF;
                    *(f32x4*)op = (acc[ai][bj][m][0] - mu) * rstd * gg[bj][0] + bb[bj][0];
                    *(f32x4*)(op + 4) = (acc[ai][bj][m][1] - mu) * rstd * gg[bj][1] + bb[bj][1]; } }
    }
};
struct PanelOrder {
    int G, vcu, ntile;
    __host__ __device__ void init(int M, int N, int G_, int c) { G = G_; vcu = (G_ % 8 == 0) ? (c % 8) * (G_ / 8) + c / 8 : c; ntile = (M / BM) * (N / BM); }
    __host__ __device__ bool next(int i, Unit& u) const { const int idx = i * G + vcu; if (idx >= ntile) return false; u.pm = idx >> 3; u.pn = idx & 7; return true; }
    __device__ __forceinline__ void a_ready(const Unit&) const {}
    __device__ __forceinline__ void done(const Unit&) const {}
};

template <class Epi, class Sched, bool ALIGN_EPI = false, bool SP2 = false, int FP8M = 0, int F8T1 = 0>
__device__ __forceinline__ void gemm_phase(PG8_LAS unsigned char* lds, const Gemm g, const Sched& S, const Epi& E) {
    int tid_ = threadIdx.x; asm volatile("" : "+v"(tid_));
    const int tid = tid_, wid = __builtin_amdgcn_readfirstlane(tid >> 6), lane = tid & 63, wr = wid >> 2, wc = wid & 3, fr = lane & 15, fq = lane >> 4;
    const int K = g.K, nt = K / BK;
    unsigned voffA[2], voffB[2];
#pragma unroll
    for (int i = 0; i < 2; ++i) { int R, C; stage_rc(tid * 16 + i * 8192, R, C); const int Rb = Epi::PERM ? ((R & ~31) + perm32(R & 31)) : R;
        voffA[i] = (unsigned)(R * K + C) * 2u; voffB[i] = (unsigned)(Rb * K + C) * 2u; }
    const size_t kstep = (size_t)(BK * 2);
    const size_t hstep = (size_t)HALF * K * 2;
    const size_t tstep = 2 * hstep;
    const unsigned ldsw = (unsigned)wid * 1024u;
    const int aoff = lds_byte(wr * 64 + fr, fq * 8), boff = lds_byte(wc * 32 + fr, fq * 8);
#define PG8_SA(b, h) (((b) * 2 + (h)) * HTB)
#define PG8_SB(b, h) ((4 + (b) * 2 + (h)) * HTB)
#define PG8_STAGE(bufoff, gbase, voff) do { _Pragma("unroll") for (int _i = 0; _i < 2; ++_i) \
        __builtin_amdgcn_global_load_lds((const unsigned*)((const char*)(gbase) + (voff)[_i]), (PG8_LAS unsigned*)(lds + (bufoff) + ldsw + _i * 8192), 16, 0, 0); } while (0)
#define PG8_LDA(dst, b, h) do { _Pragma("unroll") for (int m = 0; m < 4; ++m) _Pragma("unroll") for (int k = 0; k < 2; ++k) dst[m][k] = *(const PG8_LAS bf16x8*)(lds + PG8_SA(b, h) + aoff + m * 2048 + k * 1024); } while (0)
#define PG8_LDB(dst, b, h) do { _Pragma("unroll") for (int n = 0; n < 2; ++n) _Pragma("unroll") for (int k = 0; k < 2; ++k) dst[n][k] = *(const PG8_LAS bf16x8*)(lds + PG8_SB(b, h) + boff + n * 2048 + k * 1024); } while (0)
#define PG8_CAT(x0, x1) __builtin_shufflevector(__builtin_bit_cast(v4i_t, x0), __builtin_bit_cast(v4i_t, x1), 0, 1, 2, 3, 4, 5, 6, 7)
#define PG8_MMA_F8(ai, bj, At, Bt) do { __builtin_amdgcn_s_setprio(1); _Pragma("unroll") for (int m = 0; m < 4; ++m) _Pragma("unroll") for (int n = 0; n < 2; ++n) \
        asm volatile("v_mfma_scale_f32_16x16x128_f8f6f4 %0, %1, %2, %0, %3, %3 op_sel_hi:[0,0,0]" : "+v"(acc[ai][bj][m][n]) : "v"(PG8_CAT(Bt[n][0], Bt[n][1])), "v"(PG8_CAT(At[m][0], At[m][1])), "v"(scl8)); \
        __builtin_amdgcn_s_setprio(0); } while (0)
#define PG8_MMA_B16A(ai, bj, At, Bt) do { __builtin_amdgcn_s_setprio(1); _Pragma("unroll") for (int m = 0; m < 4; ++m) _Pragma("unroll") for (int n = 0; n < 2; ++n) _Pragma("unroll") for (int k = 0; k < 2; ++k) \
        asm volatile("v_mfma_f32_16x16x32_bf16 %0, %1, %2, %0" : "+v"(acc[ai][bj][m][n]) : "v"(Bt[n][k]), "v"(At[m][k]));   \
        __builtin_amdgcn_s_setprio(0); } while (0)
#define PG8_MMA_B16(ai, bj, At, Bt) do { __builtin_amdgcn_s_setprio(1); _Pragma("unroll") for (int m = 0; m < 4; ++m) _Pragma("unroll") for (int n = 0; n < 2; ++n) _Pragma("unroll") for (int k = 0; k < 2; ++k) \
        acc[ai][bj][m][n] = __builtin_amdgcn_mfma_f32_16x16x32_bf16(Bt[n][k], At[m][k], acc[ai][bj][m][n], 0, 0, 0); __builtin_amdgcn_s_setprio(0); } while (0)
#define PG8_MMA_I8(ai, bj, At, Bt) do { __builtin_amdgcn_s_setprio(1); _Pragma("unroll") for (int m = 0; m < 4; ++m) _Pragma("unroll") for (int n = 0; n < 2; ++n) _Pragma("unroll") for (int k = 0; k < 2; ++k) \
        acc[ai][bj][m][n] = __builtin_bit_cast(f32x4, __builtin_amdgcn_mfma_i32_16x16x64_i8(__builtin_bit_cast(v4i_t, Bt[n][k]), __builtin_bit_cast(v4i_t, At[m][k]), __builtin_bit_cast(v4i_t, acc[ai][bj][m][n]), 0, 0, 0)); \
        __builtin_amdgcn_s_setprio(0); } while (0)
#define PG8_MMA(ai, bj, At, Bt) PG8_MMA_B16(ai, bj, At, Bt)
#define PG8_WAIT_V(n) asm volatile("s_waitcnt vmcnt(" #n ")" ::: "memory")
#define PG8_WAIT_L(n) asm volatile("s_waitcnt lgkmcnt(" #n ")" ::: "memory")
#define PG8_WAIT_V1() do { if constexpr (Epi::NS == 8) asm volatile("s_waitcnt vmcnt(16)\n\ts_cmp_lg_u32 %0, 0\n\ts_cbranch_scc1 .Lrx%=\n\ts_waitcnt vmcnt(8)\n.Lrx%=:" :: "s"(rxi) : "scc", "memory"); \
                           else asm volatile("s_waitcnt vmcnt(8)" ::: "memory"); } while (0)
#define PG8_BAR __builtin_amdgcn_s_barrier()
#define PG8_SCHED __builtin_amdgcn_sched_barrier(0)
#define PG8_ITER_SP2(MMA_) do { \
            PG8_LDB(B0, 0, 0); PG8_LDB(B1, 0, 1); PG8_SCHED; PG8_LDA(At, 0, 0); PG8_STAGE(PG8_SA(1, 1), a1 + hstep, voffA); \
            PG8_WAIT_V1(); PG8_WAIT_L(0); PG8_BAR; MMA_(0, 0, At, B0); MMA_(0, 1, At, B1); PG8_BAR; PG8_SCHED; \
            PG8_LDA(At, 0, 1); PG8_STAGE(PG8_SB(0, 0), b2, voffB); PG8_STAGE(PG8_SB(0, 1), b2 + hstep, voffB); PG8_STAGE(PG8_SA(0, 0), a2, voffA); \
            PG8_WAIT_V1(); PG8_WAIT_L(0); PG8_BAR; MMA_(1, 0, At, B0); MMA_(1, 1, At, B1); PG8_BAR; PG8_SCHED; \
            PG8_LDB(B0, 1, 0); PG8_LDB(B1, 1, 1); PG8_SCHED; PG8_LDA(At, 1, 0); PG8_STAGE(PG8_SA(0, 1), a2 + hstep, voffA); \
            PG8_WAIT_V(8); PG8_WAIT_L(0); PG8_BAR; MMA_(0, 0, At, B0); MMA_(0, 1, At, B1); PG8_BAR; PG8_SCHED; \
            PG8_LDA(At, 1, 1); PG8_STAGE(PG8_SB(1, 0), b3, voffB); PG8_STAGE(PG8_SB(1, 1), b3 + hstep, voffB); PG8_STAGE(PG8_SA(1, 0), a3, voffA); \
            PG8_WAIT_V(8); PG8_WAIT_L(0); PG8_BAR; MMA_(1, 0, At, B0); MMA_(1, 1, At, B1); PG8_BAR; PG8_SCHED; \
            } while (0)
    Unit cur, nxt; int ui = 0;
    if (!S.next(0, cur)) return;
    f32x4 acc[2][2][4][2];
#pragma unroll
    for (int a = 0; a < 2; ++a)
#pragma unroll
        for (int b = 0; b < 2; ++b)
#pragma unroll
            for (int m = 0; m < 4; ++m)
#pragma unroll
                for (int n = 0; n < 2; ++n) acc[a][b][m][n] = (f32x4){0.f, 0.f, 0.f, 0.f};
    bf16x8 At[4][2], B0[2][2], B1[2][2];
    int scl8 = 0x7f7f7f7f; asm volatile("" : "+v"(scl8));
    const char* cA = (const char*)g.A + (size_t)cur.pm * tstep; const char* cB = (const char*)g.Bt + (size_t)cur.pn * tstep;
    S.a_ready(cur);
    if constexpr (Epi::MID) E.pre(cur, lds + STAGE_BYTES, tid);
    if constexpr (SP2) {
        PG8_STAGE(PG8_SB(0, 0), cB, voffB); PG8_STAGE(PG8_SB(0, 1), cB + hstep, voffB); PG8_STAGE(PG8_SA(0, 0), cA, voffA); PG8_STAGE(PG8_SA(0, 1), cA + hstep, voffA);
        if (wr == 1) PG8_BAR;
        PG8_WAIT_V(2); PG8_BAR;
        PG8_STAGE(PG8_SB(1, 0), cB + kstep, voffB); PG8_STAGE(PG8_SA(1, 0), cA + kstep, voffA); PG8_STAGE(PG8_SB(1, 1), cB + hstep + kstep, voffB);
        PG8_WAIT_V(6); PG8_BAR;
    } else {
        PG8_STAGE(PG8_SB(0, 0), cB, voffB); PG8_STAGE(PG8_SA(0, 0), cA, voffA); PG8_STAGE(PG8_SB(0, 1), cB + hstep, voffB); PG8_STAGE(PG8_SA(0, 1), cA + hstep, voffA);
        if (wr == 1) PG8_BAR;
        PG8_WAIT_V(4); PG8_BAR;
        PG8_STAGE(PG8_SB(1, 0), cB + kstep, voffB); PG8_STAGE(PG8_SA(1, 0), cA + kstep, voffA); PG8_STAGE(PG8_SB(1, 1), cB + hstep + kstep, voffB);
        PG8_WAIT_V(6); PG8_BAR;
    }
    for (;;) {
        const bool has_next = S.next(ui + 1, nxt);
        const char* nA = has_next ? (const char*)g.A + (size_t)nxt.pm * tstep : cA; const char* nB = has_next ? (const char*)g.Bt + (size_t)nxt.pn * tstep : cB;
        constexpr int SPLIT = Epi::MID ? Epi::MID_T : (FP8M == 1 ? F8T1 : 0);
        if constexpr (SPLIT > 0 && SP2) {
            for (int t = 0; t < SPLIT; t += 2) { constexpr int rxi = 0; (void)rxi;
                const char* a1 = cA + (size_t)(t + 1) * kstep; const char* a2 = cA + (size_t)(t + 2) * kstep; const char* b2 = cB + (size_t)(t + 2) * kstep;
                const char* a3 = a2 + kstep; const char* b3 = b2 + kstep;
                if constexpr (FP8M == 1) PG8_ITER_SP2(PG8_MMA_B16A); else if constexpr (FP8M == 2 || FP8M == 6) PG8_ITER_SP2(PG8_MMA_F8); else if constexpr (FP8M == 3) PG8_ITER_SP2(PG8_MMA_I8); else PG8_ITER_SP2(PG8_MMA_B16);
            }
            if constexpr (FP8M == 1) asm volatile("s_nop 15" ::: "memory");
            if constexpr (FP8M == 6) { asm volatile("s_nop 15\n\ts_nop 15" ::: "memory"); PG8_SCHED; }
            if constexpr (Epi::MID) E.mid(acc, lds + STAGE_BYTES, wr, fr);
        }
        for (int t = SPLIT; t < nt; t += 2) {
            const bool last = (t == nt - 2); const int rxi = __builtin_amdgcn_readfirstlane(((Epi::NS > 0) && t == 0 && ui > 0) ? 1 : 0); (void)rxi;
            const char* a1 = cA + (size_t)(t + 1) * kstep;
            const char* a2 = last ? nA : cA + (size_t)(t + 2) * kstep; const char* b2 = last ? nB : cB + (size_t)(t + 2) * kstep;
            const char* a3 = a2 + kstep; const char* b3 = b2 + kstep;
            if (last && has_next) S.a_ready(nxt);
            if constexpr (SP2) {
            if constexpr (FP8M == 1) PG8_ITER_SP2(PG8_MMA_F8);
            else if constexpr (FP8M == 2) PG8_ITER_SP2(PG8_MMA_F8);
            else if constexpr (FP8M == 3) PG8_ITER_SP2(PG8_MMA_I8);
            else PG8_ITER_SP2(PG8_MMA_B16);
            } else {
            PG8_LDB(B0, 0, 0); PG8_SCHED; PG8_LDA(At, 0, 0); PG8_STAGE(PG8_SA(1, 1), a1 + hstep, voffA);
            PG8_WAIT_L(8); PG8_BAR; PG8_WAIT_L(0); PG8_MMA(0, 0, At, B0); PG8_BAR; PG8_SCHED;
            PG8_LDB(B1, 0, 1); PG8_STAGE(PG8_SB(0, 0), b2, voffB);
            PG8_BAR; PG8_WAIT_L(0); PG8_MMA(0, 1, At, B1); PG8_BAR;
            PG8_LDA(At, 0, 1); PG8_STAGE(PG8_SA(0, 0), a2, voffA);
            PG8_BAR; PG8_WAIT_L(0); PG8_MMA(1, 0, At, B0); PG8_BAR; PG8_SCHED;
            PG8_STAGE(PG8_SB(0, 1), b2 + hstep, voffB);
            PG8_WAIT_V(6); PG8_BAR; PG8_MMA(1, 1, At, B1); PG8_BAR;
            PG8_LDB(B0, 1, 0); PG8_SCHED; PG8_LDA(At, 1, 0); PG8_STAGE(PG8_SA(0, 1), a2 + hstep, voffA);
            PG8_WAIT_L(8); PG8_BAR; PG8_WAIT_L(0); PG8_MMA(0, 0, At, B0); PG8_BAR; PG8_SCHED;
            PG8_LDB(B1, 1, 1); PG8_STAGE(PG8_SB(1, 0), b3, voffB);
            PG8_BAR; PG8_WAIT_L(0); PG8_MMA(0, 1, At, B1); PG8_BAR;
            PG8_LDA(At, 1, 1); PG8_STAGE(PG8_SA(1, 0), a3, voffA);
            PG8_BAR; PG8_WAIT_L(0); PG8_MMA(1, 0, At, B0); PG8_BAR; PG8_SCHED;
            PG8_STAGE(PG8_SB(1, 1), b3 + hstep, voffB);
            PG8_WAIT_V(6); PG8_BAR; PG8_MMA(1, 1, At, B1); PG8_BAR;
            }
        }
        if constexpr (ALIGN_EPI) { if (wr == 0) PG8_BAR; }
        if constexpr (FP8M == 1 || FP8M == 2) { asm volatile("s_nop 15\n\ts_nop 15" ::: "memory"); PG8_SCHED; }
        if constexpr (Epi::STAGED) { E.staged(acc, cur, wr, wc, fr, fq, lds + STAGE_BYTES, tid); S.done(cur); }
        else if constexpr (!Epi::AFTER_DRAIN) { E(acc, cur, wr, wc, fr, fq); S.done(cur); }
        if (!has_next) break;
#pragma unroll
        for (int a = 0; a < 2; ++a)
#pragma unroll
            for (int b = 0; b < 2; ++b)
#pragma unroll
                for (int m = 0; m < 4; ++m)
#pragma unroll
                    for (int n = 0; n < 2; ++n) acc[a][b][m][n] = (f32x4){0.f, 0.f, 0.f, 0.f};
        cur = nxt; cA = nA; cB = nB; ++ui;
        if constexpr (Epi::MID) E.pre(cur, lds + STAGE_BYTES, tid);
        if constexpr (ALIGN_EPI) { if (wr == 1) PG8_BAR; }
    }
    PG8_WAIT_V(0);
    if constexpr (!ALIGN_EPI) { if (wr == 0) PG8_BAR; }
    PG8_BAR;
    if constexpr (Epi::AFTER_DRAIN) { E.fused(acc, cur, wr, wc, fr, fq, lds, wid, lane); S.done(cur); }
#undef PG8_SA
#undef PG8_SB
#undef PG8_STAGE
#undef PG8_LDA
#undef PG8_LDB
#undef PG8_MMA
#undef PG8_MMA_F8
#undef PG8_MMA_I8
#undef PG8_MMA_B16
#undef PG8_MMA_B16A
#undef PG8_ITER_SP2
#undef PG8_CAT
#undef PG8_WAIT_V
#undef PG8_WAIT_L
#undef PG8_BAR
#undef PG8_SCHED
}
}

#ifndef PG8_SP2
#define PG8_SP2 true
#endif
#ifndef PG8_ALIGN
#define PG8_ALIGN true
#endif
namespace att {
typedef unsigned short bf16;
typedef short bf16x8 __attribute__((ext_vector_type(8)));
typedef short s16x4 __attribute__((ext_vector_type(4)));
typedef float f32x16 __attribute__((ext_vector_type(16)));
typedef float f32x4 __attribute__((ext_vector_type(4)));
typedef unsigned u32x4 __attribute__((ext_vector_type(4)));
constexpr int D = 128, NW = 8, QBLK = 32, KVBLK = 64, QB = NW * QBLK, LDQ = 1024, LDO = 2048;
constexpr int SHM_V = KVBLK * D * 2, SHM_K = KVBLK * D * 2;
constexpr int NVB = 3;
constexpr int LDS_BYTES = NVB * SHM_V + 2 * SHM_K + NW * 64 * 4;
constexpr int KM_OFF = LDS_BYTES + NW * QBLK * D * 2, KM_PITCH = 272;
constexpr float SCALE = 0.08838834764831845f, THR = 8.f;
constexpr size_t KPART_STRIDE = (size_t)64 * 1024;

#define KSWZ(row, colB) ((((colB) >> 7) * 8192) + (row) * 128 + (((((colB) >> 4) & 7) ^ (((row) >> 1) & 7)) << 4))
#define SBAR() __builtin_amdgcn_sched_barrier(0)
__device__ __forceinline__ int v_st(int k, int c) { const int kk = (k & ~0xC) | ((k & 4) << 1) | ((k & 8) >> 1); return ((kk >> 3) * 4 + (c >> 5)) * 512 + ((kk & 7) * 32 + (c & 31)) * 2; }
__device__ __forceinline__ int v_rd_base(int lane) { return ((lane & 3) << 3) | (((lane >> 2) & 3) << 6) | (((lane >> 4) & 1) << 5) | (((lane >> 5) & 1) << 8); }
constexpr int v_rd_off(int d0, int ks, int half) { return d0 * 512 + ks * 4096 + half * 2048; }
__device__ __forceinline__ int crow(int r, int hi) { return (r & 3) + 8 * (r >> 2) + 4 * hi; }
__device__ __forceinline__ unsigned cvtpk(float lo, float hi) { unsigned r; asm volatile("v_cvt_pk_bf16_f32 %0, %1, %2" : "=v"(r) : "v"(lo), "v"(hi)); return r; }
__device__ __forceinline__ bf16x8 pack8(f32x4 a, f32x4 b) { u32x4 w = {cvtpk(a[0], a[1]), cvtpk(a[2], a[3]), cvtpk(b[0], b[1]), cvtpk(b[2], b[3])}; return *reinterpret_cast<bf16x8*>(&w); }
__device__ __forceinline__ bf16x8 load8(const bf16* p) { return *reinterpret_cast<const bf16x8*>(p); }
__device__ __forceinline__ void mask_tile(f32x16& p0, f32x16& p1, int dq) {
#define MT1(P, r, c_) do { float t_ = P[r]; asm volatile("v_cmp_le_i32 vcc, %1, %2\n\tv_cndmask_b32 %0, %3, %0, vcc" : "+v"(t_) : "n"(c_), "v"(dq), "v"(NEG) : "vcc"); P[r] = t_; } while (0)
    float NEG = -__builtin_inff(); asm volatile("" : "+v"(NEG));
    MT1(p0, 0, 0); MT1(p0, 1, 1); MT1(p0, 2, 2); MT1(p0, 3, 3); MT1(p0, 4, 8); MT1(p0, 5, 9); MT1(p0, 6, 10); MT1(p0, 7, 11);
    MT1(p0, 8, 16); MT1(p0, 9, 17); MT1(p0, 10, 18); MT1(p0, 11, 19); MT1(p0, 12, 24); MT1(p0, 13, 25); MT1(p0, 14, 26); MT1(p0, 15, 27);
    MT1(p1, 0, 32); MT1(p1, 1, 33); MT1(p1, 2, 34); MT1(p1, 3, 35); MT1(p1, 4, 40); MT1(p1, 5, 41); MT1(p1, 6, 42); MT1(p1, 7, 43);
    MT1(p1, 8, 48); MT1(p1, 9, 49); MT1(p1, 10, 50); MT1(p1, 11, 51); MT1(p1, 12, 56); MT1(p1, 13, 57); MT1(p1, 14, 58); MT1(p1, 15, 59);
#undef MT1
}
__device__ __forceinline__ void mask_all(f32x16& p0, f32x16& p1, bool keep) {
    const float NEG = -__builtin_inff();
#pragma unroll
    for (int r = 0; r < 16; ++r) { p0[r] = keep ? p0[r] : NEG; p1[r] = keep ? p1[r] : NEG; }
}
__device__ __forceinline__ void partialSM(f32x16& p0, f32x16& p1, float& m_reg, float& mn, float& alpha) {
    float pmax = p0[0];
#pragma unroll
    for (int r = 1; r < 16; ++r) pmax = fmaxf(pmax, p0[r]);
#pragma unroll
    for (int r = 0; r < 16; ++r) pmax = fmaxf(pmax, p1[r]);
    { auto rr = __builtin_amdgcn_permlane32_swap(__float_as_uint(pmax), __float_as_uint(pmax), false, false);
      pmax = fmaxf(__uint_as_float(rr[0]), __uint_as_float(rr[1])); }
    constexpr float C2 = 1.4426950408889634f * SCALE;
    if (__builtin_expect(__all((pmax - m_reg) * SCALE <= THR), 1)) { mn = m_reg; alpha = 1.f; }
    else { mn = fmaxf(m_reg, pmax); alpha = __builtin_amdgcn_exp2f((m_reg - mn) * C2); m_reg = mn; }
    const float mnL = -mn * C2;
#pragma unroll
    for (int r = 0; r < 16; ++r) p0[r] = fmaf(p0[r], C2, mnL);
#pragma unroll
    for (int r = 0; r < 16; ++r) p1[r] = fmaf(p1[r], C2, mnL);
#pragma unroll
    for (int r = 0; r < 16; ++r) p0[r] = __builtin_amdgcn_exp2f(p0[r]);
}
__device__ __forceinline__ void finishSM(f32x16& p0, f32x16& p1, float alpha, float& l_reg, bf16x8& pa0, bf16x8& pa1, bf16x8& pa2, bf16x8& pa3) {
#pragma unroll
    for (int r = 0; r < 16; ++r) p1[r] = __builtin_amdgcn_exp2f(p1[r]);
    float ps = 0;
#pragma unroll
    for (int r = 0; r < 16; ++r) ps += p0[r];
#pragma unroll
    for (int r = 0; r < 16; ++r) ps += p1[r];
    { auto rr = __builtin_amdgcn_permlane32_swap(__float_as_uint(ps), __float_as_uint(ps), false, false);
      ps = __uint_as_float(rr[0]) + __uint_as_float(rr[1]); }
    l_reg = l_reg * alpha + ps;
#define PK4(P, B_, OUT) do { unsigned a0 = cvtpk(P[B_+0], P[B_+1]), a1 = cvtpk(P[B_+2], P[B_+3]);                          \
        unsigned b0 = cvtpk(P[B_+4], P[B_+5]), b1 = cvtpk(P[B_+6], P[B_+7]);                                             \
        auto r0 = __builtin_amdgcn_permlane32_swap(a0, b0, false, false); auto r1 = __builtin_amdgcn_permlane32_swap(a1, b1, false, false); \
        u32x4 w = {r0[0], r1[0], r0[1], r1[1]}; OUT = *reinterpret_cast<bf16x8*>(&w); } while (0)
    PK4(p0, 0, pa0); PK4(p0, 8, pa1); PK4(p1, 0, pa2); PK4(p1, 8, pa3);
#undef PK4
}
template <int KB>
__device__ __forceinline__ void qkt(f32x16& p0, f32x16& p1, const char* K_lds, int r32, int hi, const bf16x8* qr) {
    p0 = f32x16{}; p1 = f32x16{};
    int kb[4];
#pragma unroll
    for (int dd = 0; dd < 4; ++dd) kb[dd] = (int)(uintptr_t)(K_lds + KSWZ(r32, (dd * 16 + hi * 8) * 2));
#define KRD(dst, d0_) do { asm volatile("ds_read_b128 %0, %1 offset:%2" : "=&v"(dst[0]) : "v"(kb[(d0_) & 3]), "i"(KB * SHM_K + ((d0_) >> 2) * 8192) : "memory");          \
                           asm volatile("ds_read_b128 %0, %1 offset:%2" : "=&v"(dst[1]) : "v"(kb[(d0_) & 3]), "i"(KB * SHM_K + ((d0_) >> 2) * 8192 + 32 * 128) : "memory"); } while (0)
#define KMM(f, d0_, n_) do { asm volatile("s_waitcnt lgkmcnt(" #n_ ")" ::: "memory"); SBAR();                                                              \
        p0 = __builtin_amdgcn_mfma_f32_32x32x16_bf16(f[0], qr[d0_], p0, 0, 0, 0); p1 = __builtin_amdgcn_mfma_f32_32x32x16_bf16(f[1], qr[d0_], p1, 0, 0, 0); SBAR(); } while (0)
    bf16x8 fa[2], fb[2];
    KRD(fa, 0); KRD(fb, 1);
    KMM(fa, 0, 2); KRD(fa, 2);
    KMM(fb, 1, 2); KRD(fb, 3);
    KMM(fa, 2, 2); KRD(fa, 4);
    KMM(fb, 3, 2); KRD(fb, 5);
    KMM(fa, 4, 2); KRD(fa, 6);
    KMM(fb, 5, 2); KRD(fb, 7);
    KMM(fa, 6, 2);
    KMM(fb, 7, 0);
#undef KRD
#undef KMM
}
template <int KB>
__device__ __forceinline__ void qkt_c(f32x16& p0, f32x16& p1, const char* K_lds, int r32, int hi, const bf16x8* qr) {
    p0 = f32x16{}; p1 = f32x16{};
    const char* kb[4];
#pragma unroll
    for (int dd = 0; dd < 4; ++dd) kb[dd] = K_lds + KB * SHM_K + KSWZ(r32, (dd * 16 + hi * 8) * 2);
#pragma unroll
    for (int d0 = 0; d0 < 8; ++d0) { const char* a = kb[d0 & 3] + (d0 >> 2) * 8192;
        bf16x8 b0 = *reinterpret_cast<const bf16x8*>(a);
        bf16x8 b1 = *reinterpret_cast<const bf16x8*>(a + 32 * 128);
        p0 = __builtin_amdgcn_mfma_f32_32x32x16_bf16(b0, qr[d0], p0, 0, 0, 0);
        p1 = __builtin_amdgcn_mfma_f32_32x32x16_bf16(b1, qr[d0], p1, 0, 0, 0); }
}
__device__ __forceinline__ void pv_tile(f32x16* o, int vb0, bf16x8 pa0, bf16x8 pa1, bf16x8 pa2, bf16x8 pa3) {
#define TRRD(dst, off) asm volatile("ds_read_b64_tr_b16 %0, %1 offset:%2" : "=&v"(dst) : "v"(vb0), "i"(off) : "memory")
#define PV_R(d0, ks, l, h) do { TRRD(l, v_rd_off(d0, 0, 0) + (ks) * 4096); TRRD(h, v_rd_off(d0, 0, 0) + (ks) * 4096 + 2048); } while (0)
#define PV_M(d0, pa, l, h, n_) do { asm volatile("s_waitcnt lgkmcnt(" #n_ ")" ::: "memory"); SBAR();                                \
        o[d0] = __builtin_amdgcn_mfma_f32_32x32x16_bf16(pa, (bf16x8){l[0], l[1], l[2], l[3], h[0], h[1], h[2], h[3]}, o[d0], 0, 0, 0); SBAR(); } while (0)
    s16x4 l0, l1, l2, l3, h0, h1, h2, h3;
    PV_R(0, 0, l0, h0); PV_R(0, 1, l1, h1); PV_R(0, 2, l2, h2); PV_R(0, 3, l3, h3);
#define PV_G(d0) do { PV_M(d0, pa0, l0, h0, 6); PV_R(d0 + 1, 0, l0, h0); PV_M(d0, pa1, l1, h1, 6); PV_R(d0 + 1, 1, l1, h1);            \
                      PV_M(d0, pa2, l2, h2, 6); PV_R(d0 + 1, 2, l2, h2); PV_M(d0, pa3, l3, h3, 6); PV_R(d0 + 1, 3, l3, h3); } while (0)
    PV_G(0); PV_G(1); PV_G(2);
    PV_M(3, pa0, l0, h0, 6); PV_M(3, pa1, l1, h1, 4); PV_M(3, pa2, l2, h2, 2); PV_M(3, pa3, l3, h3, 0);
#undef PV_G
#undef PV_M
#undef PV_R
#undef TRRD
}

template <int KB>
__device__ __forceinline__ void qk_fin(f32x16& x0, f32x16& x1, f32x16& y0, f32x16& y1, float alY, float& l_reg, bf16x8& pa0, bf16x8& pa1, bf16x8& pa2, bf16x8& pa3,
                                       const char* K_lds, int r32, int hi, const bf16x8* qr) {
    x0 = f32x16{}; x1 = f32x16{};
    int kb[4];
#pragma unroll
    for (int dd = 0; dd < 4; ++dd) kb[dd] = (int)(uintptr_t)(K_lds + KSWZ(r32, (dd * 16 + hi * 8) * 2));
#define KRD(dst, d0_) do { asm volatile("ds_read_b128 %0, %1 offset:%2" : "=&v"(dst[0]) : "v"(kb[(d0_) & 3]), "i"(KB * SHM_K + ((d0_) >> 2) * 8192) : "memory");          \
                           asm volatile("ds_read_b128 %0, %1 offset:%2" : "=&v"(dst[1]) : "v"(kb[(d0_) & 3]), "i"(KB * SHM_K + ((d0_) >> 2) * 8192 + 32 * 128) : "memory"); } while (0)
#define KMM(f, d0_, n_) do { asm volatile("s_waitcnt lgkmcnt(" #n_ ")" ::: "memory"); SBAR();                                                              \
        x0 = __builtin_amdgcn_mfma_f32_32x32x16_bf16(f[0], qr[d0_], x0, 0, 0, 0); x1 = __builtin_amdgcn_mfma_f32_32x32x16_bf16(f[1], qr[d0_], x1, 0, 0, 0); SBAR(); } while (0)
#define EXPY(i) do { y1[2 * (i)] = __builtin_amdgcn_exp2f(y1[2 * (i)]); y1[2 * (i) + 1] = __builtin_amdgcn_exp2f(y1[2 * (i) + 1]); } while (0)
#define ADDY(Y, i) do { ps += Y[2 * (i)]; ps += Y[2 * (i) + 1]; } while (0)
#define CVA(P, B_) do { c0 = cvtpk(P[B_ + 0], P[B_ + 1]); c1 = cvtpk(P[B_ + 2], P[B_ + 3]); } while (0)
#define CVB(P, B_, OUT) do { const unsigned b0_ = cvtpk(P[B_ + 4], P[B_ + 5]), b1_ = cvtpk(P[B_ + 6], P[B_ + 7]);                                          \
        auto r0_ = __builtin_amdgcn_permlane32_swap(c0, b0_, false, false); auto r1_ = __builtin_amdgcn_permlane32_swap(c1, b1_, false, false);               \
        u32x4 w_ = {r0_[0], r1_[0], r0_[1], r1_[1]}; OUT = *reinterpret_cast<bf16x8*>(&w_); } while (0)
    bf16x8 fa[2], fb[2]; float ps = 0.f; unsigned c0, c1;
    KRD(fa, 0); KRD(fb, 1);
    KMM(fa, 0, 2); KRD(fa, 2); EXPY(0); ADDY(y0, 0); CVA(y0, 0); SBAR();
    KMM(fb, 1, 2); KRD(fb, 3); EXPY(1); ADDY(y0, 1); ADDY(y1, 0); CVB(y0, 0, pa0); SBAR();
    KMM(fa, 2, 2); KRD(fa, 4); EXPY(2); ADDY(y0, 2); ADDY(y1, 1); CVA(y0, 8); SBAR();
    KMM(fb, 3, 2); KRD(fb, 5); EXPY(3); ADDY(y0, 3); ADDY(y1, 2); CVB(y0, 8, pa1); SBAR();
    KMM(fa, 4, 2); KRD(fa, 6); EXPY(4); ADDY(y0, 4); ADDY(y1, 3); CVA(y1, 0); SBAR();
    KMM(fb, 5, 2); KRD(fb, 7); EXPY(5); ADDY(y0, 5); ADDY(y1, 4); CVB(y1, 0, pa2); SBAR();
    KMM(fa, 6, 2);             EXPY(6); ADDY(y0, 6); ADDY(y1, 5); CVA(y1, 8); SBAR();
    KMM(fb, 7, 0);             EXPY(7); ADDY(y0, 7); ADDY(y1, 6); SBAR();
    ADDY(y1, 7); CVB(y1, 8, pa3);
    { auto rr = __builtin_amdgcn_permlane32_swap(__float_as_uint(ps), __float_as_uint(ps), false, false); ps = __uint_as_float(rr[0]) + __uint_as_float(rr[1]); }
    l_reg = l_reg * alY + ps;
#undef KRD
#undef KMM
#undef EXPY
#undef ADDY
#undef CVA
#undef CVB
}
__device__ __forceinline__ void pv_par(f32x16* o, int vb0, bf16x8 pa0, bf16x8 pa1, bf16x8 pa2, bf16x8 pa3, f32x16& x0, f32x16& x1, float& m_reg, float& alpha, bool keep) {
#define TRRD(dst, off) asm volatile("ds_read_b64_tr_b16 %0, %1 offset:%2" : "=&v"(dst) : "v"(vb0), "i"(off) : "memory")
#define PV_R(d0, ks, l, h) do { TRRD(l, v_rd_off(d0, 0, 0) + (ks) * 4096); TRRD(h, v_rd_off(d0, 0, 0) + (ks) * 4096 + 2048); } while (0)
#define PV_M(d0, pa, l, h, n_) do { asm volatile("s_waitcnt lgkmcnt(" #n_ ")" ::: "memory"); SBAR();                                \
        o[d0] = __builtin_amdgcn_mfma_f32_32x32x16_bf16(pa, (bf16x8){l[0], l[1], l[2], l[3], h[0], h[1], h[2], h[3]}, o[d0], 0, 0, 0); SBAR(); } while (0)
#define MX8(t, X, b) do { t = fmaxf(fmaxf(X[b], X[b + 1]), X[b + 2]); t = fmaxf(fmaxf(t, X[b + 3]), X[b + 4]); t = fmaxf(fmaxf(t, X[b + 5]), X[b + 6]); t = fmaxf(t, X[b + 7]); } while (0)
#define FM4(j) do { x0[2 * (j)] = fmaf(x0[2 * (j)], C2, mnL); x0[2 * (j) + 1] = fmaf(x0[2 * (j) + 1], C2, mnL); x1[2 * (j)] = fmaf(x1[2 * (j)], C2, mnL); x1[2 * (j) + 1] = fmaf(x1[2 * (j) + 1], C2, mnL); } while (0)
#define EX0(e) x0[e] = __builtin_amdgcn_exp2f(x0[e])
    constexpr float C2 = 1.4426950408889634f * SCALE;
    s16x4 l0, l1, l2, l3, h0, h1, h2, h3; float t0, t1, t2, t3, pmax, mnL;
    PV_R(0, 0, l0, h0); PV_R(0, 1, l1, h1); PV_R(0, 2, l2, h2); PV_R(0, 3, l3, h3);
    PV_M(0, pa0, l0, h0, 6); PV_R(1, 0, l0, h0); MX8(t0, x0, 0); SBAR();
    PV_M(0, pa1, l1, h1, 6); PV_R(1, 1, l1, h1); MX8(t1, x0, 8); SBAR();
    PV_M(0, pa2, l2, h2, 6); PV_R(1, 2, l2, h2); MX8(t2, x1, 0); SBAR();
    PV_M(0, pa3, l3, h3, 6); PV_R(1, 3, l3, h3); MX8(t3, x1, 8); SBAR();
    PV_M(1, pa0, l0, h0, 6); PV_R(2, 0, l0, h0);
    { pmax = fmaxf(fmaxf(t0, t1), fmaxf(t2, t3)); auto rr = __builtin_amdgcn_permlane32_swap(__float_as_uint(pmax), __float_as_uint(pmax), false, false); pmax = fmaxf(__uint_as_float(rr[0]), __uint_as_float(rr[1])); pmax = keep ? pmax : -__builtin_inff(); } SBAR();
    PV_M(1, pa1, l1, h1, 6); PV_R(2, 1, l1, h1);
    { const bool ok = __all((pmax - m_reg) * SCALE <= THR) != 0;
      const float mn = ok ? m_reg : fmaxf(m_reg, pmax); alpha = __builtin_amdgcn_exp2f((m_reg - mn) * C2); m_reg = mn; mnL = keep ? -mn * C2 : -__builtin_inff(); } SBAR();
    PV_M(1, pa2, l2, h2, 6); PV_R(2, 2, l2, h2); FM4(0); SBAR();
    PV_M(1, pa3, l3, h3, 6); PV_R(2, 3, l3, h3); FM4(1); EX0(0); SBAR();
    PV_M(2, pa0, l0, h0, 6); PV_R(3, 0, l0, h0); FM4(2); EX0(1); SBAR();
    PV_M(2, pa1, l1, h1, 6); PV_R(3, 1, l1, h1); FM4(3); EX0(2); SBAR();
    PV_M(2, pa2, l2, h2, 6); PV_R(3, 2, l2, h2); FM4(4); EX0(3); SBAR();
    PV_M(2, pa3, l3, h3, 6); PV_R(3, 3, l3, h3); FM4(5); EX0(4); SBAR();
    PV_M(3, pa0, l0, h0, 6); FM4(6); EX0(5); SBAR();
    PV_M(3, pa1, l1, h1, 4); FM4(7); EX0(6); SBAR();
    PV_M(3, pa2, l2, h2, 2); EX0(7); EX0(8); EX0(9); SBAR();
    PV_M(3, pa3, l3, h3, 0); EX0(10); EX0(11); EX0(12); SBAR();
    EX0(13); EX0(14); EX0(15);
#undef TRRD
#undef PV_R
#undef PV_M
#undef MX8
#undef FM4
#undef EX0
}

struct BlockRef { int b, h, qb; };
struct Bases { const bf16* proj; bf16* mixed; float* ssq; const float* kpart; };
__device__ __forceinline__ const bf16* refQ(const Bases& B, const BlockRef& r) { return B.proj + ((size_t)(r.b * SEQ + r.qb * QB) * LDQ + r.h * D); }
__device__ __forceinline__ const bf16* refK(const Bases& B, const BlockRef& r) { return B.proj + (size_t)M_TOK * LDQ + ((size_t)(r.b * SEQ) * LDQ + r.h * D); }
__device__ __forceinline__ const bf16* refV(const Bases& B, const BlockRef& r) { return B.proj + (size_t)2 * M_TOK * LDQ + ((size_t)(r.b * SEQ) * LDQ + r.h * D); }
struct Seam { bf16x8 qr[8]; bf16x8 st_v0, st_v1, st_k0, st_k1; };

__device__ __forceinline__ void km_load(const float* kpart, int b, int h, int tid, f32x4& x, f32x4& y) {
    const int j = (tid >> 5) & 7, c = (tid & 31) * 4;
    const float* p = kpart + ((size_t)(b * 8 + j) * 1024 + h * D + c);
    x = *(const f32x4*)p; y = *(const f32x4*)(p + KPART_STRIDE);
}
__device__ __forceinline__ void km_write(char* lds, int tid, f32x4 x, f32x4 y) {
    const int j = (tid >> 5) & 7, c = (tid & 31) * 4; const f32x4 a = x + y;
    const unsigned h0 = cvtpk(a[0], a[1]), h1 = cvtpk(a[2], a[3]);
    const unsigned l0 = cvtpk(a[0] - __uint_as_float(h0 << 16), a[1] - __uint_as_float(h0 & 0xffff0000u)), l1 = cvtpk(a[2] - __uint_as_float(h1 << 16), a[3] - __uint_as_float(h1 & 0xffff0000u));
    typedef unsigned u32x2 __attribute__((ext_vector_type(2)));
    if (tid < 256) { *(u32x2*)(lds + KM_OFF + j * KM_PITCH + c * 2) = (u32x2){h0, h1}; *(u32x2*)(lds + KM_OFF + (8 + j) * KM_PITCH + c * 2) = (u32x2){l0, l1}; }
}
__device__ __forceinline__ unsigned moba_select(const bf16x8* qr, const char* lds, int own, int r32, int hi) {
    if (own == 0) return 0u;
    f32x16 g = f32x16{};
    const bool act = r32 < 16;
    const char* kmf = lds + KM_OFF + (r32 & 15) * KM_PITCH + hi * 16;
#pragma unroll
    for (int d0 = 0; d0 < 8; ++d0) {
        bf16x8 f = *(const bf16x8*)(kmf + d0 * 32);
        if (!act) f = (bf16x8){0, 0, 0, 0, 0, 0, 0, 0};
        g = __builtin_amdgcn_mfma_f32_32x32x16_bf16(f, qr[d0], g, 0, 0, 0);
    }
    float G[8];
#pragma unroll
    for (int i = 0; i < 4; ++i) { const float v = g[i] + g[4 + i];
        auto rr = __builtin_amdgcn_permlane32_swap(__float_as_uint(v), __float_as_uint(v), false, false);
        G[i] = __uint_as_float(rr[0]); G[4 + i] = __uint_as_float(rr[1]); }
    unsigned sel = 0u;
#pragma unroll
    for (int a = 0; a < 8; ++a) { int cnt = 0;
#pragma unroll
        for (int b = 0; b < 8; ++b) { if (b == a) continue;
            const bool beats = (b < a) ? (G[b] >= G[a]) : (G[b] > G[a]);
            cnt += (b < own && beats) ? 1 : 0; }
        sel |= (a < own && cnt < 3) ? (1u << a) : 0u; }
    return sel;
}

#define ROW(p, k0, rr) ((p) + (size_t)((k0) + (rr)) * LDQ + sc)
#define VMW() asm volatile("s_waitcnt vmcnt(0)" ::: "memory")
#define VMWN(n) asm volatile("s_waitcnt vmcnt(%0)" :: "i"(n) : "memory")
#define SLOAD_H(Kp, Vp, k0) do { S.st_v0 = load8(ROW(Vp, k0, sr)); S.st_v1 = load8(ROW(Vp, k0, 32 + sr));              \
                         S.st_k0 = load8(ROW(Kp, k0, sr)); S.st_k1 = load8(ROW(Kp, k0, 32 + sr)); } while (0)
#define SWRITE_HK(bf) do { *(bf16x8*)(K_lds + (bf) * SHM_K + kws) = S.st_k0; *(bf16x8*)(K_lds + (bf) * SHM_K + kws + 32 * 128) = S.st_k1; } while (0)
#define SWRITE_HV(bf) do { *(bf16x8*)(V_lds + (bf) * SHM_V + vst0) = S.st_v0; *(bf16x8*)(V_lds + (bf) * SHM_V + vst1) = S.st_v1; } while (0)
#define SWRITE_H(bf) do { SWRITE_HV(bf); SWRITE_HK(bf); } while (0)
__device__ __forceinline__ void moba_prime(const Bases& B, const BlockRef& cur, char* lds, Seam& S) {
    int tid_ = threadIdx.x; asm volatile("" : "+v"(tid_));
    const int tid = tid_, wid = __builtin_amdgcn_readfirstlane(tid >> 6), lane = tid & 63, r32 = lane & 31, hi = lane >> 5;
    const int sr = tid >> 4, sc = (tid & 15) * 8, kws = KSWZ(sr, sc * 2); char* K_lds = lds + NVB * SHM_V;
#pragma unroll
    for (int d0 = 0; d0 < 8; ++d0) S.qr[d0] = load8(refQ(B, cur) + (size_t)(wid * QBLK + r32) * LDQ + d0 * 16 + hi * 8);
    f32x4 kx, ky; km_load(B.kpart, cur.b, cur.h, tid, kx, ky);
    { const bf16* Kp = refK(B, cur); const bf16* Vp = refV(B, cur); SLOAD_H(Kp, Vp, 0); } VMW(); SWRITE_HK(0); km_write(lds, tid, kx, ky);
    __syncthreads();
}
template <bool ORDA> __device__ __forceinline__ void moba_block(const Bases& B, const BlockRef& cur, const BlockRef& nxt, char* lds, Seam& S) {
    int tid_ = threadIdx.x; asm volatile("" : "+v"(tid_));
    const int tid = tid_, wid = __builtin_amdgcn_readfirstlane(tid >> 6), lane = tid & 63, r32 = lane & 31, hi = lane >> 5;
    const int own = cur.qb, P0 = cur.qb * QB;
    const int NT = (P0 + QB) / KVBLK;
    const int qlo = P0 + wid * QBLK, qm = qlo + r32 - 4 * hi;
    char* V_lds = lds; char* K_lds = lds + NVB * SHM_V;
    float* ws = (float*)(lds + NVB * SHM_V + 2 * SHM_K) + wid * 64; float* li_l = ws, * al_l = ws + 32;
    float m_reg = -1e30f, l_reg = 0; f32x16 o[4] = {};
    const int sr = tid >> 4, sc = (tid & 15) * 8, vst0 = v_st(sr, sc), vst1 = v_st(32 + sr, sc), kws = KSWZ(sr, sc * 2);
    const int vb0 = (int)(uintptr_t)V_lds + v_rd_base(lane);
    const bf16* Kh = refK(B, cur); const bf16* Vh = refV(B, cur);
#define RESC(a) do { if (__any((a) < 1.f)) { if (hi == 0) al_l[r32] = (a); asm volatile("s_waitcnt lgkmcnt(0)" ::: "memory");              \
                     for (int d_ = 0; d_ < 4; ++d_) for (int r = 0; r < 16; ++r) o[d_][r] *= al_l[crow(r, hi)]; } } while (0)
#define KBASE(t) ((t) * KVBLK)
#define MASKT(P0_, P1_, t) do { const int kb_ = KBASE(t); const int jb_ = (t) >> 2;                                             \
        if (jb_ == own) { if (kb_ + KVBLK - 1 > qlo) mask_tile(P0_, P1_, qm - kb_); }                                          \
        else { const bool keep_ = ((selm >> jb_) & 1u) != 0u; if (!__all(keep_)) mask_all(P0_, P1_, keep_); } } while (0)
#define SEAM_K0() do { VMWN(8); SWRITE_HK(0); SBAR(); } while (0)
    f32x16 pA0, pA1, pB0, pB1; float mnA, mnB, alA, alB; bf16x8 pa0, pa1, pa2, pa3;
    SWRITE_HV(0); SBAR();
    if (NT > 1) { SLOAD_H(Kh, Vh, KBASE(1)); }
    SBAR();
    const unsigned selm = moba_select(S.qr, lds, own, r32, hi);
    SBAR(); qkt<0>(pA0, pA1, K_lds, r32, hi, S.qr);
    MASKT(pA0, pA1, 0); partialSM(pA0, pA1, m_reg, mnA, alA);
    if (NT > 1) { VMW(); SWRITE_H(1); }
    __syncthreads();
    int vp = 0;
#define HALF_STEP(PX0, PX1, alX, PY0, PY1, alY, t, KB, SB, CAUSAL) do {                                                       \
        const int vrd_ = vb0 + vp * SHM_V, vw_ = (vp == 0 ? 2 : vp - 1); const int jb_ = (t) >> 2;                            \
        SBAR(); qk_fin<KB>(PX0, PX1, PY0, PY1, alY, l_reg, pa0, pa1, pa2, pa3, K_lds, r32, hi, S.qr); SBAR();                 \
        if ((t) + 1 < NT) { SLOAD_H(Kh, Vh, KBASE((t) + 1)); SBAR(); }                                                        \
        if (CAUSAL) { mask_tile(PX0, PX1, qm - KBASE(t)); SBAR(); }           \
        const bool keep_ = (jb_ == own) || (((selm >> jb_) & 1u) != 0u);                                                      \
        pv_par(o, vrd_, pa0, pa1, pa2, pa3, PX0, PX1, m_reg, alX, keep_); SBAR();                                             \
        if ((t) + 1 < NT) { VMW(); SWRITE_HK(SB); *(bf16x8*)(V_lds + vw_ * SHM_V + vst0) = S.st_v0; *(bf16x8*)(V_lds + vw_ * SHM_V + vst1) = S.st_v1; } \
        RESC(alX); vp = (vp == 2 ? 0 : vp + 1); __syncthreads(); } while (0)
    int t = 1;
    for (; t + 1 < NT - 4; t += 2) {
        HALF_STEP(pB0, pB1, alB, pA0, pA1, alA, t, 1, 0, 0);
        HALF_STEP(pA0, pA1, alA, pB0, pB1, alB, t + 1, 0, 1, 0);
    }
    for (; t + 1 < NT; t += 2) {
        HALF_STEP(pB0, pB1, alB, pA0, pA1, alA, t, 1, 0, 1);
        HALF_STEP(pA0, pA1, alA, pB0, pB1, alB, t + 1, 0, 1, 1);
    }
    SBAR(); qkt_c<1>(pB0, pB1, K_lds, r32, hi, S.qr); SBAR();
    { const bf16* Kn = refK(B, nxt); const bf16* Vn = refV(B, nxt); SLOAD_H(Kn, Vn, 0); } SBAR();
#pragma unroll
    for (int d0 = 0; d0 < 8; ++d0) S.qr[d0] = load8(refQ(B, nxt) + (size_t)(wid * QBLK + r32) * LDQ + d0 * 16 + hi * 8);
    SBAR();
    finishSM(pA0, pA1, alA, l_reg, pa0, pa1, pa2, pa3); SBAR();
    pv_tile(o, vb0 + vp * SHM_V, pa0, pa1, pa2, pa3); vp = (vp == 2 ? 0 : vp + 1);
    MASKT(pB0, pB1, NT - 1); partialSM(pB0, pB1, m_reg, mnB, alB); __syncthreads(); RESC(alB);
    finishSM(pB0, pB1, alB, l_reg, pa0, pa1, pa2, pa3); SBAR(); pv_tile(o, vb0 + vp * SHM_V, pa0, pa1, pa2, pa3);
    SBAR(); SEAM_K0();
    if (hi == 0) li_l[r32] = l_reg; asm volatile("s_waitcnt lgkmcnt(0)" ::: "memory");
    int hi4 = 4 * hi; asm volatile("" : "+v"(hi4));
    float rli[16];
#pragma unroll
    for (int r = 0; r < 16; ++r) rli[r] = __builtin_amdgcn_rcpf(li_l[crow(r, 0) + hi4]);
    const size_t orow0 = (size_t)(cur.b * SEQ + P0 + wid * QBLK);
    unsigned char* Ob = (unsigned char*)B.mixed + orow0 * MIX_PITCH + cur.h * D; float* sqw = B.ssq + orow0 * 8 + cur.h;
    unsigned short* stg = (unsigned short*)(lds + LDS_BYTES) + wid * (QBLK * D);
#pragma unroll
    for (int r = 0; r < 16; ++r) { const int orow = crow(r, 0) + hi4;
#pragma unroll
        for (int d0 = 0; d0 < 4; ++d0) { const float v = o[d0][r] * rli[r]; stg[orow * D + d0 * 32 + r32] = (unsigned short)cvtpk(v, v); } }
    asm volatile("s_waitcnt lgkmcnt(0)" ::: "memory");
    int lrow = lane >> 4; asm volatile("" : "+v"(lrow));
    f32x4 kx, ky; km_load(B.kpart, nxt.b, nxt.h, tid, kx, ky);
#pragma unroll
    for (int i = 0; i < 8; ++i) { const int row = 4 * i + lrow, ch = lane & 15;
        const u32x4 w = *(const u32x4*)(stg + row * D + ch * 8);
        float a = 0.f; int q8[2] = {0, 0};
#pragma unroll
        for (int e = 0; e < 4; ++e) { const float lo = __uint_as_float(w[e] << 16), hi_ = __uint_as_float(w[e] & 0xffff0000u); a += lo * lo + hi_ * hi_;
            if (e & 1) q8[e >> 1] = __builtin_amdgcn_cvt_pk_fp8_f32(lo * AQ_SCALE, hi_ * AQ_SCALE, q8[e >> 1], true);
            else       q8[e >> 1] = __builtin_amdgcn_cvt_pk_fp8_f32(lo * AQ_SCALE, hi_ * AQ_SCALE, q8[e >> 1], false); }
        typedef int i32x2 __attribute__((ext_vector_type(2)));
        *(i32x2*)(Ob + (size_t)row * MIX_PITCH + ch * 8) = (i32x2){q8[0], q8[1]};
        a += __shfl_xor(a, 1); a += __shfl_xor(a, 2); a += __shfl_xor(a, 4); a += __shfl_xor(a, 8);
        if (ch == 0) sqw[row * 8] = a;
        SBAR(); }
    km_write(lds, tid, kx, ky);
    __syncthreads();
#undef RESC
#undef KBASE
#undef MASKT
#undef SEAM_K0
#undef HALF_STEP
}
#undef ROW
#undef VMW
#undef VMWN
#undef SLOAD_H
#undef SWRITE_HK
#undef SWRITE_HV
#undef SWRITE_H
#undef SBAR
#undef KSWZ
}

#ifndef PH_MASK
#define PH_MASK 0x7f
#endif
#ifndef DUP_MASK
#define DUP_MASK 0
#endif
#define NREP(k) (1 + ((DUP_MASK >> (k)) & 1))
constexpr int NWAVES = 8;
constexpr size_t MiB = 1u << 20;
constexpr size_t WS_CTL = 0, CTL_ZERO_BYTES = 1 * MiB;
constexpr size_t CTL_STATS1 = 0, CTL_STATS2 = 128 * 1024, CTL_C1 = 256 * 1024, CTL_C2 = 288 * 1024, CTL_BAR = 512 * 1024;
constexpr size_t WS_KPART = 1 * MiB;
constexpr size_t WS_SSQ = WS_KPART + 512 * 1024;
constexpr size_t WS_XS = 2 * MiB;
constexpr size_t WS_WIN = 4 * MiB;
constexpr size_t WS_WIN8 = 12 * MiB;
constexpr size_t WS_WO = 20 * MiB;
constexpr size_t WS_WUP = 28 * MiB;
constexpr size_t WS_WDN = 44 * MiB;
constexpr size_t WS_XB = 64 * MiB;
constexpr size_t WS_X8 = 128 * MiB;
constexpr size_t WS_PROJ = 160 * MiB;
constexpr size_t WS_R = 64 * MiB;
constexpr size_t WS_MIXED = 320 * MiB;
constexpr size_t WS_Z = 320 * MiB;
constexpr size_t WS_YB = 384 * MiB;
constexpr size_t WS_Y8 = 448 * MiB;
constexpr size_t WS_END = 480 * MiB;
constexpr size_t CTL_CNT = 768 * 1024, CTL_CNT_DUMMY = 832 * 1024;
constexpr size_t CTL_DUMMY = 640 * 1024;
constexpr int RING_BYTES = 131072, LDS_BYTES = 155648, MISC_OFF = LDS_BYTES - 64;

typedef unsigned short bf16;
typedef float f32x4 __attribute__((ext_vector_type(4)));
typedef unsigned v4u __attribute__((ext_vector_type(4)));
#define LAS __attribute__((address_space(3)))
#define LDS_WAIT() asm volatile("s_waitcnt lgkmcnt(0)" ::: "memory")
__device__ __forceinline__ unsigned pkbf(float lo, float hi) { unsigned r; asm volatile("v_cvt_pk_bf16_f32 %0, %1, %2" : "=v"(r) : "v"(lo), "v"(hi)); return r; }
__device__ __forceinline__ float wave_sum(float v) {
#pragma unroll
    for (int o = 1; o < 64; o <<= 1) v += __shfl_xor(v, o);
    return v;
}
__device__ __forceinline__ void p0_transpose_item(const float* W, int K, int N, bf16* WT, const float* gain, const float* bvec, float* c1, float* c2, LAS float* scr, int item, int lane, int pairgates = 0, int pitchB = 0, int boff = 0) {
    const int nblk = N / 64, kb = item / nblk, nb = item % nblk, k0 = 64 * kb, n0 = 64 * nb;
    const int nd0 = n0; (void)pairgates;
#pragma unroll
    for (int i = 0; i < 16; ++i) { const int kk = 4 * i + (lane >> 4), nn = 4 * (lane & 15);
        const f32x4 v = __builtin_nontemporal_load((const f32x4*)(W + (size_t)(k0 + kk) * N + n0 + nn));
        scr[kk * 65 + nn] = v[0]; scr[kk * 65 + nn + 1] = v[1]; scr[kk * 65 + nn + 2] = v[2]; scr[kk * 65 + nn + 3] = v[3]; }
    LDS_WAIT(); asm volatile("" ::: "memory");
    const int c = lane & 7;
    float gk[8], bk[8];
#pragma unroll
    for (int e = 0; e < 8; ++e) { gk[e] = gain ? gain[k0 + 8 * c + e] : 1.0f; bk[e] = bvec ? bvec[k0 + 8 * c + e] : 0.0f; }
#pragma unroll
    for (int j = 0; j < 8; ++j) { const int n = (lane >> 3) + 8 * j; const LAS float* s = scr + (8 * c) * 65 + n;
        float w[8];
#pragma unroll
        for (int e = 0; e < 8; ++e) w[e] = s[e * 65];
        v4u o; o.x = pkbf(w[0] * gk[0], w[1] * gk[1]); o.y = pkbf(w[2] * gk[2], w[3] * gk[3]); o.z = pkbf(w[4] * gk[4], w[5] * gk[5]); o.w = pkbf(w[6] * gk[6], w[7] * gk[7]);
        if (pitchB) *(v4u*)((unsigned char*)WT + (size_t)(nd0 + n) * pitchB + boff + 2 * (k0 + 8 * c)) = o; else *(v4u*)(WT + (size_t)(nd0 + n) * K + k0 + 8 * c) = o;
        if (c1) {
            float s1 = (__uint_as_float(o.x << 16) + __uint_as_float(o.x & 0xffff0000u)) + (__uint_as_float(o.y << 16) + __uint_as_float(o.y & 0xffff0000u))
                     + (__uint_as_float(o.z << 16) + __uint_as_float(o.z & 0xffff0000u)) + (__uint_as_float(o.w << 16) + __uint_as_float(o.w & 0xffff0000u));
            float s2 = 0.f;
#pragma unroll
            for (int e = 0; e < 8; ++e) s2 += w[e] * bk[e];
            s1 += __shfl_xor(s1, 1); s1 += __shfl_xor(s1, 2); s1 += __shfl_xor(s1, 4);
            s2 += __shfl_xor(s2, 1); s2 += __shfl_xor(s2, 2); s2 += __shfl_xor(s2, 4);
            if (c == 0) { (void)__hip_atomic_fetch_add(c1 + n0 + n, s1, __ATOMIC_RELAXED, __HIP_MEMORY_SCOPE_AGENT); (void)__hip_atomic_fetch_add(c2 + n0 + n, s2, __ATOMIC_RELAXED, __HIP_MEMORY_SCOPE_AGENT); }
        } }
    LDS_WAIT(); asm volatile("" ::: "memory");
}

#define XB_TMO      128
#define XB_XCNT(j)  (256  + 64 * (j))
#define XB_XSUB(j)  (1280 + 64 * (j))
#define XB_XGEN(j)  (2304 + 64 * (j))
#define XB_TOP      3328
#define XB_TOPGEN   3392
#define XCD_BAR_WORDS 3456
#define XB_SPIN_CAP (1u << 18)

__device__ __forceinline__ unsigned xb_ld(unsigned* p)              { return __hip_atomic_load(p, __ATOMIC_RELAXED, __HIP_MEMORY_SCOPE_AGENT); }
__device__ __forceinline__ unsigned xb_add(unsigned* p, unsigned v) { return __hip_atomic_fetch_add(p, v, __ATOMIC_RELAXED, __HIP_MEMORY_SCOPE_AGENT); }
__device__ __forceinline__ unsigned xb_xcc_id() { return (unsigned)__builtin_amdgcn_s_getreg((3 << 11) | 20) & 0xFu; }
#define XB_SPIN(cond, bar) do { unsigned _sp = 0; while (cond) { __builtin_amdgcn_s_sleep(1); \
    if ((++_sp & 255u) == 0u) { if (xb_ld(&(bar)[XB_TMO])) break; if (_sp > XB_SPIN_CAP) { atomicAdd(&(bar)[XB_TMO], 1u); break; } } } } while (0)

struct XcdBarrier {
    unsigned* bar; unsigned x;
    volatile LAS unsigned* st;
};

__device__ __forceinline__ XcdBarrier xcd_barrier_post(unsigned* bar, volatile LAS unsigned* st) {
    XcdBarrier b; b.bar = bar; b.x = xb_xcc_id(); b.st = st;
    if (threadIdx.x == 0) (void)xb_add(&bar[XB_XCNT(b.x)], 1u);
    return b;
}
__device__ __forceinline__ void xcd_barrier_complete(unsigned* bar, unsigned x, unsigned& nloc, unsigned& nx) {
    const unsigned G = gridDim.x * gridDim.y * gridDim.z;
    unsigned sum, cnt, mine, sp = 0u;
    for (;;) {
        sum = 0u; cnt = 0u; mine = 0u;
#pragma unroll
        for (unsigned j = 0; j < 16; ++j) { const unsigned c = xb_ld(&bar[XB_XCNT(j)]); sum += c; cnt += (c > 0u) ? 1u : 0u; mine = (j == x) ? c : mine; }
        if (sum == G) break;
        __builtin_amdgcn_s_sleep(1);
        if ((++sp & 255u) == 0u) { if (xb_ld(&bar[XB_TMO])) break; if (sp > XB_SPIN_CAP) { atomicAdd(&bar[XB_TMO], 1u); break; } }
    }
    nloc = mine > 0u ? mine : 1u; nx = cnt > 0u ? cnt : 1u;
}

__device__ __forceinline__ void xcd_barrier(const XcdBarrier& b) {
    asm volatile("s_waitcnt vmcnt(0)" ::: "memory");
    __syncthreads();
    if (threadIdx.x == 0) {
        unsigned* bar = b.bar;
        __builtin_amdgcn_s_waitcnt(0);
        unsigned nloc = b.st[0], nx = b.st[1];
        if (nloc == 0u) { xcd_barrier_complete(bar, b.x, nloc, nx); b.st[0] = nloc; b.st[1] = nx; }
        const unsigned old = xb_add(&bar[XB_XSUB(b.x)], 1u);
        const unsigned gen = old / nloc;
        if (old + 1u == (gen + 1u) * nloc) {
            __builtin_amdgcn_fence(__ATOMIC_RELEASE, "agent");
            asm volatile("s_waitcnt vmcnt(0)" ::: "memory");
            const unsigned og = xb_add(&bar[XB_TOP], 1u);
            const unsigned tg = og / nx;
            if (og + 1u == (tg + 1u) * nx) xb_add(&bar[XB_TOPGEN], 1u);
            else XB_SPIN(xb_ld(&bar[XB_TOPGEN]) == tg, bar);
            __builtin_amdgcn_fence(__ATOMIC_ACQUIRE, "agent");
            xb_add(&bar[XB_XGEN(b.x)], 1u);
            asm volatile("s_waitcnt vmcnt(0)" ::: "memory");
        } else {
            XB_SPIN(xb_ld(&bar[XB_XGEN(b.x)]) == gen, bar);
            __builtin_amdgcn_fence(__ATOMIC_ACQUIRE, "agent");
            asm volatile("s_waitcnt vmcnt(0)" ::: "memory");
        }
    }
    __syncthreads();
}

__device__ __forceinline__ void p0_transpose_item_i8(const float* W, int K, int N, unsigned char* WT, int nd0, const float* gain, const float* bvec, float* c1, float* c2, LAS float* scr, int item, int lane) {
    const int nblk = N / 64, kb = item / nblk, nb = item % nblk, k0 = 64 * kb, n0 = 64 * nb;
#pragma unroll
    for (int i = 0; i < 16; ++i) { const int kk = 4 * i + (lane >> 4), nn = 4 * (lane & 15);
        const f32x4 v = __builtin_nontemporal_load((const f32x4*)(W + (size_t)(k0 + kk) * N + n0 + nn));
        scr[kk * 65 + nn] = v[0]; scr[kk * 65 + nn + 1] = v[1]; scr[kk * 65 + nn + 2] = v[2]; scr[kk * 65 + nn + 3] = v[3]; }
    LDS_WAIT(); asm volatile("" ::: "memory");
    const int c = lane & 7;
    float gk[8], bk[8];
#pragma unroll
    for (int e = 0; e < 8; ++e) { gk[e] = (gain ? gain[k0 + 8 * c + e] : 1.0f) * WQ_SCALE; bk[e] = bvec ? bvec[k0 + 8 * c + e] : 0.0f; }
#pragma unroll
    for (int j = 0; j < 8; ++j) { const int n = (lane >> 3) + 8 * j; const LAS float* s = scr + (8 * c) * 65 + n;
        float w[8], s1 = 0.f, s2 = 0.f;
#pragma unroll
        for (int e = 0; e < 8; ++e) { w[e] = s[e * 65]; s2 += w[e] * bk[e]; w[e] = __builtin_rintf(__builtin_amdgcn_fmed3f(w[e] * gk[e], -127.f, 127.f)); s1 += w[e]; }
        typedef unsigned u32x2 __attribute__((ext_vector_type(2)));
        *(u32x2*)(WT + (size_t)(nd0 + n) * K + k0 + 8 * c) = (u32x2){pg8::pack_i8x4((f32x4){w[0], w[1], w[2], w[3]}), pg8::pack_i8x4((f32x4){w[4], w[5], w[6], w[7]})};
        if (c1) { s1 *= WQ_INV;
            s1 += __shfl_xor(s1, 1); s1 += __shfl_xor(s1, 2); s1 += __shfl_xor(s1, 4);
            s2 += __shfl_xor(s2, 1); s2 += __shfl_xor(s2, 2); s2 += __shfl_xor(s2, 4);
            if (c == 0) { (void)__hip_atomic_fetch_add(c1 + n0 + n, s1, __ATOMIC_RELAXED, __HIP_MEMORY_SCOPE_AGENT); (void)__hip_atomic_fetch_add(c2 + n0 + n, s2, __ATOMIC_RELAXED, __HIP_MEMORY_SCOPE_AGENT); } } }
    LDS_WAIT(); asm volatile("" ::: "memory");
}

__device__ __forceinline__ void p0_transpose_item_fp8(const float* W, int K, int N, unsigned char* WT, float scale, LAS float* scr, int item, int lane, const float* gain = nullptr, int pitchB = 0) {
    const int nblk = N / 64, kb = item / nblk, nb = item % nblk, k0 = 64 * kb, n0 = 64 * nb;
#pragma unroll
    for (int i = 0; i < 16; ++i) { const int kk = 4 * i + (lane >> 4), nn = 4 * (lane & 15);
        const f32x4 v = __builtin_nontemporal_load((const f32x4*)(W + (size_t)(k0 + kk) * N + n0 + nn));
        scr[kk * 65 + nn] = v[0]; scr[kk * 65 + nn + 1] = v[1]; scr[kk * 65 + nn + 2] = v[2]; scr[kk * 65 + nn + 3] = v[3]; }
    LDS_WAIT(); asm volatile("" ::: "memory");
    const int c = lane & 7;
#pragma unroll
    for (int j = 0; j < 8; ++j) { const int n = (lane >> 3) + 8 * j; const LAS float* s = scr + (8 * c) * 65 + n;
        float w[8];
#pragma unroll
        for (int e = 0; e < 8; ++e) w[e] = s[e * 65] * (gain ? gain[k0 + 8 * c + e] * scale : scale);
        int w0 = __builtin_amdgcn_cvt_pk_fp8_f32(w[0], w[1], 0, false); w0 = __builtin_amdgcn_cvt_pk_fp8_f32(w[2], w[3], w0, true);
        int w1 = __builtin_amdgcn_cvt_pk_fp8_f32(w[4], w[5], 0, false); w1 = __builtin_amdgcn_cvt_pk_fp8_f32(w[6], w[7], w1, true);
        typedef int i32x2 __attribute__((ext_vector_type(2)));
        *(i32x2*)(WT + (size_t)(n0 + n) * (pitchB ? pitchB : K) + k0 + 8 * c) = (i32x2){w0, w1}; }
    LDS_WAIT(); asm volatile("" ::: "memory");
}

__device__ __forceinline__ void p0_prologue(const float* x, const float* w_in, const float* w_o, const float* w_up, const float* w_down, const float* attn_g, const float* conv_g, const float* ln1_g, const float* ln1_b,
        bf16* WinT, unsigned char* Win8, bf16* WoT, unsigned char* Wup8, bf16* WdnT, bf16* XB, unsigned char* X8, float* xs, float* c1, float* c2, unsigned char* lds, int wave, int lane, int tid, int gw, int NGW, int G, int bx) {
        for (int row = gw; row < M_TOK; row += NGW) {
            f32x4 v[4][2]; float mx = 0.f;
#pragma unroll
            for (int j = 0; j < 4; ++j) { const float* p = x + (size_t)row * DM + (j * 64 + lane) * 8;
                v[j][0] = __builtin_nontemporal_load((const f32x4*)p); v[j][1] = __builtin_nontemporal_load((const f32x4*)(p + 4)); }
#pragma unroll
            for (int j = 0; j < 4; ++j)
#pragma unroll
                for (int h = 0; h < 2; ++h)
#pragma unroll
                    for (int e = 0; e < 4; ++e) mx = fmaxf(mx, fabsf(v[j][h][e]));
#pragma unroll
            for (int o = 1; o < 64; o <<= 1) mx = fmaxf(mx, __shfl_xor(mx, o));
            mx = fmaxf(mx, 1e-30f);
            const float inv = 127.0f / mx;
            if (lane == 0) xs[row] = mx * (1.0f / 127.0f);
#pragma unroll
            for (int j = 0; j < 4; ++j) { const size_t off = (size_t)row * DM + (j * 64 + lane) * 8;
                v4u o; o.x = pkbf(v[j][0][0], v[j][0][1]); o.y = pkbf(v[j][0][2], v[j][0][3]); o.z = pkbf(v[j][1][0], v[j][1][1]); o.w = pkbf(v[j][1][2], v[j][1][3]);
                *(v4u*)(XB + off) = o;
                typedef unsigned u32x2 __attribute__((ext_vector_type(2)));
                *(u32x2*)(X8 + off) = (u32x2){pg8::pack_i8x4(v[j][0] * inv), pg8::pack_i8x4(v[j][1] * inv)}; }
        }
        LAS float* scr = (LAS float*)((LAS unsigned char*)lds + wave * 16640);
        constexpr int I_IN = (DM / 64) * (NPROJ / 64), I_O = (DM / 64) * (DM / 64), I_UP = (DM / 64) * (FF / 64), I_DN = (FF / 64) * (DM / 64);
        constexpr int NITEMS = I_IN + I_O + I_UP + I_DN;
        for (int it = gw; it < NITEMS; it += NGW) {
            int r = it;
            if (r < I_UP) { const int nb = r % (FF / 64); p0_transpose_item_i8(w_up, DM, FF, Wup8, 64 * nb, ln1_g, ln1_b, c1, c2, scr, r, lane); continue; } r -= I_UP;
            if (r < I_IN) { const int n0 = 64 * (r % (NPROJ / 64));
                if (n0 < 2048) p0_transpose_item(w_in, DM, NPROJ, WinT, nullptr, nullptr, nullptr, nullptr, scr, r, lane);
                else { int nd0;
                    if (n0 < 4096) nd0 = n0 - 2048; else { const int isu = n0 >= 5120, ch = n0 - (isu ? 5120 : 4096); nd0 = 2048 + (ch >> 7) * 256 + isu * 128 + (ch & 127); }
                    p0_transpose_item_i8(w_in, DM, NPROJ, Win8, nd0, nullptr, nullptr, nullptr, nullptr, scr, r, lane); }
                continue; } r -= I_IN;
            if (r < I_O) { const int kb = r / (DM / 64);
                if (kb < 16) p0_transpose_item_fp8(w_o, DM, DM, (unsigned char*)WoT, WOA_SCALE, scr, r, lane, attn_g, MIX_PITCH);
                else p0_transpose_item(w_o, DM, DM, WoT, conv_g - AW, nullptr, nullptr, nullptr, scr, r, lane, 0, MIX_PITCH, -1024);
                continue; } r -= I_O;
            p0_transpose_item_fp8(w_down, FF, DM, (unsigned char*)WdnT, WDN_SCALE, scr, r, lane);
        }
}

__device__ __forceinline__ void conv_pass(const bf16* PROJ, bf16* MIXED, const float* conv_w, int vcu, int G) {
    int tid_ = threadIdx.x; asm volatile("" : "+v"(tid_));
    const int lane = tid_ & 63, gw = vcu * NWAVES + __builtin_amdgcn_readfirstlane(tid_ >> 6), NGW = G * NWAVES;
        const bf16* Bg = PROJ + (size_t)3 * M_TOK * 1024; const bf16* Zg = PROJ + (size_t)4 * M_TOK * 1024;
        for (int ch = gw; ch < M_TOK / 8; ch += NGW) {
            const int r0 = ch * 8;
            float w0[16], w1[16], w2[16], z1[16], z2[16];
#pragma unroll
            for (int hh = 0; hh < 2; ++hh)
#pragma unroll
                for (int e = 0; e < 8; ++e) { const int cc = hh * 512 + lane * 8 + e; w0[hh * 8 + e] = conv_w[cc]; w1[hh * 8 + e] = conv_w[1024 + cc]; w2[hh * 8 + e] = conv_w[2048 + cc]; z1[hh * 8 + e] = 0.f; z2[hh * 8 + e] = 0.f; }
            auto ldz = [&](int row, float* z) {
#pragma unroll
                for (int hh = 0; hh < 2; ++hh) { const v4u zv = __builtin_nontemporal_load((const v4u*)(Zg + (size_t)row * 1024 + hh * 512 + lane * 8));
#pragma unroll
                    for (int e = 0; e < 4; ++e) { z[hh * 8 + 2 * e] = __uint_as_float(zv[e] << 16); z[hh * 8 + 2 * e + 1] = __uint_as_float(zv[e] & 0xffff0000u); } } };
            if ((r0 & (SEQ - 1)) != 0) { ldz(r0 - 1, z1); ldz(r0 - 2, z2); }
            for (int i = 0; i < 8; ++i) { const int row = r0 + i;
                float z0[16], y[16]; ldz(row, z0);
                float ss = 0.f;
#pragma unroll
                for (int hh = 0; hh < 2; ++hh) { const v4u bv = __builtin_nontemporal_load((const v4u*)(Bg + (size_t)row * 1024 + hh * 512 + lane * 8));
#pragma unroll
                    for (int e = 0; e < 8; ++e) { const int k = hh * 8 + e; const float bb = (e & 1) ? __uint_as_float(bv[e >> 1] & 0xffff0000u) : __uint_as_float(bv[e >> 1] << 16);
                        y[k] = bb * (w0[k] * z2[k] + w1[k] * z1[k] + w2[k] * z0[k]); ss += y[k] * y[k]; } }
                const float rs = __builtin_amdgcn_rsqf(wave_sum(ss) * (1.0f / 1024.0f) + RMS_EPS);
#pragma unroll
                for (int hh = 0; hh < 2; ++hh) { v4u o;
#pragma unroll
                    for (int e = 0; e < 4; ++e) o[e] = pkbf(y[hh * 8 + 2 * e] * rs, y[hh * 8 + 2 * e + 1] * rs);
                    *(v4u*)((bf16*)((unsigned char*)MIXED + (size_t)row * MIX_PITCH + 1024) + hh * 512 + lane * 8) = o; }
#pragma unroll
                for (int k = 0; k < 16; ++k) { z2[k] = z1[k]; z1[k] = z0[k]; } }
        }
}

struct Args { const float* in[12]; float* out; unsigned char* ws; };

__global__ void __launch_bounds__(NWAVES * 64, 2) hymba_fwd(Args args) {
    extern __shared__ __attribute__((aligned(16))) unsigned char lds[];
    const int tid = threadIdx.x, lane = tid & 63, wave = __builtin_amdgcn_readfirstlane(tid >> 6);
    const int G = gridDim.x, bx = blockIdx.x;
    const int vcu = (G % 8 == 0) ? (bx % 8) * (G / 8) + bx / 8 : bx;
    const int gw = vcu * NWAVES + wave, NGW = G * NWAVES;
    unsigned char* ws = args.ws;
    const float* x = args.in[0]; const float* w_in = args.in[1]; const float* conv_w = args.in[2]; const float* attn_g = args.in[3]; const float* conv_g = args.in[4];
    const float* w_o = args.in[5]; const float* ln1_g = args.in[6]; const float* ln1_b = args.in[7]; const float* w_up = args.in[8]; const float* w_down = args.in[9];
    const float* ln2_g = args.in[10]; const float* ln2_b = args.in[11];
    float* stats1 = (float*)(ws + WS_CTL + CTL_STATS1); float* stats2 = (float*)(ws + WS_CTL + CTL_STATS2);
    float* c1 = (float*)(ws + WS_CTL + CTL_C1); float* c2 = (float*)(ws + WS_CTL + CTL_C2);
    float* dummy = (float*)(ws + WS_CTL + CTL_DUMMY);
    float* kpart = (float*)(ws + WS_KPART); float* ssq = (float*)(ws + WS_SSQ);
    bf16* WinT = (bf16*)(ws + WS_WIN); unsigned char* Win8 = ws + WS_WIN8; bf16* WoT = (bf16*)(ws + WS_WO); unsigned char* Wup8 = ws + WS_WUP; bf16* WdnT = (bf16*)(ws + WS_WDN); float* xs = (float*)(ws + WS_XS);
    bf16* XB = (bf16*)(ws + WS_XB); bf16* PROJ = (bf16*)(ws + WS_PROJ); bf16* RB = (bf16*)(ws + WS_R); bf16* MIXED = (bf16*)(ws + WS_MIXED); bf16* YB = (bf16*)(ws + WS_YB); unsigned char* Y8 = ws + WS_Y8; unsigned char* X8 = ws + WS_X8;
    PG8_LAS unsigned char* ldsp = (PG8_LAS unsigned char*)lds;
    volatile LAS unsigned* MISC = (volatile LAS unsigned*)((LAS unsigned char*)lds + MISC_OFF);
    if (tid < 16) MISC[tid] = 0u;
    __syncthreads();
    const XcdBarrier bar = xcd_barrier_post((unsigned*)(ws + WS_CTL + CTL_BAR), MISC + 8);
#define GRID_SYNC() xcd_barrier(bar)

    for (int rep = 0; rep < NREP(0) && (PH_MASK & 1); ++rep) { if (rep) GRID_SYNC();
        p0_prologue(x, w_in, w_o, w_up, w_down, attn_g, conv_g, ln1_g, ln1_b, WinT, Win8, WoT, Wup8, WdnT, XB, X8, xs, rep ? dummy : c1, rep ? dummy + 8192 : c2, lds, wave, lane, tid, gw, NGW, G, bx);
    }
    GRID_SYNC();

    for (int rep = 0; rep < NREP(1) && (PH_MASK & 2); ++rep) { if (rep) GRID_SYNC();
        { pg8::Gemm g{XB, WinT, M_TOK, 2048, DM}; pg8::StaticOrder S; S.init(M_TOK, 2048, G, bx);
          pg8::EpiProj E{PROJ, kpart};
          pg8::gemm_phase<pg8::EpiProj, pg8::StaticOrder, true, true>(ldsp, g, S, E); }
        { pg8::Gemm g{(const bf16*)X8, (const bf16*)Win8, M_TOK, 4096, DM / 2}; pg8::StaticOrder S; S.init(M_TOK, 4096, G, bx);
          pg8::EpiProjI8 E{PROJ, xs};
          pg8::gemm_phase<pg8::EpiProjI8, pg8::StaticOrder, true, true, 3>(ldsp, g, S, E); }
    }
    GRID_SYNC();

    for (int rep = 0; rep < NREP(2) && (PH_MASK & 4); ++rep) { if (rep) GRID_SYNC();
        if (vcu & 1) conv_pass(PROJ, MIXED, conv_w, vcu, G);
        att::Seam S; const att::Bases AB{PROJ, MIXED, ssq, kpart};
        int L = vcu, pass = 0;
        if (L < 256) {
            att::BlockRef cur{L >> 5, (L >> 2) & 7, L & 3};
            att::moba_prime(AB, cur, (char*)lds, S);
            for (;;) {
                const bool more_pass = pass == 0, more_item = L + G < 256, last = !more_pass && !more_item;
                int passn = pass + 1, Ln = L; if (!more_pass) { passn = 0; Ln = more_item ? L + G : L; }
                att::BlockRef nxt{Ln >> 5, (Ln >> 2) & 7, passn ? 7 - (Ln & 3) : (Ln & 3)}; if (last) nxt = cur;
                att::moba_block<true>(AB, cur, nxt, (char*)lds, S);
                if (last) break;
                cur = nxt; pass = passn; L = Ln;
            }
        }
        asm volatile("s_waitcnt vmcnt(0)" ::: "memory");
        if (!(vcu & 1)) conv_pass(PROJ, MIXED, conv_w, vcu, G);
    }
    GRID_SYNC();

    for (int rep = 0; rep < NREP(3) && (PH_MASK & 8); ++rep) { if (rep) GRID_SYNC();
        pg8::Gemm g{MIXED, WoT, M_TOK, DM, MIX_PITCH / 2}; pg8::StaticOrder S; S.init(M_TOK, DM, G, bx);
        pg8::EpiWo E{XB, YB, Y8, rep ? dummy : stats1, ssq};
        pg8::gemm_phase<pg8::EpiWo, pg8::StaticOrder, true, true, 6>(ldsp, g, S, E);
    }
    GRID_SYNC();

    for (int rep = 0; rep < NREP(4) && (PH_MASK & 16); ++rep) { if (rep) GRID_SYNC();
        pg8::Gemm g{(const bf16*)Y8, (const bf16*)Wup8, M_TOK, FF, DM / 2}; pg8::StaticOrder S; S.init(M_TOK, FF, G, bx);
        pg8::EpiUp E{stats1, c1, c2, (unsigned char*)RB};
        pg8::gemm_phase<pg8::EpiUp, pg8::StaticOrder, true, true, 3>(ldsp, g, S, E);
    }
    GRID_SYNC();

    for (int rep = 0; rep < NREP(5) && (PH_MASK & 32); ++rep) { if (rep) GRID_SYNC();
        pg8::Gemm g{RB, WdnT, M_TOK, DM, FF / 2}; pg8::PanelOrder S; S.init(M_TOK, DM, G, bx);
        pg8::EpiDownLN E{Y8, stats1, ln1_g, ln1_b, rep ? dummy : stats2, (unsigned*)(ws + WS_CTL + (rep ? CTL_CNT_DUMMY : CTL_CNT)), ln2_g, ln2_b, args.out};
        pg8::gemm_phase<pg8::EpiDownLN, pg8::PanelOrder, true, true, 2>(ldsp, g, S, E);
    }

    for (int xs = 0; xs < ((DUP_MASK >> 8) & 0xff); ++xs) GRID_SYNC();
    if ((DUP_MASK >> 7) & 1) { GRID_SYNC(); p0_prologue(x, w_in, w_o, w_up, w_down, attn_g, conv_g, ln1_g, ln1_b, WinT, Win8, WoT, Wup8, WdnT, XB, X8, xs, dummy, dummy + 8192, lds, wave, lane, tid, gw, NGW, G, bx); }
}

extern "C" void kernel_launch(void* const* d_in, const int* in_sizes, int n_in, void* d_out, int out_size, void* d_ws, size_t ws_size, hipStream_t stream) {
    static int grid = 0;
    if (grid == 0) {
        if (n_in != 12 || in_sizes[0] != M_TOK * DM || out_size != M_TOK * DM || ws_size < WS_END) {
            fprintf(stderr, "kernel_launch: shape/workspace mismatch (n_in %d, in0 %d, out %d, ws %zu; need ws >= %zu); nothing launched\n", n_in, n_in > 0 ? in_sizes[0] : -1, out_size, ws_size, (size_t)WS_END); grid = -1; return; }
        int dev = 0, cus = 0, per_cu = 0;
        if (hipGetDevice(&dev) != hipSuccess || hipDeviceGetAttribute(&cus, hipDeviceAttributeMultiprocessorCount, dev) != hipSuccess) { fprintf(stderr, "kernel_launch: device query failed\n"); grid = -1; return; }
        if (hipFuncSetAttribute((const void*)hymba_fwd, hipFuncAttributeMaxDynamicSharedMemorySize, LDS_BYTES) != hipSuccess) { fprintf(stderr, "kernel_launch: hipFuncSetAttribute failed\n"); grid = -1; return; }
        if (hipOccupancyMaxActiveBlocksPerMultiprocessor(&per_cu, (const void*)hymba_fwd, NWAVES * 64, LDS_BYTES) != hipSuccess || per_cu < 1) { fprintf(stderr, "kernel_launch: occupancy query says %d blocks per CU\n", per_cu); grid = -1; (void)hipGetLastError(); return; }
        grid = cus;
        if (grid > 256) grid = 256;
    }
    if (grid < 0) return;
    (void)hipMemsetAsync((char*)d_ws + WS_CTL, 0, CTL_ZERO_BYTES, stream);
    Args a{};
    for (int i = 0; i < 12; ++i) a.in[i] = (const float*)d_in[i];
    a.out = (float*)d_out; a.ws = (unsigned char*)d_ws;
    void* kargs[] = {&a};
    hipError_t e = hipLaunchCooperativeKernel((const void*)hymba_fwd, dim3(grid), dim3(NWAVES * 64), kargs, LDS_BYTES, stream);
    if (e != hipSuccess) fprintf(stderr, "kernel_launch: cooperative launch failed: %s (grid %d)\n", hipGetErrorString(e), grid);
}
```

```cpp
#include <hip/hip_runtime.h>
#include <hip/hip_cooperative_groups.h>
#include <cstdio>
#include <cstdint>
namespace cg = cooperative_groups;

constexpr int M_TOK = 16384, DM = 2048, SEQ = 2048, NBATCH = 8, AW = 1024, NPROJ = 6144, FF = 8192, NHEAD = 8, HD = 128, NBLK = 8;
constexpr float LN_EPS = 1e-5f, RMS_EPS = 1e-6f, ALPHA = 1.189207115002721f;
constexpr float WQ_SCALE = 1536.f, WQ_INV = 1.0f / 1536.f;
constexpr float AQ_SCALE = 16.f, WOA_SCALE = 512.f, P3_ATT_INV = 1.0f / (16.f * 512.f);
constexpr int MIX_PITCH = 3072;
constexpr float YQ_SCALE = 24.f, YQ_INV = 1.0f / 24.f;
constexpr float WDN_SCALE = 1024.f, WDN_INV_SCALE = 1.0f / 1024.f;

namespace pg8 {
#define PG8_LAS __attribute__((address_space(3)))
typedef unsigned short bf16_t;
typedef short bf16x8 __attribute__((ext_vector_type(8)));
typedef float f32x4 __attribute__((ext_vector_type(4)));
typedef unsigned u32x4 __attribute__((ext_vector_type(4)));
typedef int v4i_t __attribute__((ext_vector_type(4)));
constexpr int BM = 256, BK = 64, HALF = 128, HTB = HALF * BK * 2  , STAGE_BYTES = 8 * HTB, NXCD = 8, WGM = 8;

__host__ __device__ __forceinline__ int lds_byte(int r, int c) { const int st = (r >> 4) * 2 + (c >> 5), rr = r & 15, cc = c & 31, ob = rr * 64 + cc * 2; return st * 1024 + (ob ^ (((ob >> 9) & 1) << 5)); }
__host__ __device__ __forceinline__ void stage_rc(int b, int& R, int& C) { const int st = b / 1024, sb = b % 1024, swz = sb ^ (((sb >> 9) & 1) << 5); R = (st >> 1) * 16 + swz / 64; C = (st & 1) * 32 + (swz % 64) / 2; }
__host__ __device__ __forceinline__ int perm32(int rho) { const int n = rho >> 4, i = rho & 15; return 8 * (i >> 2) + 4 * n + (i & 3); }

struct Unit { int pm, pn; };
struct Gemm { const bf16_t* A; const bf16_t* Bt; int M, N, K; };

struct StaticOrder {
    int nM, nN, nwg, G, c;
    __host__ __device__ void init(int M, int N, int G_, int c_) { nM = M / BM; nN = N / BM; nwg = nM * nN; G = G_; c = c_; }
    __host__ __device__ bool next(int i, Unit& u) const {
        const long L = (long)i * G + c; if (L >= nwg) return false;
        int wgid = (int)L; { const int q = nwg / NXCD, r = nwg % NXCD, xcd = wgid % NXCD, off = wgid / NXCD; wgid = (xcd < r ? xcd * (q + 1) : r * (q + 1) + (xcd - r) * q) + off; }
        const int nig = WGM * nN, gid = wgid / nig, fm = gid * WGM, gsz = (nM - fm) < WGM ? (nM - fm) : WGM;
        u.pm = fm + ((wgid % nig) % gsz); u.pn = (wgid % nig) / gsz; return true;
    }
    __device__ __forceinline__ void a_ready(const Unit&) const {}
    __device__ __forceinline__ void done(const Unit&) const {}
};
__device__ __forceinline__ unsigned cvt_pk_bf16(float lo, float hi) { unsigned r; asm volatile("v_cvt_pk_bf16_f32 %0, %1, %2" : "=v"(r) : "v"(lo), "v"(hi)); return r; }
__device__ __forceinline__ float bf_lo(unsigned w) { return __uint_as_float(w << 16); }
__device__ __forceinline__ float bf_hi(unsigned w) { return __uint_as_float(w & 0xffff0000u); }
__device__ __forceinline__ float hsum4(f32x4 v) { return (v[0] + v[1]) + (v[2] + v[3]); }
__device__ __forceinline__ float hsq4(f32x4 v) { return (v[0] * v[0] + v[1] * v[1]) + (v[2] * v[2] + v[3] * v[3]); }
__device__ __forceinline__ unsigned pack_i8x4(f32x4 v) {
    const unsigned u0 = __float_as_uint(__builtin_amdgcn_fmed3f(v[0], -127.f, 127.f) + 12582912.f), u1 = __float_as_uint(__builtin_amdgcn_fmed3f(v[1], -127.f, 127.f) + 12582912.f);
    const unsigned u2 = __float_as_uint(__builtin_amdgcn_fmed3f(v[2], -127.f, 127.f) + 12582912.f), u3 = __float_as_uint(__builtin_amdgcn_fmed3f(v[3], -127.f, 127.f) + 12582912.f);
    const unsigned w01 = __builtin_amdgcn_perm(u1, u0, 0x0c0c0400u), w23 = __builtin_amdgcn_perm(u3, u2, 0x0c0c0400u);
    return __builtin_amdgcn_perm(w23, w01, 0x05040100u);
}
__device__ __forceinline__ f32x4 i32_to_f32(f32x4 a) { return __builtin_convertvector(__builtin_bit_cast(v4i_t, a), f32x4); }
__device__ __forceinline__ void atomic_addf(float* p, float v) { (void)__hip_atomic_fetch_add(p, v, __ATOMIC_RELAXED, __HIP_MEMORY_SCOPE_AGENT); }

struct EpiProj {
    static constexpr int NS = 0; static constexpr bool STAGED = false, PERM = true, AFTER_DRAIN = false, MID = false; static constexpr int MID_T = 0;
    bf16_t* O; float* kpart;
    __device__ __forceinline__ void mid(f32x4 (&)[2][2][4][2], PG8_LAS unsigned char*, int, int) const {}
    __device__ __forceinline__ void operator()(const f32x4 (&acc)[2][2][4][2], const Unit& u, int wr, int wc, int fr, int fq) const {
        const int t = u.pn >> 2, colt = (u.pn & 3) * BM;
        const int row0 = u.pm * BM + wr * 64 + fr;
        bf16_t* base = O + (size_t)t * ((size_t)M_TOK * 1024);
        const int col0 = colt + wc * 32 + 8 * fq;
#pragma unroll
        for (int ai = 0; ai < 2; ++ai)
#pragma unroll
            for (int m = 0; m < 4; ++m) { bf16_t* rowp = base + (size_t)(row0 + ai * HALF + m * 16) * 1024 + col0;
#pragma unroll
                for (int bj = 0; bj < 2; ++bj) { const f32x4 v0 = acc[ai][bj][m][0], v1 = acc[ai][bj][m][1];
                    u32x4 w; w.x = cvt_pk_bf16(v0[0], v0[1]); w.y = cvt_pk_bf16(v0[2], v0[3]); w.z = cvt_pk_bf16(v1[0], v1[1]); w.w = cvt_pk_bf16(v1[2], v1[3]);
                    *(u32x4*)(rowp + bj * HALF) = w; } }
        if (t == 1) {
#pragma unroll
            for (int bj = 0; bj < 2; ++bj)
#pragma unroll
                for (int n = 0; n < 2; ++n) { f32x4 s = (f32x4){0.f, 0.f, 0.f, 0.f};
#pragma unroll
                    for (int ai = 0; ai < 2; ++ai)
#pragma unroll
                        for (int m = 0; m < 4; ++m) s += acc[ai][bj][m][n];
#pragma unroll
                    for (int o = 1; o < 16; o <<= 1) { s[0] += __shfl_xor(s[0], o); s[1] += __shfl_xor(s[1], o); s[2] += __shfl_xor(s[2], o); s[3] += __shfl_xor(s[3], o); }
                    if (fr == 0) *(f32x4*)(kpart + ((size_t)wr * 64 + u.pm) * 1024 + col0 + bj * HALF + 4 * n) = s; }
        }
    }
};

struct EpiProjI8 {
    static constexpr int NS = 0; static constexpr bool STAGED = false, PERM = true, AFTER_DRAIN = false, MID = false, LDSX = false; static constexpr int MID_T = 0;
    bf16_t* O; const float* xs;
    __device__ __forceinline__ void mid(f32x4 (&)[2][2][4][2], PG8_LAS unsigned char*, int, int) const {}
    __device__ __forceinline__ void operator()(const f32x4 (&acc)[2][2][4][2], const Unit& u, int wr, int wc, int fr, int fq) const {
        const int row0 = u.pm * BM + wr * 64 + fr;
        float sc[2][4];
#pragma unroll
        for (int ai = 0; ai < 2; ++ai)
#pragma unroll
            for (int m = 0; m < 4; ++m) sc[ai][m] = xs[row0 + ai * HALF + m * 16] * WQ_INV;
        if (u.pn >= 8) {
            bf16_t* zb = O + (size_t)4 * ((size_t)M_TOK * 1024); const int ch0 = (u.pn - 8) * HALF + wc * 32 + 8 * fq;
#pragma unroll
            for (int ai = 0; ai < 2; ++ai)
#pragma unroll
                for (int m = 0; m < 4; ++m) { const float s2 = sc[ai][m] * sc[ai][m];
                    const f32x4 v0 = i32_to_f32(acc[ai][0][m][0]) * i32_to_f32(acc[ai][1][m][0]) * s2, v1 = i32_to_f32(acc[ai][0][m][1]) * i32_to_f32(acc[ai][1][m][1]) * s2;
                    u32x4 w; w.x = cvt_pk_bf16(v0[0], v0[1]); w.y = cvt_pk_bf16(v0[2], v0[3]); w.z = cvt_pk_bf16(v1[0], v1[1]); w.w = cvt_pk_bf16(v1[2], v1[3]);
                    *(u32x4*)(zb + (size_t)(row0 + ai * HALF + m * 16) * 1024 + ch0) = w; }
            return;
        }
        bf16_t* base = O + (size_t)(2 + (u.pn >> 2)) * ((size_t)M_TOK * 1024);
        const int col0 = (u.pn & 3) * BM + wc * 32 + 8 * fq;
#pragma unroll
        for (int ai = 0; ai < 2; ++ai)
#pragma unroll
            for (int m = 0; m < 4; ++m) { bf16_t* rowp = base + (size_t)(row0 + ai * HALF + m * 16) * 1024 + col0;
#pragma unroll
                for (int bj = 0; bj < 2; ++bj) { const f32x4 v0 = i32_to_f32(acc[ai][bj][m][0]) * sc[ai][m], v1 = i32_to_f32(acc[ai][bj][m][1]) * sc[ai][m];
                    u32x4 w; w.x = cvt_pk_bf16(v0[0], v0[1]); w.y = cvt_pk_bf16(v0[2], v0[3]); w.z = cvt_pk_bf16(v1[0], v1[1]); w.w = cvt_pk_bf16(v1[2], v1[3]);
                    *(u32x4*)(rowp + bj * HALF) = w; } }
    }
};

struct EpiWo {
    static constexpr int NS = 0; static constexpr bool STAGED = false, PERM = true, AFTER_DRAIN = false, MID = true; static constexpr int MID_T = 8;
    const bf16_t* xb; bf16_t* YB; unsigned char* Y8; float* stats; const float* ssq;
    __device__ __forceinline__ void pre(const Unit& u, PG8_LAS unsigned char* ldsx, int tid) const {
        if (tid < BM) { const int row = u.pm * BM + tid;
            const f32x4 a = *(const f32x4*)(ssq + (size_t)row * 8), b = *(const f32x4*)(ssq + (size_t)row * 8 + 4);
            ((PG8_LAS float*)ldsx)[tid] = __builtin_amdgcn_rsqf((hsum4(a) + hsum4(b)) * (1.0f / 1024.0f) + RMS_EPS) * P3_ATT_INV; }
    }
    __device__ __forceinline__ void mid(f32x4 (&acc)[2][2][4][2], PG8_LAS unsigned char* ldsx, int wr, int fr) const {
#pragma unroll
        for (int ai = 0; ai < 2; ++ai)
#pragma unroll
            for (int m = 0; m < 4; ++m) { const float ra = ((const PG8_LAS float*)ldsx)[ai * HALF + wr * 64 + m * 16 + fr];
#pragma unroll
                for (int bj = 0; bj < 2; ++bj)
#pragma unroll
                    for (int n = 0; n < 2; ++n) acc[ai][bj][m][n] *= ra; }
    }
    __device__ __forceinline__ void operator()(const f32x4 (&acc)[2][2][4][2], const Unit& u, int wr, int wc, int fr, int fq) const {
        const int row0 = u.pm * BM + wr * 64 + fr, col0 = u.pn * BM + wc * 32 + 8 * fq;
#pragma unroll
        for (int ai = 0; ai < 2; ++ai) {
        u32x4 xr[2][4][2];
#pragma unroll
            for (int m = 0; m < 4; ++m)
#pragma unroll
                for (int bj = 0; bj < 2; ++bj) xr[ai][m][bj] = __builtin_nontemporal_load((const u32x4*)(xb + (size_t)(row0 + ai * HALF + m * 16) * DM + col0 + bj * HALF));
#pragma unroll
            for (int m = 0; m < 4; ++m) { const int row = row0 + ai * HALF + m * 16; float s = 0.f, q = 0.f;
#pragma unroll
                for (int bj = 0; bj < 2; ++bj) { const u32x4 xw = xr[ai][m][bj];
                    const f32x4 x0 = (f32x4){bf_lo(xw.x), bf_hi(xw.x), bf_lo(xw.y), bf_hi(xw.y)}, x1 = (f32x4){bf_lo(xw.z), bf_hi(xw.z), bf_lo(xw.w), bf_hi(xw.w)};
                    const f32x4 v0 = acc[ai][bj][m][0] + x0 * ALPHA, v1 = acc[ai][bj][m][1] + x1 * ALPHA;
                    s += hsum4(v0) + hsum4(v1); q += hsq4(v0) + hsq4(v1);
                    u32x4 w; w.x = cvt_pk_bf16(v0[0], v0[1]); w.y = cvt_pk_bf16(v0[2], v0[3]); w.z = cvt_pk_bf16(v1[0], v1[1]); w.w = cvt_pk_bf16(v1[2], v1[3]);
                    const int col = col0 + bj * HALF;
                    typedef unsigned u32x2 __attribute__((ext_vector_type(2)));
                    *(u32x2*)(Y8 + (size_t)row * DM + col) = (u32x2){pack_i8x4(v0 * YQ_SCALE), pack_i8x4(v1 * YQ_SCALE)}; }
                s += __shfl_xor(s, 16); s += __shfl_xor(s, 32); q += __shfl_xor(q, 16); q += __shfl_xor(q, 32);
                if (fq == 0) { atomic_addf(stats + (size_t)row * 2, s); atomic_addf(stats + (size_t)row * 2 + 1, q); } }
        }
    }
};

struct EpiUp {
    static constexpr int NS = 8;
    static constexpr bool STAGED = true, PERM = true, AFTER_DRAIN = false, MID = false; static constexpr int MID_T = 0;
    const float* stats1; const float* c1; const float* c2; unsigned char* R;
    __device__ __forceinline__ void mid(f32x4 (&)[2][2][4][2], PG8_LAS unsigned char*, int, int) const {}
    __device__ __forceinline__ void operator()(const f32x4 (&)[2][2][4][2], const Unit&, int, int, int, int) const {}
    __device__ __forceinline__ void staged(const f32x4 (&acc)[2][2][4][2], const Unit& u, int wr, int wc, int fr, int fq, PG8_LAS unsigned char* stg, int tid) const {
        const int row0 = u.pm * BM + wr * 64 + fr, col0 = u.pn * BM + wc * 32 + 8 * fq;
        f32x4 k1[2][2], k2[2][2];
#pragma unroll
        for (int bj = 0; bj < 2; ++bj)
#pragma unroll
            for (int n = 0; n < 2; ++n) { k1[bj][n] = *(const f32x4*)(c1 + col0 + bj * HALF + 4 * n); k2[bj][n] = *(const f32x4*)(c2 + col0 + bj * HALF + 4 * n); }
        typedef float f32x2 __attribute__((ext_vector_type(2))); f32x2 st[2][4];
#pragma unroll
        for (int ai = 0; ai < 2; ++ai)
#pragma unroll
            for (int m = 0; m < 4; ++m) st[ai][m] = *(const f32x2*)(stats1 + (size_t)(row0 + ai * HALF + m * 16) * 2);
        int w0 = 0, w1 = 0;
        constexpr int PITCH = 272, BUF = 32 * PITCH;
        const int wofs = (wr * 16 + fr) * PITCH + wc * 32 + 8 * fq, rrow = tid >> 4, rofs = rrow * PITCH + (tid & 15) * 16;
        unsigned char* gout = R + (size_t)(u.pm * BM + (rrow >> 4) * 64 + (rrow & 15)) * FF + u.pn * BM + (tid & 15) * 16;
#pragma unroll
        for (int ai = 0; ai < 2; ++ai)
#pragma unroll
            for (int m = 0; m < 4; ++m) { PG8_LAS unsigned char* buf = stg + ((ai * 4 + m) & 1) * BUF;
                const float sm = st[ai][m].x, sq = st[ai][m].y;
                const float mu = sm * (1.0f / DM), var = sq * (1.0f / DM) - mu * mu, rstd = __builtin_amdgcn_rsqf(var + LN_EPS), rs = rstd * (YQ_INV * WQ_INV), nm = -rstd * mu;
#pragma unroll
                for (int bj = 0; bj < 2; ++bj) {
                    f32x4 v0 = i32_to_f32(acc[ai][bj][m][0]) * rs + (k1[bj][0] * nm + k2[bj][0]), v1 = i32_to_f32(acc[ai][bj][m][1]) * rs + (k1[bj][1] * nm + k2[bj][1]);
#pragma unroll
                    for (int e = 0; e < 4; ++e) { v0[e] = __builtin_amdgcn_fmed3f(v0[e], 0.f, 21.166f); v1[e] = __builtin_amdgcn_fmed3f(v1[e], 0.f, 21.166f); }
                    v0 = v0 * v0; v1 = v1 * v1;
                    w0 = __builtin_amdgcn_cvt_pk_fp8_f32(v0[0], v0[1], w0, false); w0 = __builtin_amdgcn_cvt_pk_fp8_f32(v0[2], v0[3], w0, true);
                    w1 = __builtin_amdgcn_cvt_pk_fp8_f32(v1[0], v1[1], w1, false); w1 = __builtin_amdgcn_cvt_pk_fp8_f32(v1[2], v1[3], w1, true);
                    typedef int i32x2 __attribute__((ext_vector_type(2)));
                    *(PG8_LAS i32x2*)(buf + wofs + bj * HALF) = (i32x2){w0, w1}; }
                asm volatile("s_waitcnt lgkmcnt(0)" ::: "memory"); __builtin_amdgcn_s_barrier();
                const u32x4 v = *(const PG8_LAS u32x4*)(buf + rofs);
                *(u32x4*)(gout + (size_t)(ai * HALF + m * 16) * FF) = v; }
    }
};

struct EpiDownLN {
    static constexpr int NS = 0; static constexpr bool STAGED = false, PERM = true, AFTER_DRAIN = false, MID = false; static constexpr int MID_T = 0;
    const unsigned char* Y8; const float* stats1; const float* g1; const float* b1; float* stats2; unsigned* cnt; const float* g2; const float* b2; float* out;
    __device__ __forceinline__ void mid(f32x4 (&)[2][2][4][2], PG8_LAS unsigned char*, int, int) const {}
    __device__ __forceinline__ void operator()(f32x4 (&acc)[2][2][4][2], const Unit& u, int wr, int wc, int fr, int fq) const {
        const int row0 = u.pm * BM + wr * 64 + fr, col0 = u.pn * BM + wc * 32 + 8 * fq;
        typedef float f32x2 __attribute__((ext_vector_type(2)));
        {
        f32x4 gv[2][2], bv[2][2];
#pragma unroll
        for (int bj = 0; bj < 2; ++bj)
#pragma unroll
            for (int n = 0; n < 2; ++n) { gv[bj][n] = *(const f32x4*)(g1 + col0 + bj * HALF + 4 * n); bv[bj][n] = *(const f32x4*)(b1 + col0 + bj * HALF + 4 * n); }
#pragma unroll
        for (int aim = 0; aim < 4; ++aim) { const int ai = aim >> 1;
            typedef unsigned u32x2 __attribute__((ext_vector_type(2))); u32x2 yr[4][2];
#pragma unroll
            for (int m = 2 * (aim & 1); m < 2 * (aim & 1) + 2; ++m)
#pragma unroll
                for (int bj = 0; bj < 2; ++bj) { const int row = row0 + ai * HALF + m * 16, col = col0 + bj * HALF;
                    yr[m][bj] = __builtin_nontemporal_load((const u32x2*)(Y8 + (size_t)row * DM + col)); }
#pragma unroll
            for (int m = 2 * (aim & 1); m < 2 * (aim & 1) + 2; ++m) { const int row = row0 + ai * HALF + m * 16;
                const f32x2 stv = *(const f32x2*)(stats1 + (size_t)row * 2); const float sm = stv.x, sq = stv.y;
                const float mu = sm * (1.0f / DM), var = sq * (1.0f / DM) - mu * mu, rstd = __builtin_amdgcn_rsqf(var + LN_EPS);
                float s = 0.f, q = 0.f;
#pragma unroll
                for (int bj = 0; bj < 2; ++bj) { const u32x2 yb = yr[m][bj];
                    f32x4 y0 = (f32x4){(float)(int)(signed char)(yb.x), (float)(int)(signed char)(yb.x >> 8), (float)(int)(signed char)(yb.x >> 16), (float)((int)yb.x >> 24)} * YQ_INV;
                    f32x4 y1 = (f32x4){(float)(int)(signed char)(yb.y), (float)(int)(signed char)(yb.y >> 8), (float)(int)(signed char)(yb.y >> 16), (float)((int)yb.y >> 24)} * YQ_INV;
                    const f32x4 h0 = (y0 - mu) * rstd * gv[bj][0] + bv[bj][0], h1 = (y1 - mu) * rstd * gv[bj][1] + bv[bj][1];
                    const f32x4 v0 = acc[ai][bj][m][0] * WDN_INV_SCALE + h0 * ALPHA, v1 = acc[ai][bj][m][1] * WDN_INV_SCALE + h1 * ALPHA;
                    s += hsum4(v0) + hsum4(v1); q += hsq4(v0) + hsq4(v1);
                    acc[ai][bj][m][0] = v0; acc[ai][bj][m][1] = v1; }
                s += __shfl_xor(s, 16); s += __shfl_xor(s, 32); q += __shfl_xor(q, 16); q += __shfl_xor(q, 32);
                if (fq == 0) { atomic_addf(stats2 + (size_t)row * 2, s); atomic_addf(stats2 + (size_t)row * 2 + 1, q); } }
        }
        }
        asm volatile("s_waitcnt vmcnt(0)" ::: "memory");
        unsigned* pc = cnt + 64 * u.pm;
        if (fr == 0 && fq == 0) (void)__hip_atomic_fetch_add(pc, 1u, __ATOMIC_RELAXED, __HIP_MEMORY_SCOPE_AGENT);
        { unsigned spins = 0;
          while ((unsigned)__builtin_amdgcn_readfirstlane(__hip_atomic_load(pc, __ATOMIC_RELAXED, __HIP_MEMORY_SCOPE_AGENT)) < 64u) { __builtin_amdgcn_s_sleep(2); if (++spins > (1u << 20)) break; } }
        f32x4 gg[2][2], bb[2][2];
#pragma unroll
        for (int bj = 0; bj < 2; ++bj)
#pragma unroll
            for (int n = 0; n < 2; ++n) { gg[bj][n] = *(const f32x4*)(g2 + col0 + bj * HALF + 4 * n); bb[bj][n] = *(const f32x4*)(b2 + col0 + bj * HALF + 4 * n); }
#pragma unroll
        for (int ai = 0; ai < 2; ++ai)
#pragma unroll
            for (int m = 0; m < 4; ++m) { const int row = row0 + ai * HALF + m * 16;
                const float sm = __hip_atomic_load(stats2 + (size_t)row * 2, __ATOMIC_RELAXED, __HIP_MEMORY_SCOPE_AGENT), sq = __hip_atomic_load(stats2 + (size_t)row * 2 + 1, __ATOMIC_RELAXED, __HIP_MEMORY_SCOPE_AGENT);
                const float mu = sm * (1.0f / DM), var = sq * (1.0f / DM) - mu * mu, rstd = __builtin_amdgcn_rsqf(var + LN_EPS);
#pragma unroll
                for (int bj = 0; bj < 2; ++bj) { float* op = out + (size_t)row * DM + col0 + bj * HALF;
                    *(f32x4*)op = (acc[ai][bj][m][0] - mu) * rstd * gg[bj][0] + bb[bj][0];
                    *(f32x4*)(op + 4) = (acc[ai][bj][m][1] - mu) * rstd * gg[bj][1] + bb[bj][1]; } }
    }
};
struct PanelOrder {
    int G, vcu, ntile;
    __host__ __device__ void init(int M, int N, int G_, int c) { G = G_; vcu = (G_ % 8 == 0) ? (c % 8) * (G_ / 8) + c / 8 : c; ntile = (M / BM) * (N / BM); }
    __host__ __device__ bool next(int i, Unit& u) const { const int idx = i * G + vcu; if (idx >= ntile) return false; u.pm = idx >> 3; u.pn = idx & 7; return true; }
    __device__ __forceinline__ void a_ready(const Unit&) const {}
    __device__ __forceinline__ void done(const Unit&) const {}
};

template <class Epi, class Sched, bool ALIGN_EPI = false, bool SP2 = false, int FP8M = 0, int F8T1 = 0>
__device__ __forceinline__ void gemm_phase(PG8_LAS unsigned char* lds, const Gemm g, const Sched& S, const Epi& E) {
    int tid_ = threadIdx.x; asm volatile("" : "+v"(tid_));
    const int tid = tid_, wid = __builtin_amdgcn_readfirstlane(tid >> 6), lane = tid & 63, wr = wid >> 2, wc = wid & 3, fr = lane & 15, fq = lane >> 4;
    const int K = g.K, nt = K / BK;
    unsigned voffA[2], voffB[2];
#pragma unroll
    for (int i = 0; i < 2; ++i) { int R, C; stage_rc(tid * 16 + i * 8192, R, C); const int Rb = Epi::PERM ? ((R & ~31) + perm32(R & 31)) : R;
        voffA[i] = (unsigned)(R * K + C) * 2u; voffB[i] = (unsigned)(Rb * K + C) * 2u; }
    const size_t kstep = (size_t)(BK * 2);
    const size_t hstep = (size_t)HALF * K * 2;
    const size_t tstep = 2 * hstep;
    const unsigned ldsw = (unsigned)wid * 1024u;
    const int aoff = lds_byte(wr * 64 + fr, fq * 8), boff = lds_byte(wc * 32 + fr, fq * 8);
#define PG8_SA(b, h) (((b) * 2 + (h)) * HTB)
#define PG8_SB(b, h) ((4 + (b) * 2 + (h)) * HTB)
#define PG8_STAGE(bufoff, gbase, voff) do { _Pragma("unroll") for (int _i = 0; _i < 2; ++_i) \
        __builtin_amdgcn_global_load_lds((const unsigned*)((const char*)(gbase) + (voff)[_i]), (PG8_LAS unsigned*)(lds + (bufoff) + ldsw + _i * 8192), 16, 0, 0); } while (0)
#define PG8_LDA(dst, b, h) do { _Pragma("unroll") for (int m = 0; m < 4; ++m) _Pragma("unroll") for (int k = 0; k < 2; ++k) dst[m][k] = *(const PG8_LAS bf16x8*)(lds + PG8_SA(b, h) + aoff + m * 2048 + k * 1024); } while (0)
#define PG8_LDB(dst, b, h) do { _Pragma("unroll") for (int n = 0; n < 2; ++n) _Pragma("unroll") for (int k = 0; k < 2; ++k) dst[n][k] = *(const PG8_LAS bf16x8*)(lds + PG8_SB(b, h) + boff + n * 2048 + k * 1024); } while (0)
#define PG8_CAT(x0, x1) __builtin_shufflevector(__builtin_bit_cast(v4i_t, x0), __builtin_bit_cast(v4i_t, x1), 0, 1, 2, 3, 4, 5, 6, 7)
#define PG8_MMA_F8(ai, bj, At, Bt) do { __builtin_amdgcn_s_setprio(1); _Pragma("unroll") for (int m = 0; m < 4; ++m) _Pragma("unroll") for (int n = 0; n < 2; ++n) \
        asm volatile("v_mfma_scale_f32_16x16x128_f8f6f4 %0, %1, %2, %0, %3, %3 op_sel_hi:[0,0,0]" : "+v"(acc[ai][bj][m][n]) : "v"(PG8_CAT(Bt[n][0], Bt[n][1])), "v"(PG8_CAT(At[m][0], At[m][1])), "v"(scl8)); \
        __builtin_amdgcn_s_setprio(0); } while (0)
#define PG8_MMA_B16A(ai, bj, At, Bt) do { __builtin_amdgcn_s_setprio(1); _Pragma("unroll") for (int m = 0; m < 4; ++m) _Pragma("unroll") for (int n = 0; n < 2; ++n) _Pragma("unroll") for (int k = 0; k < 2; ++k) \
        asm volatile("v_mfma_f32_16x16x32_bf16 %0, %1, %2, %0" : "+v"(acc[ai][bj][m][n]) : "v"(Bt[n][k]), "v"(At[m][k]));   \
        __builtin_amdgcn_s_setprio(0); } while (0)
#define PG8_MMA_B16(ai, bj, At, Bt) do { __builtin_amdgcn_s_setprio(1); _Pragma("unroll") for (int m = 0; m < 4; ++m) _Pragma("unroll") for (int n = 0; n < 2; ++n) _Pragma("unroll") for (int k = 0; k < 2; ++k) \
        acc[ai][bj][m][n] = __builtin_amdgcn_mfma_f32_16x16x32_bf16(Bt[n][k], At[m][k], acc[ai][bj][m][n], 0, 0, 0); __builtin_amdgcn_s_setprio(0); } while (0)
#define PG8_MMA_I8(ai, bj, At, Bt) do { __builtin_amdgcn_s_setprio(1); _Pragma("unroll") for (int m = 0; m < 4; ++m) _Pragma("unroll") for (int n = 0; n < 2; ++n) _Pragma("unroll") for (int k = 0; k < 2; ++k) \
        acc[ai][bj][m][n] = __builtin_bit_cast(f32x4, __builtin_amdgcn_mfma_i32_16x16x64_i8(__builtin_bit_cast(v4i_t, Bt[n][k]), __builtin_bit_cast(v4i_t, At[m][k]), __builtin_bit_cast(v4i_t, acc[ai][bj][m][n]), 0, 0, 0)); \
        __builtin_amdgcn_s_setprio(0); } while (0)
#define PG8_MMA(ai, bj, At, Bt) PG8_MMA_B16(ai, bj, At, Bt)
#define PG8_WAIT_V(n) asm volatile("s_waitcnt vmcnt(" #n ")" ::: "memory")
#define PG8_WAIT_L(n) asm volatile("s_waitcnt lgkmcnt(" #n ")" ::: "memory")
#define PG8_WAIT_V1() do { if constexpr (Epi::NS == 8) asm volatile("s_waitcnt vmcnt(16)\n\ts_cmp_lg_u32 %0, 0\n\ts_cbranch_scc1 .Lrx%=\n\ts_waitcnt vmcnt(8)\n.Lrx%=:" :: "s"(rxi) : "scc", "memory"); \
                           else asm volatile("s_waitcnt vmcnt(8)" ::: "memory"); } while (0)
#define PG8_BAR __builtin_amdgcn_s_barrier()
#define PG8_SCHED __builtin_amdgcn_sched_barrier(0)
#define PG8_ITER_SP2(MMA_) do { \
            PG8_LDB(B0, 0, 0); PG8_LDB(B1, 0, 1); PG8_SCHED; PG8_LDA(At, 0, 0); PG8_STAGE(PG8_SA(1, 1), a1 + hstep, voffA); \
            PG8_WAIT_V1(); PG8_WAIT_L(0); PG8_BAR; MMA_(0, 0, At, B0); MMA_(0, 1, At, B1); PG8_BAR; PG8_SCHED; \
            PG8_LDA(At, 0, 1); PG8_STAGE(PG8_SB(0, 0), b2, voffB); PG8_STAGE(PG8_SB(0, 1), b2 + hstep, voffB); PG8_STAGE(PG8_SA(0, 0), a2, voffA); \
            PG8_WAIT_V1(); PG8_WAIT_L(0); PG8_BAR; MMA_(1, 0, At, B0); MMA_(1, 1, At, B1); PG8_BAR; PG8_SCHED; \
            PG8_LDB(B0, 1, 0); PG8_LDB(B1, 1, 1); PG8_SCHED; PG8_LDA(At, 1, 0); PG8_STAGE(PG8_SA(0, 1), a2 + hstep, voffA); \
            PG8_WAIT_V(8); PG8_WAIT_L(0); PG8_BAR; MMA_(0, 0, At, B0); MMA_(0, 1, At, B1); PG8_BAR; PG8_SCHED; \
            PG8_LDA(At, 1, 1); PG8_STAGE(PG8_SB(1, 0), b3, voffB); PG8_STAGE(PG8_SB(1, 1), b3 + hstep, voffB); PG8_STAGE(PG8_SA(1, 0), a3, voffA); \
            PG8_WAIT_V(8); PG8_WAIT_L(0); PG8_BAR; MMA_(1, 0, At, B0); MMA_(1, 1, At, B1); PG8_BAR; PG8_SCHED; \
            } while (0)
    Unit cur, nxt; int ui = 0;
    if (!S.next(0, cur)) return;
    f32x4 acc[2][2][4][2];
#pragma unroll
    for (int a = 0; a < 2; ++a)
#pragma unroll
        for (int b = 0; b < 2; ++b)
#pragma unroll
            for (int m = 0; m < 4; ++m)
#pragma unroll
                for (int n = 0; n < 2; ++n) acc[a][b][m][n] = (f32x4){0.f, 0.f, 0.f, 0.f};
    bf16x8 At[4][2], B0[2][2], B1[2][2];
    int scl8 = 0x7f7f7f7f; asm volatile("" : "+v"(scl8));
    const char* cA = (const char*)g.A + (size_t)cur.pm * tstep; const char* cB = (const char*)g.Bt + (size_t)cur.pn * tstep;
    S.a_ready(cur);
    if constexpr (Epi::MID) E.pre(cur, lds + STAGE_BYTES, tid);
    if constexpr (SP2) {
        PG8_STAGE(PG8_SB(0, 0), cB, voffB); PG8_STAGE(PG8_SB(0, 1), cB + hstep, voffB); PG8_STAGE(PG8_SA(0, 0), cA, voffA); PG8_STAGE(PG8_SA(0, 1), cA + hstep, voffA);
        if (wr == 1) PG8_BAR;
        PG8_WAIT_V(2); PG8_BAR;
        PG8_STAGE(PG8_SB(1, 0), cB + kstep, voffB); PG8_STAGE(PG8_SA(1, 0), cA + kstep, voffA); PG8_STAGE(PG8_SB(1, 1), cB + hstep + kstep, voffB);
        PG8_WAIT_V(6); PG8_BAR;
    } else {
        PG8_STAGE(PG8_SB(0, 0), cB, voffB); PG8_STAGE(PG8_SA(0, 0), cA, voffA); PG8_STAGE(PG8_SB(0, 1), cB + hstep, voffB); PG8_STAGE(PG8_SA(0, 1), cA + hstep, voffA);
        if (wr == 1) PG8_BAR;
        PG8_WAIT_V(4); PG8_BAR;
        PG8_STAGE(PG8_SB(1, 0), cB + kstep, voffB); PG8_STAGE(PG8_SA(1, 0), cA + kstep, voffA); PG8_STAGE(PG8_SB(1, 1), cB + hstep + kstep, voffB);
        PG8_WAIT_V(6); PG8_BAR;
    }
    for (;;) {
        const bool has_next = S.next(ui + 1, nxt);
        const char* nA = has_next ? (const char*)g.A + (size_t)nxt.pm * tstep : cA; const char* nB = has_next ? (const char*)g.Bt + (size_t)nxt.pn * tstep : cB;
        constexpr int SPLIT = Epi::MID ? Epi::MID_T : (FP8M == 1 ? F8T1 : 0);
        if constexpr (SPLIT > 0 && SP2) {
            for (int t = 0; t < SPLIT; t += 2) { constexpr int rxi = 0; (void)rxi;
                const char* a1 = cA + (size_t)(t + 1) * kstep; const char* a2 = cA + (size_t)(t + 2) * kstep; const char* b2 = cB + (size_t)(t + 2) * kstep;
                const char* a3 = a2 + kstep; const char* b3 = b2 + kstep;
                if constexpr (FP8M == 1) PG8_ITER_SP2(PG8_MMA_B16A); else if constexpr (FP8M == 2 || FP8M == 6) PG8_ITER_SP2(PG8_MMA_F8); else if constexpr (FP8M == 3) PG8_ITER_SP2(PG8_MMA_I8); else PG8_ITER_SP2(PG8_MMA_B16);
            }
            if constexpr (FP8M == 1) asm volatile("s_nop 15" ::: "memory");
            if constexpr (FP8M == 6) { asm volatile("s_nop 15\n\ts_nop 15" ::: "memory"); PG8_SCHED; }
            if constexpr (Epi::MID) E.mid(acc, lds + STAGE_BYTES, wr, fr);
        }
        for (int t = SPLIT; t < nt; t += 2) {
            const bool last = (t == nt - 2); const int rxi = __builtin_amdgcn_readfirstlane(((Epi::NS > 0) && t == 0 && ui > 0) ? 1 : 0); (void)rxi;
            const char* a1 = cA + (size_t)(t + 1) * kstep;
            const char* a2 = last ? nA : cA + (size_t)(t + 2) * kstep; const char* b2 = last ? nB : cB + (size_t)(t + 2) * kstep;
            const char* a3 = a2 + kstep; const char* b3 = b2 + kstep;
            if (last && has_next) S.a_ready(nxt);
            if constexpr (SP2) {
            if constexpr (FP8M == 1) PG8_ITER_SP2(PG8_MMA_F8);
            else if constexpr (FP8M == 2) PG8_ITER_SP2(PG8_MMA_F8);
            else if constexpr (FP8M == 3) PG8_ITER_SP2(PG8_MMA_I8);
            else PG8_ITER_SP2(PG8_MMA_B16);
            } else {
            PG8_LDB(B0, 0, 0); PG8_SCHED; PG8_LDA(At, 0, 0); PG8_STAGE(PG8_SA(1, 1), a1 + hstep, voffA);
            PG8_WAIT_L(8); PG8_BAR; PG8_WAIT_L(0); PG8_MMA(0, 0, At, B0); PG8_BAR; PG8_SCHED;
            PG8_LDB(B1, 0, 1); PG8_STAGE(PG8_SB(0, 0), b2, voffB);
            PG8_BAR; PG8_WAIT_L(0); PG8_MMA(0, 1, At, B1); PG8_BAR;
            PG8_LDA(At, 0, 1); PG8_STAGE(PG8_SA(0, 0), a2, voffA);
            PG8_BAR; PG8_WAIT_L(0); PG8_MMA(1, 0, At, B0); PG8_BAR; PG8_SCHED;
            PG8_STAGE(PG8_SB(0, 1), b2 + hstep, voffB);
            PG8_WAIT_V(6); PG8_BAR; PG8_MMA(1, 1, At, B1); PG8_BAR;
            PG8_LDB(B0, 1, 0); PG8_SCHED; PG8_LDA(At, 1, 0); PG8_STAGE(PG8_SA(0, 1), a2 + hstep, voffA);
            PG8_WAIT_L(8); PG8_BAR; PG8_WAIT_L(0); PG8_MMA(0, 0, At, B0); PG8_BAR; PG8_SCHED;
            PG8_LDB(B1, 1, 1); PG8_STAGE(PG8_SB(1, 0), b3, voffB);
            PG8_BAR; PG8_WAIT_L(0); PG8_MMA(0, 1, At, B1); PG8_BAR;
            PG8_LDA(At, 1, 1); PG8_STAGE(PG8_SA(1, 0), a3, voffA);
            PG8_BAR; PG8_WAIT_L(0); PG8_MMA(1, 0, At, B0); PG8_BAR; PG8_SCHED;
            PG8_STAGE(PG8_SB(1, 1), b3 + hstep, voffB);
            PG8_WAIT_V(6); PG8_BAR; PG8_MMA(1, 1, At, B1); PG8_BAR;
            }
        }
        if constexpr (ALIGN_EPI) { if (wr == 0) PG8_BAR; }
        if constexpr (FP8M == 1 || FP8M == 2) { asm volatile("s_nop 15\n\ts_nop 15" ::: "memory"); PG8_SCHED; }
        if constexpr (Epi::STAGED) { E.staged(acc, cur, wr, wc, fr, fq, lds + STAGE_BYTES, tid); S.done(cur); }
        else if constexpr (!Epi::AFTER_DRAIN) { E(acc, cur, wr, wc, fr, fq); S.done(cur); }
        if (!has_next) break;
#pragma unroll
        for (int a = 0; a < 2; ++a)
#pragma unroll
            for (int b = 0; b < 2; ++b)
#pragma unroll
                for (int m = 0; m < 4; ++m)
#pragma unroll
                    for (int n = 0; n < 2; ++n) acc[a][b][m][n] = (f32x4){0.f, 0.f, 0.f, 0.f};
        cur = nxt; cA = nA; cB = nB; ++ui;
        if constexpr (Epi::MID) E.pre(cur, lds + STAGE_BYTES, tid);
        if constexpr (ALIGN_EPI) { if (wr == 1) PG8_BAR; }
    }
    PG8_WAIT_V(0);
    if constexpr (!ALIGN_EPI) { if (wr == 0) PG8_BAR; }
    PG8_BAR;
    if constexpr (Epi::AFTER_DRAIN) { E.fused(acc, cur, wr, wc, fr, fq, lds, wid, lane); S.done(cur); }
#undef PG8_SA
#undef PG8_SB
#undef PG8_STAGE
#undef PG8_LDA
#undef PG8_LDB
#undef PG8_MMA
#undef PG8_MMA_F8
#undef PG8_MMA_I8
#undef PG8_MMA_B16
#undef PG8_MMA_B16A
#undef PG8_ITER_SP2
#undef PG8_CAT
#undef PG8_WAIT_V
#undef PG8_WAIT_L
#undef PG8_BAR
#undef PG8_SCHED
}
}

#ifndef PG8_SP2
#define PG8_SP2 true
#endif
#ifndef PG8_ALIGN
#define PG8_ALIGN true
#endif
namespace att {
typedef unsigned short bf16;
typedef short bf16x8 __attribute__((ext_vector_type(8)));
typedef short s16x4 __attribute__((ext_vector_type(4)));
typedef float f32x16 __attribute__((ext_vector_type(16)));
typedef float f32x4 __attribute__((ext_vector_type(4)));
typedef unsigned u32x4 __attribute__((ext_vector_type(4)));
constexpr int D = 128, NW = 8, QBLK = 32, KVBLK = 64, QB = NW * QBLK, LDQ = 1024, LDO = 2048;
constexpr int SHM_V = KVBLK * D * 2, SHM_K = KVBLK * D * 2;
constexpr int NVB = 3;
constexpr int LDS_BYTES = NVB * SHM_V + 2 * SHM_K + NW * 64 * 4;
constexpr int KM_OFF = LDS_BYTES + NW * QBLK * D * 2, KM_PITCH = 272;
constexpr float SCALE = 0.08838834764831845f, THR = 8.f;
constexpr size_t KPART_STRIDE = (size_t)64 * 1024;

#define KSWZ(row, colB) ((((colB) >> 7) * 8192) + (row) * 128 + (((((colB) >> 4) & 7) ^ (((row) >> 1) & 7)) << 4))
#define SBAR() __builtin_amdgcn_sched_barrier(0)
__device__ __forceinline__ int v_st(int k, int c) { const int kk = (k & ~0xC) | ((k & 4) << 1) | ((k & 8) >> 1); return ((kk >> 3) * 4 + (c >> 5)) * 512 + ((kk & 7) * 32 + (c & 31)) * 2; }
__device__ __forceinline__ int v_rd_base(int lane) { return ((lane & 3) << 3) | (((lane >> 2) & 3) << 6) | (((lane >> 4) & 1) << 5) | (((lane >> 5) & 1) << 8); }
constexpr int v_rd_off(int d0, int ks, int half) { return d0 * 512 + ks * 4096 + half * 2048; }
__device__ __forceinline__ int crow(int r, int hi) { return (r & 3) + 8 * (r >> 2) + 4 * hi; }
__device__ __forceinline__ unsigned cvtpk(float lo, float hi) { unsigned r; asm volatile("v_cvt_pk_bf16_f32 %0, %1, %2" : "=v"(r) : "v"(lo), "v"(hi)); return r; }
__device__ __forceinline__ bf16x8 pack8(f32x4 a, f32x4 b) { u32x4 w = {cvtpk(a[0], a[1]), cvtpk(a[2], a[3]), cvtpk(b[0], b[1]), cvtpk(b[2], b[3])}; return *reinterpret_cast<bf16x8*>(&w); }
__device__ __forceinline__ bf16x8 load8(const bf16* p) { return *reinterpret_cast<const bf16x8*>(p); }
__device__ __forceinline__ void mask_tile(f32x16& p0, f32x16& p1, int dq) {
#define MT1(P, r, c_) do { float t_ = P[r]; asm volatile("v_cmp_le_i32 vcc, %1, %2\n\tv_cndmask_b32 %0, %3, %0, vcc" : "+v"(t_) : "n"(c_), "v"(dq), "v"(NEG) : "vcc"); P[r] = t_; } while (0)
    float NEG = -__builtin_inff(); asm volatile("" : "+v"(NEG));
    MT1(p0, 0, 0); MT1(p0, 1, 1); MT1(p0, 2, 2); MT1(p0, 3, 3); MT1(p0, 4, 8); MT1(p0, 5, 9); MT1(p0, 6, 10); MT1(p0, 7, 11);
    MT1(p0, 8, 16); MT1(p0, 9, 17); MT1(p0, 10, 18); MT1(p0, 11, 19); MT1(p0, 12, 24); MT1(p0, 13, 25); MT1(p0, 14, 26); MT1(p0, 15, 27);
    MT1(p1, 0, 32); MT1(p1, 1, 33); MT1(p1, 2, 34); MT1(p1, 3, 35); MT1(p1, 4, 40); MT1(p1, 5, 41); MT1(p1, 6, 42); MT1(p1, 7, 43);
    MT1(p1, 8, 48); MT1(p1, 9, 49); MT1(p1, 10, 50); MT1(p1, 11, 51); MT1(p1, 12, 56); MT1(p1, 13, 57); MT1(p1, 14, 58); MT1(p1, 15, 59);
#undef MT1
}
__device__ __forceinline__ void mask_all(f32x16& p0, f32x16& p1, bool keep) {
    const float NEG = -__builtin_inff();
#pragma unroll
    for (int r = 0; r < 16; ++r) { p0[r] = keep ? p0[r] : NEG; p1[r] = keep ? p1[r] : NEG; }
}
__device__ __forceinline__ void partialSM(f32x16& p0, f32x16& p1, float& m_reg, float& mn, float& alpha) {
    float pmax = p0[0];
#pragma unroll
    for (int r = 1; r < 16; ++r) pmax = fmaxf(pmax, p0[r]);
#pragma unroll
    for (int r = 0; r < 16; ++r) pmax = fmaxf(pmax, p1[r]);
    { auto rr = __builtin_amdgcn_permlane32_swap(__float_as_uint(pmax), __float_as_uint(pmax), false, false);
      pmax = fmaxf(__uint_as_float(rr[0]), __uint_as_float(rr[1])); }
    constexpr float C2 = 1.4426950408889634f * SCALE;
    if (__builtin_expect(__all((pmax - m_reg) * SCALE <= THR), 1)) { mn = m_reg; alpha = 1.f; }
    else { mn = fmaxf(m_reg, pmax); alpha = __builtin_amdgcn_exp2f((m_reg - mn) * C2); m_reg = mn; }
    const float mnL = -mn * C2;
#pragma unroll
    for (int r = 0; r < 16; ++r) p0[r] = fmaf(p0[r], C2, mnL);
#pragma unroll
    for (int r = 0; r < 16; ++r) p1[r] = fmaf(p1[r], C2, mnL);
#pragma unroll
    for (int r = 0; r < 16; ++r) p0[r] = __builtin_amdgcn_exp2f(p0[r]);
}
__device__ __forceinline__ void finishSM(f32x16& p0, f32x16& p1, float alpha, float& l_reg, bf16x8& pa0, bf16x8& pa1, bf16x8& pa2, bf16x8& pa3) {
#pragma unroll
    for (int r = 0; r < 16; ++r) p1[r] = __builtin_amdgcn_exp2f(p1[r]);
    float ps = 0;
#pragma unroll
    for (int r = 0; r < 16; ++r) ps += p0[r];
#pragma unroll
    for (int r = 0; r < 16; ++r) ps += p1[r];
    { auto rr = __builtin_amdgcn_permlane32_swap(__float_as_uint(ps), __float_as_uint(ps), false, false);
      ps = __uint_as_float(rr[0]) + __uint_as_float(rr[1]); }
    l_reg = l_reg * alpha + ps;
#define PK4(P, B_, OUT) do { unsigned a0 = cvtpk(P[B_+0], P[B_+1]), a1 = cvtpk(P[B_+2], P[B_+3]);                          \
        unsigned b0 = cvtpk(P[B_+4], P[B_+5]), b1 = cvtpk(P[B_+6], P[B_+7]);                                             \
        auto r0 = __builtin_amdgcn_permlane32_swap(a0, b0, false, false); auto r1 = __builtin_amdgcn_permlane32_swap(a1, b1, false, false); \
        u32x4 w = {r0[0], r1[0], r0[1], r1[1]}; OUT = *reinterpret_cast<bf16x8*>(&w); } while (0)
    PK4(p0, 0, pa0); PK4(p0, 8, pa1); PK4(p1, 0, pa2); PK4(p1, 8, pa3);
#undef PK4
}
template <int KB>
__device__ __forceinline__ void qkt(f32x16& p0, f32x16& p1, const char* K_lds, int r32, int hi, const bf16x8* qr) {
    p0 = f32x16{}; p1 = f32x16{};
    int kb[4];
#pragma unroll
    for (int dd = 0; dd < 4; ++dd) kb[dd] = (int)(uintptr_t)(K_lds + KSWZ(r32, (dd * 16 + hi * 8) * 2));
#define KRD(dst, d0_) do { asm volatile("ds_read_b128 %0, %1 offset:%2" : "=&v"(dst[0]) : "v"(kb[(d0_) & 3]), "i"(KB * SHM_K + ((d0_) >> 2) * 8192) : "memory");          \
                           asm volatile("ds_read_b128 %0, %1 offset:%2" : "=&v"(dst[1]) : "v"(kb[(d0_) & 3]), "i"(KB * SHM_K + ((d0_) >> 2) * 8192 + 32 * 128) : "memory"); } while (0)
#define KMM(f, d0_, n_) do { asm volatile("s_waitcnt lgkmcnt(" #n_ ")" ::: "memory"); SBAR();                                                              \
        p0 = __builtin_amdgcn_mfma_f32_32x32x16_bf16(f[0], qr[d0_], p0, 0, 0, 0); p1 = __builtin_amdgcn_mfma_f32_32x32x16_bf16(f[1], qr[d0_], p1, 0, 0, 0); SBAR(); } while (0)
    bf16x8 fa[2], fb[2];
    KRD(fa, 0); KRD(fb, 1);
    KMM(fa, 0, 2); KRD(fa, 2);
    KMM(fb, 1, 2); KRD(fb, 3);
    KMM(fa, 2, 2); KRD(fa, 4);
    KMM(fb, 3, 2); KRD(fb, 5);
    KMM(fa, 4, 2); KRD(fa, 6);
    KMM(fb, 5, 2); KRD(fb, 7);
    KMM(fa, 6, 2);
    KMM(fb, 7, 0);
#undef KRD
#undef KMM
}
template <int KB>
__device__ __forceinline__ void qkt_c(f32x16& p0, f32x16& p1, const char* K_lds, int r32, int hi, const bf16x8* qr) {
    p0 = f32x16{}; p1 = f32x16{};
    const char* kb[4];
#pragma unroll
    for (int dd = 0; dd < 4; ++dd) kb[dd] = K_lds + KB * SHM_K + KSWZ(r32, (dd * 16 + hi * 8) * 2);
#pragma unroll
    for (int d0 = 0; d0 < 8; ++d0) { const char* a = kb[d0 & 3] + (d0 >> 2) * 8192;
        bf16x8 b0 = *reinterpret_cast<const bf16x8*>(a);
        bf16x8 b1 = *reinterpret_cast<const bf16x8*>(a + 32 * 128);
        p0 = __builtin_amdgcn_mfma_f32_32x32x16_bf16(b0, qr[d0], p0, 0, 0, 0);
        p1 = __builtin_amdgcn_mfma_f32_32x32x16_bf16(b1, qr[d0], p1, 0, 0, 0); }
}
__device__ __forceinline__ void pv_tile(f32x16* o, int vb0, bf16x8 pa0, bf16x8 pa1, bf16x8 pa2, bf16x8 pa3) {
#define TRRD(dst, off) asm volatile("ds_read_b64_tr_b16 %0, %1 offset:%2" : "=&v"(dst) : "v"(vb0), "i"(off) : "memory")
#define PV_R(d0, ks, l, h) do { TRRD(l, v_rd_off(d0, 0, 0) + (ks) * 4096); TRRD(h, v_rd_off(d0, 0, 0) + (ks) * 4096 + 2048); } while (0)
#define PV_M(d0, pa, l, h, n_) do { asm volatile("s_waitcnt lgkmcnt(" #n_ ")" ::: "memory"); SBAR();                                \
        o[d0] = __builtin_amdgcn_mfma_f32_32x32x16_bf16(pa, (bf16x8){l[0], l[1], l[2], l[3], h[0], h[1], h[2], h[3]}, o[d0], 0, 0, 0); SBAR(); } while (0)
    s16x4 l0, l1, l2, l3, h0, h1, h2, h3;
    PV_R(0, 0, l0, h0); PV_R(0, 1, l1, h1); PV_R(0, 2, l2, h2); PV_R(0, 3, l3, h3);
#define PV_G(d0) do { PV_M(d0, pa0, l0, h0, 6); PV_R(d0 + 1, 0, l0, h0); PV_M(d0, pa1, l1, h1, 6); PV_R(d0 + 1, 1, l1, h1);            \
                      PV_M(d0, pa2, l2, h2, 6); PV_R(d0 + 1, 2, l2, h2); PV_M(d0, pa3, l3, h3, 6); PV_R(d0 + 1, 3, l3, h3); } while (0)
    PV_G(0); PV_G(1); PV_G(2);
    PV_M(3, pa0, l0, h0, 6); PV_M(3, pa1, l1, h1, 4); PV_M(3, pa2, l2, h2, 2); PV_M(3, pa3, l3, h3, 0);
#undef PV_G
#undef PV_M
#undef PV_R
#undef TRRD
}

template <int KB>
__device__ __forceinline__ void qk_fin(f32x16& x0, f32x16& x1, f32x16& y0, f32x16& y1, float alY, float& l_reg, bf16x8& pa0, bf16x8& pa1, bf16x8& pa2, bf16x8& pa3,
                                       const char* K_lds, int r32, int hi, const bf16x8* qr) {
    x0 = f32x16{}; x1 = f32x16{};
    int kb[4];
#pragma unroll
    for (int dd = 0; dd < 4; ++dd) kb[dd] = (int)(uintptr_t)(K_lds + KSWZ(r32, (dd * 16 + hi * 8) * 2));
#define KRD(dst, d0_) do { asm volatile("ds_read_b128 %0, %1 offset:%2" : "=&v"(dst[0]) : "v"(kb[(d0_) & 3]), "i"(KB * SHM_K + ((d0_) >> 2) * 8192) : "memory");          \
                           asm volatile("ds_read_b128 %0, %1 offset:%2" : "=&v"(dst[1]) : "v"(kb[(d0_) & 3]), "i"(KB * SHM_K + ((d0_) >> 2) * 8192 + 32 * 128) : "memory"); } while (0)
#define KMM(f, d0_, n_) do { asm volatile("s_waitcnt lgkmcnt(" #n_ ")" ::: "memory"); SBAR();                                                              \
        x0 = __builtin_amdgcn_mfma_f32_32x32x16_bf16(f[0], qr[d0_], x0, 0, 0, 0); x1 = __builtin_amdgcn_mfma_f32_32x32x16_bf16(f[1], qr[d0_], x1, 0, 0, 0); SBAR(); } while (0)
#define EXPY(i) do { y1[2 * (i)] = __builtin_amdgcn_exp2f(y1[2 * (i)]); y1[2 * (i) + 1] = __builtin_amdgcn_exp2f(y1[2 * (i) + 1]); } while (0)
#define ADDY(Y, i) do { ps += Y[2 * (i)]; ps += Y[2 * (i) + 1]; } while (0)
#define CVA(P, B_) do { c0 = cvtpk(P[B_ + 0], P[B_ + 1]); c1 = cvtpk(P[B_ + 2], P[B_ + 3]); } while (0)
#define CVB(P, B_, OUT) do { const unsigned b0_ = cvtpk(P[B_ + 4], P[B_ + 5]), b1_ = cvtpk(P[B_ + 6], P[B_ + 7]);                                          \
        auto r0_ = __builtin_amdgcn_permlane32_swap(c0, b0_, false, false); auto r1_ = __builtin_amdgcn_permlane32_swap(c1, b1_, false, false);               \
        u32x4 w_ = {r0_[0], r1_[0], r0_[1], r1_[1]}; OUT = *reinterpret_cast<bf16x8*>(&w_); } while (0)
    bf16x8 fa[2], fb[2]; float ps = 0.f; unsigned c0, c1;
    KRD(fa, 0); KRD(fb, 1);
    KMM(fa, 0, 2); KRD(fa, 2); EXPY(0); ADDY(y0, 0); CVA(y0, 0); SBAR();
    KMM(fb, 1, 2); KRD(fb, 3); EXPY(1); ADDY(y0, 1); ADDY(y1, 0); CVB(y0, 0, pa0); SBAR();
    KMM(fa, 2, 2); KRD(fa, 4); EXPY(2); ADDY(y0, 2); ADDY(y1, 1); CVA(y0, 8); SBAR();
    KMM(fb, 3, 2); KRD(fb, 5); EXPY(3); ADDY(y0, 3); ADDY(y1, 2); CVB(y0, 8, pa1); SBAR();
    KMM(fa, 4, 2); KRD(fa, 6); EXPY(4); ADDY(y0, 4); ADDY(y1, 3); CVA(y1, 0); SBAR();
    KMM(fb, 5, 2); KRD(fb, 7); EXPY(5); ADDY(y0, 5); ADDY(y1, 4); CVB(y1, 0, pa2); SBAR();
    KMM(fa, 6, 2);             EXPY(6); ADDY(y0, 6); ADDY(y1, 5); CVA(y1, 8); SBAR();
    KMM(fb, 7, 0);             EXPY(7); ADDY(y0, 7); ADDY(y1, 6); SBAR();
    ADDY(y1, 7); CVB(y1, 8, pa3);
    { auto rr = __builtin_amdgcn_permlane32_swap(__float_as_uint(ps), __float_as_uint(ps), false, false); ps = __uint_as_float(rr[0]) + __uint_as_float(rr[1]); }
    l_reg = l_reg * alY + ps;
#undef KRD
#undef KMM
#undef EXPY
#undef ADDY
#undef CVA
#undef CVB
}
__device__ __forceinline__ void pv_par(f32x16* o, int vb0, bf16x8 pa0, bf16x8 pa1, bf16x8 pa2, bf16x8 pa3, f32x16& x0, f32x16& x1, float& m_reg, float& alpha, bool keep) {
#define TRRD(dst, off) asm volatile("ds_read_b64_tr_b16 %0, %1 offset:%2" : "=&v"(dst) : "v"(vb0), "i"(off) : "memory")
#define PV_R(d0, ks, l, h) do { TRRD(l, v_rd_off(d0, 0, 0) + (ks) * 4096); TRRD(h, v_rd_off(d0, 0, 0) + (ks) * 4096 + 2048); } while (0)
#define PV_M(d0, pa, l, h, n_) do { asm volatile("s_waitcnt lgkmcnt(" #n_ ")" ::: "memory"); SBAR();                                \
        o[d0] = __builtin_amdgcn_mfma_f32_32x32x16_bf16(pa, (bf16x8){l[0], l[1], l[2], l[3], h[0], h[1], h[2], h[3]}, o[d0], 0, 0, 0); SBAR(); } while (0)
#define MX8(t, X, b) do { t = fmaxf(fmaxf(X[b], X[b + 1]), X[b + 2]); t = fmaxf(fmaxf(t, X[b + 3]), X[b + 4]); t = fmaxf(fmaxf(t, X[b + 5]), X[b + 6]); t = fmaxf(t, X[b + 7]); } while (0)
#define FM4(j) do { x0[2 * (j)] = fmaf(x0[2 * (j)], C2, mnL); x0[2 * (j) + 1] = fmaf(x0[2 * (j) + 1], C2, mnL); x1[2 * (j)] = fmaf(x1[2 * (j)], C2, mnL); x1[2 * (j) + 1] = fmaf(x1[2 * (j) + 1], C2, mnL); } while (0)
#define EX0(e) x0[e] = __builtin_amdgcn_exp2f(x0[e])
    constexpr float C2 = 1.4426950408889634f * SCALE;
    s16x4 l0, l1, l2, l3, h0, h1, h2, h3; float t0, t1, t2, t3, pmax, mnL;
    PV_R(0, 0, l0, h0); PV_R(0, 1, l1, h1); PV_R(0, 2, l2, h2); PV_R(0, 3, l3, h3);
    PV_M(0, pa0, l0, h0, 6); PV_R(1, 0, l0, h0); MX8(t0, x0, 0); SBAR();
    PV_M(0, pa1, l1, h1, 6); PV_R(1, 1, l1, h1); MX8(t1, x0, 8); SBAR();
    PV_M(0, pa2, l2, h2, 6); PV_R(1, 2, l2, h2); MX8(t2, x1, 0); SBAR();
    PV_M(0, pa3, l3, h3, 6); PV_R(1, 3, l3, h3); MX8(t3, x1, 8); SBAR();
    PV_M(1, pa0, l0, h0, 6); PV_R(2, 0, l0, h0);
    { pmax = fmaxf(fmaxf(t0, t1), fmaxf(t2, t3)); auto rr = __builtin_amdgcn_permlane32_swap(__float_as_uint(pmax), __float_as_uint(pmax), false, false); pmax = fmaxf(__uint_as_float(rr[0]), __uint_as_float(rr[1])); pmax = keep ? pmax : -__builtin_inff(); } SBAR();
    PV_M(1, pa1, l1, h1, 6); PV_R(2, 1, l1, h1);
    { const bool ok = __all((pmax - m_reg) * SCALE <= THR) != 0;
      const float mn = ok ? m_reg : fmaxf(m_reg, pmax); alpha = __builtin_amdgcn_exp2f((m_reg - mn) * C2); m_reg = mn; mnL = keep ? -mn * C2 : -__builtin_inff(); } SBAR();
    PV_M(1, pa2, l2, h2, 6); PV_R(2, 2, l2, h2); FM4(0); SBAR();
    PV_M(1, pa3, l3, h3, 6); PV_R(2, 3, l3, h3); FM4(1); EX0(0); SBAR();
    PV_M(2, pa0, l0, h0, 6); PV_R(3, 0, l0, h0); FM4(2); EX0(1); SBAR();
    PV_M(2, pa1, l1, h1, 6); PV_R(3, 1, l1, h1); FM4(3); EX0(2); SBAR();
    PV_M(2, pa2, l2, h2, 6); PV_R(3, 2, l2, h2); FM4(4); EX0(3); SBAR();
    PV_M(2, pa3, l3, h3, 6); PV_R(3, 3, l3, h3); FM4(5); EX0(4); SBAR();
    PV_M(3, pa0, l0, h0, 6); FM4(6); EX0(5); SBAR();
    PV_M(3, pa1, l1, h1, 4); FM4(7); EX0(6); SBAR();
    PV_M(3, pa2, l2, h2, 2); EX0(7); EX0(8); EX0(9); SBAR();
    PV_M(3, pa3, l3, h3, 0); EX0(10); EX0(11); EX0(12); SBAR();
    EX0(13); EX0(14); EX0(15);
#undef TRRD
#undef PV_R
#undef PV_M
#undef MX8
#undef FM4
#undef EX0
}

struct BlockRef { int b, h, qb; };
struct Bases { const bf16* proj; bf16* mixed; float* ssq; const float* kpart; };
__device__ __forceinline__ const bf16* refQ(const Bases& B, const BlockRef& r) { return B.proj + ((size_t)(r.b * SEQ + r.qb * QB) * LDQ + r.h * D); }
__device__ __forceinline__ const bf16* refK(const Bases& B, const BlockRef& r) { return B.proj + (size_t)M_TOK * LDQ + ((size_t)(r.b * SEQ) * LDQ + r.h * D); }
__device__ __forceinline__ const bf16* refV(const Bases& B, const BlockRef& r) { return B.proj + (size_t)2 * M_TOK * LDQ + ((size_t)(r.b * SEQ) * LDQ + r.h * D); }
struct Seam { bf16x8 qr[8]; bf16x8 st_v0, st_v1, st_k0, st_k1; };

__device__ __forceinline__ void km_load(const float* kpart, int b, int h, int tid, f32x4& x, f32x4& y) {
    const int j = (tid >> 5) & 7, c = (tid & 31) * 4;
    const float* p = kpart + ((size_t)(b * 8 + j) * 1024 + h * D + c);
    x = *(const f32x4*)p; y = *(const f32x4*)(p + KPART_STRIDE);
}
__device__ __forceinline__ void km_write(char* lds, int tid, f32x4 x, f32x4 y) {
    const int j = (tid >> 5) & 7, c = (tid & 31) * 4; const f32x4 a = x + y;
    const unsigned h0 = cvtpk(a[0], a[1]), h1 = cvtpk(a[2], a[3]);
    const unsigned l0 = cvtpk(a[0] - __uint_as_float(h0 << 16), a[1] - __uint_as_float(h0 & 0xffff0000u)), l1 = cvtpk(a[2] - __uint_as_float(h1 << 16), a[3] - __uint_as_float(h1 & 0xffff0000u));
    typedef unsigned u32x2 __attribute__((ext_vector_type(2)));
    if (tid < 256) { *(u32x2*)(lds + KM_OFF + j * KM_PITCH + c * 2) = (u32x2){h0, h1}; *(u32x2*)(lds + KM_OFF + (8 + j) * KM_PITCH + c * 2) = (u32x2){l0, l1}; }
}
__device__ __forceinline__ unsigned moba_select(const bf16x8* qr, const char* lds, int own, int r32, int hi) {
    if (own == 0) return 0u;
    f32x16 g = f32x16{};
    const bool act = r32 < 16;
    const char* kmf = lds + KM_OFF + (r32 & 15) * KM_PITCH + hi * 16;
#pragma unroll
    for (int d0 = 0; d0 < 8; ++d0) {
        bf16x8 f = *(const bf16x8*)(kmf + d0 * 32);
        if (!act) f = (bf16x8){0, 0, 0, 0, 0, 0, 0, 0};
        g = __builtin_amdgcn_mfma_f32_32x32x16_bf16(f, qr[d0], g, 0, 0, 0);
    }
    float G[8];
#pragma unroll
    for (int i = 0; i < 4; ++i) { const float v = g[i] + g[4 + i];
        auto rr = __builtin_amdgcn_permlane32_swap(__float_as_uint(v), __float_as_uint(v), false, false);
        G[i] = __uint_as_float(rr[0]); G[4 + i] = __uint_as_float(rr[1]); }
    unsigned sel = 0u;
#pragma unroll
    for (int a = 0; a < 8; ++a) { int cnt = 0;
#pragma unroll
        for (int b = 0; b < 8; ++b) { if (b == a) continue;
            const bool beats = (b < a) ? (G[b] >= G[a]) : (G[b] > G[a]);
            cnt += (b < own && beats) ? 1 : 0; }
        sel |= (a < own && cnt < 3) ? (1u << a) : 0u; }
    return sel;
}

#define ROW(p, k0, rr) ((p) + (size_t)((k0) + (rr)) * LDQ + sc)
#define VMW() asm volatile("s_waitcnt vmcnt(0)" ::: "memory")
#define VMWN(n) asm volatile("s_waitcnt vmcnt(%0)" :: "i"(n) : "memory")
#define SLOAD_H(Kp, Vp, k0) do { S.st_v0 = load8(ROW(Vp, k0, sr)); S.st_v1 = load8(ROW(Vp, k0, 32 + sr));              \
                         S.st_k0 = load8(ROW(Kp, k0, sr)); S.st_k1 = load8(ROW(Kp, k0, 32 + sr)); } while (0)
#define SWRITE_HK(bf) do { *(bf16x8*)(K_lds + (bf) * SHM_K + kws) = S.st_k0; *(bf16x8*)(K_lds + (bf) * SHM_K + kws + 32 * 128) = S.st_k1; } while (0)
#define SWRITE_HV(bf) do { *(bf16x8*)(V_lds + (bf) * SHM_V + vst0) = S.st_v0; *(bf16x8*)(V_lds + (bf) * SHM_V + vst1) = S.st_v1; } while (0)
#define SWRITE_H(bf) do { SWRITE_HV(bf); SWRITE_HK(bf); } while (0)
__device__ __forceinline__ void moba_prime(const Bases& B, const BlockRef& cur, char* lds, Seam& S) {
    int tid_ = threadIdx.x; asm volatile("" : "+v"(tid_));
    const int tid = tid_, wid = __builtin_amdgcn_readfirstlane(tid >> 6), lane = tid & 63, r32 = lane & 31, hi = lane >> 5;
    const int sr = tid >> 4, sc = (tid & 15) * 8, kws = KSWZ(sr, sc * 2); char* K_lds = lds + NVB * SHM_V;
#pragma unroll
    for (int d0 = 0; d0 < 8; ++d0) S.qr[d0] = load8(refQ(B, cur) + (size_t)(wid * QBLK + r32) * LDQ + d0 * 16 + hi * 8);
    f32x4 kx, ky; km_load(B.kpart, cur.b, cur.h, tid, kx, ky);
    { const bf16* Kp = refK(B, cur); const bf16* Vp = refV(B, cur); SLOAD_H(Kp, Vp, 0); } VMW(); SWRITE_HK(0); km_write(lds, tid, kx, ky);
    __syncthreads();
}
template <bool ORDA> __device__ __forceinline__ void moba_block(const Bases& B, const BlockRef& cur, const BlockRef& nxt, char* lds, Seam& S) {
    int tid_ = threadIdx.x; asm volatile("" : "+v"(tid_));
    const int tid = tid_, wid = __builtin_amdgcn_readfirstlane(tid >> 6), lane = tid & 63, r32 = lane & 31, hi = lane >> 5;
    const int own = cur.qb, P0 = cur.qb * QB;
    const int NT = (P0 + QB) / KVBLK;
    const int qlo = P0 + wid * QBLK, qm = qlo + r32 - 4 * hi;
    char* V_lds = lds; char* K_lds = lds + NVB * SHM_V;
    float* ws = (float*)(lds + NVB * SHM_V + 2 * SHM_K) + wid * 64; float* li_l = ws, * al_l = ws + 32;
    float m_reg = -1e30f, l_reg = 0; f32x16 o[4] = {};
    const int sr = tid >> 4, sc = (tid & 15) * 8, vst0 = v_st(sr, sc), vst1 = v_st(32 + sr, sc), kws = KSWZ(sr, sc * 2);
    const int vb0 = (int)(uintptr_t)V_lds + v_rd_base(lane);
    const bf16* Kh = refK(B, cur); const bf16* Vh = refV(B, cur);
#define RESC(a) do { if (__any((a) < 1.f)) { if (hi == 0) al_l[r32] = (a); asm volatile("s_waitcnt lgkmcnt(0)" ::: "memory");              \
                     for (int d_ = 0; d_ < 4; ++d_) for (int r = 0; r < 16; ++r) o[d_][r] *= al_l[crow(r, hi)]; } } while (0)
#define KBASE(t) ((t) * KVBLK)
#define MASKT(P0_, P1_, t) do { const int kb_ = KBASE(t); const int jb_ = (t) >> 2;                                             \
        if (jb_ == own) { if (kb_ + KVBLK - 1 > qlo) mask_tile(P0_, P1_, qm - kb_); }                                          \
        else { const bool keep_ = ((selm >> jb_) & 1u) != 0u; if (!__all(keep_)) mask_all(P0_, P1_, keep_); } } while (0)
#define SEAM_K0() do { VMWN(8); SWRITE_HK(0); SBAR(); } while (0)
    f32x16 pA0, pA1, pB0, pB1; float mnA, mnB, alA, alB; bf16x8 pa0, pa1, pa2, pa3;
    SWRITE_HV(0); SBAR();
    if (NT > 1) { SLOAD_H(Kh, Vh, KBASE(1)); }
    SBAR();
    const unsigned selm = moba_select(S.qr, lds, own, r32, hi);
    SBAR(); qkt<0>(pA0, pA1, K_lds, r32, hi, S.qr);
    MASKT(pA0, pA1, 0); partialSM(pA0, pA1, m_reg, mnA, alA);
    if (NT > 1) { VMW(); SWRITE_H(1); }
    __syncthreads();
    int vp = 0;
#define HALF_STEP(PX0, PX1, alX, PY0, PY1, alY, t, KB, SB, CAUSAL) do {                                                       \
        const int vrd_ = vb0 + vp * SHM_V, vw_ = (vp == 0 ? 2 : vp - 1); const int jb_ = (t) >> 2;                            \
        SBAR(); qk_fin<KB>(PX0, PX1, PY0, PY1, alY, l_reg, pa0, pa1, pa2, pa3, K_lds, r32, hi, S.qr); SBAR();                 \
        if ((t) + 1 < NT) { SLOAD_H(Kh, Vh, KBASE((t) + 1)); SBAR(); }                                                        \
        if (CAUSAL) { mask_tile(PX0, PX1, qm - KBASE(t)); SBAR(); }           \
        const bool keep_ = (jb_ == own) || (((selm >> jb_) & 1u) != 0u);                                                      \
        pv_par(o, vrd_, pa0, pa1, pa2, pa3, PX0, PX1, m_reg, alX, keep_); SBAR();                                             \
        if ((t) + 1 < NT) { VMW(); SWRITE_HK(SB); *(bf16x8*)(V_lds + vw_ * SHM_V + vst0) = S.st_v0; *(bf16x8*)(V_lds + vw_ * SHM_V + vst1) = S.st_v1; } \
        RESC(alX); vp = (vp == 2 ? 0 : vp + 1); __syncthreads(); } while (0)
    int t = 1;
    for (; t + 1 < NT - 4; t += 2) {
        HALF_STEP(pB0, pB1, alB, pA0, pA1, alA, t, 1, 0, 0);
        HALF_STEP(pA0, pA1, alA, pB0, pB1, alB, t + 1, 0, 1, 0);
    }
    for (; t + 1 < NT; t += 2) {
        HALF_STEP(pB0, pB1, alB, pA0, pA1, alA, t, 1, 0, 1);
        HALF_STEP(pA0, pA1, alA, pB0, pB1, alB, t + 1, 0, 1, 1);
    }
    SBAR(); qkt_c<1>(pB0, pB1, K_lds, r32, hi, S.qr); SBAR();
    { const bf16* Kn = refK(B, nxt); const bf16* Vn = refV(B, nxt); SLOAD_H(Kn, Vn, 0); } SBAR();
#pragma unroll
    for (int d0 = 0; d0 < 8; ++d0) S.qr[d0] = load8(refQ(B, nxt) + (size_t)(wid * QBLK + r32) * LDQ + d0 * 16 + hi * 8);
    SBAR();
    finishSM(pA0, pA1, alA, l_reg, pa0, pa1, pa2, pa3); SBAR();
    pv_tile(o, vb0 + vp * SHM_V, pa0, pa1, pa2, pa3); vp = (vp == 2 ? 0 : vp + 1);
    MASKT(pB0, pB1, NT - 1); partialSM(pB0, pB1, m_reg, mnB, alB); __syncthreads(); RESC(alB);
    finishSM(pB0, pB1, alB, l_reg, pa0, pa1, pa2, pa3); SBAR(); pv_tile(o, vb0 + vp * SHM_V, pa0, pa1, pa2, pa3);
    SBAR(); SEAM_K0();
    if (hi == 0) li_l[r32] = l_reg; asm volatile("s_waitcnt lgkmcnt(0)" ::: "memory");
    int hi4 = 4 * hi; asm volatile("" : "+v"(hi4));
    float rli[16];
#pragma unroll
    for (int r = 0; r < 16; ++r) rli[r] = __builtin_amdgcn_rcpf(li_l[crow(r, 0) + hi4]);
    const size_t orow0 = (size_t)(cur.b * SEQ + P0 + wid * QBLK);
    unsigned char* Ob = (unsigned char*)B.mixed + orow0 * MIX_PITCH + cur.h * D; float* sqw = B.ssq + orow0 * 8 + cur.h;
    unsigned short* stg = (unsigned short*)(lds + LDS_BYTES) + wid * (QBLK * D);
#pragma unroll
    for (int r = 0; r < 16; ++r) { const int orow = crow(r, 0) + hi4;
#pragma unroll
        for (int d0 = 0; d0 < 4; ++d0) { const float v = o[d0][r] * rli[r]; stg[orow * D + d0 * 32 + r32] = (unsigned short)cvtpk(v, v); } }
    asm volatile("s_waitcnt lgkmcnt(0)" ::: "memory");
    int lrow = lane >> 4; asm volatile("" : "+v"(lrow));
    f32x4 kx, ky; km_load(B.kpart, nxt.b, nxt.h, tid, kx, ky);
#pragma unroll
    for (int i = 0; i < 8; ++i) { const int row = 4 * i + lrow, ch = lane & 15;
        const u32x4 w = *(const u32x4*)(stg + row * D + ch * 8);
        float a = 0.f; int q8[2] = {0, 0};
#pragma unroll
        for (int e = 0; e < 4; ++e) { const float lo = __uint_as_float(w[e] << 16), hi_ = __uint_as_float(w[e] & 0xffff0000u); a += lo * lo + hi_ * hi_;
            if (e & 1) q8[e >> 1] = __builtin_amdgcn_cvt_pk_fp8_f32(lo * AQ_SCALE, hi_ * AQ_SCALE, q8[e >> 1], true);
            else       q8[e >> 1] = __builtin_amdgcn_cvt_pk_fp8_f32(lo * AQ_SCALE, hi_ * AQ_SCALE, q8[e >> 1], false); }
        typedef int i32x2 __attribute__((ext_vector_type(2)));
        *(i32x2*)(Ob + (size_t)row * MIX_PITCH + ch * 8) = (i32x2){q8[0], q8[1]};
        a += __shfl_xor(a, 1); a += __shfl_xor(a, 2); a += __shfl_xor(a, 4); a += __shfl_xor(a, 8);
        if (ch == 0) sqw[row * 8] = a;
        SBAR(); }
    km_write(lds, tid, kx, ky);
    __syncthreads();
#undef RESC
#undef KBASE
#undef MASKT
#undef SEAM_K0
#undef HALF_STEP
}
#undef ROW
#undef VMW
#undef VMWN
#undef SLOAD_H
#undef SWRITE_HK
#undef SWRITE_HV
#undef SWRITE_H
#undef SBAR
#undef KSWZ
}

#ifndef PH_MASK
#define PH_MASK 0x7f
#endif
#ifndef DUP_MASK
#define DUP_MASK 0
#endif
#define NREP(k) (1 + ((DUP_MASK >> (k)) & 1))
constexpr int NWAVES = 8;
constexpr size_t MiB = 1u << 20;
constexpr size_t WS_CTL = 0, CTL_ZERO_BYTES = 1 * MiB;
constexpr size_t CTL_STATS1 = 0, CTL_STATS2 = 128 * 1024, CTL_C1 = 256 * 1024, CTL_C2 = 288 * 1024, CTL_BAR = 512 * 1024;
constexpr size_t WS_KPART = 1 * MiB;
constexpr size_t WS_SSQ = WS_KPART + 512 * 1024;
constexpr size_t WS_XS = 2 * MiB;
constexpr size_t WS_WIN = 4 * MiB;
constexpr size_t WS_WIN8 = 12 * MiB;
constexpr size_t WS_WO = 20 * MiB;
constexpr size_t WS_WUP = 28 * MiB;
constexpr size_t WS_WDN = 44 * MiB;
constexpr size_t WS_XB = 64 * MiB;
constexpr size_t WS_X8 = 128 * MiB;
constexpr size_t WS_PROJ = 160 * MiB;
constexpr size_t WS_R = 64 * MiB;
constexpr size_t WS_MIXED = 320 * MiB;
constexpr size_t WS_Z = 320 * MiB;
constexpr size_t WS_YB = 384 * MiB;
constexpr size_t WS_Y8 = 448 * MiB;
constexpr size_t WS_END = 480 * MiB;
constexpr size_t CTL_CNT = 768 * 1024, CTL_CNT_DUMMY = 832 * 1024;
constexpr size_t CTL_DUMMY = 640 * 1024;
constexpr int RING_BYTES = 131072, LDS_BYTES = 155648, MISC_OFF = LDS_BYTES - 64;

typedef unsigned short bf16;
typedef float f32x4 __attribute__((ext_vector_type(4)));
typedef unsigned v4u __attribute__((ext_vector_type(4)));
#define LAS __attribute__((address_space(3)))
#define LDS_WAIT() asm volatile("s_waitcnt lgkmcnt(0)" ::: "memory")
__device__ __forceinline__ unsigned pkbf(float lo, float hi) { unsigned r; asm volatile("v_cvt_pk_bf16_f32 %0, %1, %2" : "=v"(r) : "v"(lo), "v"(hi)); return r; }
__device__ __forceinline__ float wave_sum(float v) {
#pragma unroll
    for (int o = 1; o < 64; o <<= 1) v += __shfl_xor(v, o);
    return v;
}
__device__ __forceinline__ void p0_transpose_item(const float* W, int K, int N, bf16* WT, const float* gain, const float* bvec, float* c1, float* c2, LAS float* scr, int item, int lane, int pairgates = 0, int pitchB = 0, int boff = 0) {
    const int nblk = N / 64, kb = item / nblk, nb = item % nblk, k0 = 64 * kb, n0 = 64 * nb;
    const int nd0 = n0; (void)pairgates;
#pragma unroll
    for (int i = 0; i < 16; ++i) { const int kk = 4 * i + (lane >> 4), nn = 4 * (lane & 15);
        const f32x4 v = __builtin_nontemporal_load((const f32x4*)(W + (size_t)(k0 + kk) * N + n0 + nn));
        scr[kk * 65 + nn] = v[0]; scr[kk * 65 + nn + 1] = v[1]; scr[kk * 65 + nn + 2] = v[2]; scr[kk * 65 + nn + 3] = v[3]; }
    LDS_WAIT(); asm volatile("" ::: "memory");
    const int c = lane & 7;
    float gk[8], bk[8];
#pragma unroll
    for (int e = 0; e < 8; ++e) { gk[e] = gain ? gain[k0 + 8 * c + e] : 1.0f; bk[e] = bvec ? bvec[k0 + 8 * c + e] : 0.0f; }
#pragma unroll
    for (int j = 0; j < 8; ++j) { const int n = (lane >> 3) + 8 * j; const LAS float* s = scr + (8 * c) * 65 + n;
        float w[8];
#pragma unroll
        for (int e = 0; e < 8; ++e) w[e] = s[e * 65];
        v4u o; o.x = pkbf(w[0] * gk[0], w[1] * gk[1]); o.y = pkbf(w[2] * gk[2], w[3] * gk[3]); o.z = pkbf(w[4] * gk[4], w[5] * gk[5]); o.w = pkbf(w[6] * gk[6], w[7] * gk[7]);
        if (pitchB) *(v4u*)((unsigned char*)WT + (size_t)(nd0 + n) * pitchB + boff + 2 * (k0 + 8 * c)) = o; else *(v4u*)(WT + (size_t)(nd0 + n) * K + k0 + 8 * c) = o;
        if (c1) {
            float s1 = (__uint_as_float(o.x << 16) + __uint_as_float(o.x & 0xffff0000u)) + (__uint_as_float(o.y << 16) + __uint_as_float(o.y & 0xffff0000u))
                     + (__uint_as_float(o.z << 16) + __uint_as_float(o.z & 0xffff0000u)) + (__uint_as_float(o.w << 16) + __uint_as_float(o.w & 0xffff0000u));
            float s2 = 0.f;
#pragma unroll
            for (int e = 0; e < 8; ++e) s2 += w[e] * bk[e];
            s1 += __shfl_xor(s1, 1); s1 += __shfl_xor(s1, 2); s1 += __shfl_xor(s1, 4);
            s2 += __shfl_xor(s2, 1); s2 += __shfl_xor(s2, 2); s2 += __shfl_xor(s2, 4);
            if (c == 0) { (void)__hip_atomic_fetch_add(c1 + n0 + n, s1, __ATOMIC_RELAXED, __HIP_MEMORY_SCOPE_AGENT); (void)__hip_atomic_fetch_add(c2 + n0 + n, s2, __ATOMIC_RELAXED, __HIP_MEMORY_SCOPE_AGENT); }
        } }
    LDS_WAIT(); asm volatile("" ::: "memory");
}

#define XB_TMO      128
#define XB_XCNT(j)  (256  + 64 * (j))
#define XB_XSUB(j)  (1280 + 64 * (j))
#define XB_XGEN(j)  (2304 + 64 * (j))
#define XB_TOP      3328
#define XB_TOPGEN   3392
#define XCD_BAR_WORDS 3456
#define XB_SPIN_CAP (1u << 18)

__device__ __forceinline__ unsigned xb_ld(unsigned* p)              { return __hip_atomic_load(p, __ATOMIC_RELAXED, __HIP_MEMORY_SCOPE_AGENT); }
__device__ __forceinline__ unsigned xb_add(unsigned* p, unsigned v) { return __hip_atomic_fetch_add(p, v, __ATOMIC_RELAXED, __HIP_MEMORY_SCOPE_AGENT); }
__device__ __forceinline__ unsigned xb_xcc_id() { return (unsigned)__builtin_amdgcn_s_getreg((3 << 11) | 20) & 0xFu; }
#define XB_SPIN(cond, bar) do { unsigned _sp = 0; while (cond) { __builtin_amdgcn_s_sleep(1); \
    if ((++_sp & 255u) == 0u) { if (xb_ld(&(bar)[XB_TMO])) break; if (_sp > XB_SPIN_CAP) { atomicAdd(&(bar)[XB_TMO], 1u); break; } } } } while (0)

struct XcdBarrier {
    unsigned* bar; unsigned x;
    volatile LAS unsigned* st;
};

__device__ __forceinline__ XcdBarrier xcd_barrier_post(unsigned* bar, volatile LAS unsigned* st) {
    XcdBarrier b; b.bar = bar; b.x = xb_xcc_id(); b.st = st;
    if (threadIdx.x == 0) (void)xb_add(&bar[XB_XCNT(b.x)], 1u);
    return b;
}
__device__ __forceinline__ void xcd_barrier_complete(unsigned* bar, unsigned x, unsigned& nloc, unsigned& nx) {
    const unsigned G = gridDim.x * gridDim.y * gridDim.z;
    unsigned sum, cnt, mine, sp = 0u;
    for (;;) {
        sum = 0u; cnt = 0u; mine = 0u;
#pragma unroll
        for (unsigned j = 0; j < 16; ++j) { const unsigned c = xb_ld(&bar[XB_XCNT(j)]); sum += c; cnt += (c > 0u) ? 1u : 0u; mine = (j == x) ? c : mine; }
        if (sum == G) break;
        __builtin_amdgcn_s_sleep(1);
        if ((++sp & 255u) == 0u) { if (xb_ld(&bar[XB_TMO])) break; if (sp > XB_SPIN_CAP) { atomicAdd(&bar[XB_TMO], 1u); break; } }
    }
    nloc = mine > 0u ? mine : 1u; nx = cnt > 0u ? cnt : 1u;
}

__device__ __forceinline__ void xcd_barrier(const XcdBarrier& b) {
    asm volatile("s_waitcnt vmcnt(0)" ::: "memory");
    __syncthreads();
    if (threadIdx.x == 0) {
        unsigned* bar = b.bar;
        __builtin_amdgcn_s_waitcnt(0);
        unsigned nloc = b.st[0], nx = b.st[1];
        if (nloc == 0u) { xcd_barrier_complete(bar, b.x, nloc, nx); b.st[0] = nloc; b.st[1] = nx; }
        const unsigned old = xb_add(&bar[XB_XSUB(b.x)], 1u);
        const unsigned gen = old / nloc;
        if (old + 1u == (gen + 1u) * nloc) {
            __builtin_amdgcn_fence(__ATOMIC_RELEASE, "agent");
            asm volatile("s_waitcnt vmcnt(0)" ::: "memory");
            const unsigned og = xb_add(&bar[XB_TOP], 1u);
            const unsigned tg = og / nx;
            if (og + 1u == (tg + 1u) * nx) xb_add(&bar[XB_TOPGEN], 1u);
            else XB_SPIN(xb_ld(&bar[XB_TOPGEN]) == tg, bar);
            __builtin_amdgcn_fence(__ATOMIC_ACQUIRE, "agent");
            xb_add(&bar[XB_XGEN(b.x)], 1u);
            asm volatile("s_waitcnt vmcnt(0)" ::: "memory");
        } else {
            XB_SPIN(xb_ld(&bar[XB_XGEN(b.x)]) == gen, bar);
            __builtin_amdgcn_fence(__ATOMIC_ACQUIRE, "agent");
            asm volatile("s_waitcnt vmcnt(0)" ::: "memory");
        }
    }
    __syncthreads();
}

__device__ __forceinline__ void p0_transpose_item_i8(const float* W, int K, int N, unsigned char* WT, int nd0, const float* gain, const float* bvec, float* c1, float* c2, LAS float* scr, int item, int lane) {
    const int nblk = N / 64, kb = item / nblk, nb = item % nblk, k0 = 64 * kb, n0 = 64 * nb;
#pragma unroll
    for (int i = 0; i < 16; ++i) { const int kk = 4 * i + (lane >> 4), nn = 4 * (lane & 15);
        const f32x4 v = __builtin_nontemporal_load((const f32x4*)(W + (size_t)(k0 + kk) * N + n0 + nn));
        scr[kk * 65 + nn] = v[0]; scr[kk * 65 + nn + 1] = v[1]; scr[kk * 65 + nn + 2] = v[2]; scr[kk * 65 + nn + 3] = v[3]; }
    LDS_WAIT(); asm volatile("" ::: "memory");
    const int c = lane & 7;
    float gk[8], bk[8];
#pragma unroll
    for (int e = 0; e < 8; ++e) { gk[e] = (gain ? gain[k0 + 8 * c + e] : 1.0f) * WQ_SCALE; bk[e] = bvec ? bvec[k0 + 8 * c + e] : 0.0f; }
#pragma unroll
    for (int j = 0; j < 8; ++j) { const int n = (lane >> 3) + 8 * j; const LAS float* s = scr + (8 * c) * 65 + n;
        float w[8], s1 = 0.f, s2 = 0.f;
#pragma unroll
        for (int e = 0; e < 8; ++e) { w[e] = s[e * 65]; s2 += w[e] * bk[e]; w[e] = __builtin_rintf(__builtin_amdgcn_fmed3f(w[e] * gk[e], -127.f, 127.f)); s1 += w[e]; }
        typedef unsigned u32x2 __attribute__((ext_vector_type(2)));
        *(u32x2*)(WT + (size_t)(nd0 + n) * K + k0 + 8 * c) = (u32x2){pg8::pack_i8x4((f32x4){w[0], w[1], w[2], w[3]}), pg8::pack_i8x4((f32x4){w[4], w[5], w[6], w[7]})};
        if (c1) { s1 *= WQ_INV;
            s1 += __shfl_xor(s1, 1); s1 += __shfl_xor(s1, 2); s1 += __shfl_xor(s1, 4);
            s2 += __shfl_xor(s2, 1); s2 += __shfl_xor(s2, 2); s2 += __shfl_xor(s2, 4);
            if (c == 0) { (void)__hip_atomic_fetch_add(c1 + n0 + n, s1, __ATOMIC_RELAXED, __HIP_MEMORY_SCOPE_AGENT); (void)__hip_atomic_fetch_add(c2 + n0 + n, s2, __ATOMIC_RELAXED, __HIP_MEMORY_SCOPE_AGENT); } } }
    LDS_WAIT(); asm volatile("" ::: "memory");
}

__device__ __forceinline__ void p0_transpose_item_fp8(const float* W, int K, int N, unsigned char* WT, float scale, LAS float* scr, int item, int lane, const float* gain = nullptr, int pitchB = 0) {
    const int nblk = N / 64, kb = item / nblk, nb = item % nblk, k0 = 64 * kb, n0 = 64 * nb;
#pragma unroll
    for (int i = 0; i < 16; ++i) { const int kk = 4 * i + (lane >> 4), nn = 4 * (lane & 15);
        const f32x4 v = __builtin_nontemporal_load((const f32x4*)(W + (size_t)(k0 + kk) * N + n0 + nn));
        scr[kk * 65 + nn] = v[0]; scr[kk * 65 + nn + 1] = v[1]; scr[kk * 65 + nn + 2] = v[2]; scr[kk * 65 + nn + 3] = v[3]; }
    LDS_WAIT(); asm volatile("" ::: "memory");
    const int c = lane & 7;
#pragma unroll
    for (int j = 0; j < 8; ++j) { const int n = (lane >> 3) + 8 * j; const LAS float* s = scr + (8 * c) * 65 + n;
        float w[8];
#pragma unroll
        for (int e = 0; e < 8; ++e) w[e] = s[e * 65] * (gain ? gain[k0 + 8 * c + e] * scale : scale);
        int w0 = __builtin_amdgcn_cvt_pk_fp8_f32(w[0], w[1], 0, false); w0 = __builtin_amdgcn_cvt_pk_fp8_f32(w[2], w[3], w0, true);
        int w1 = __builtin_amdgcn_cvt_pk_fp8_f32(w[4], w[5], 0, false); w1 = __builtin_amdgcn_cvt_pk_fp8_f32(w[6], w[7], w1, true);
        typedef int i32x2 __attribute__((ext_vector_type(2)));
        *(i32x2*)(WT + (size_t)(n0 + n) * (pitchB ? pitchB : K) + k0 + 8 * c) = (i32x2){w0, w1}; }
    LDS_WAIT(); asm volatile("" ::: "memory");
}

__device__ __forceinline__ void p0_prologue(const float* x, const float* w_in, const float* w_o, const float* w_up, const float* w_down, const float* attn_g, const float* conv_g, const float* ln1_g, const float* ln1_b,
        bf16* WinT, unsigned char* Win8, bf16* WoT, unsigned char* Wup8, bf16* WdnT, bf16* XB, unsigned char* X8, float* xs, float* c1, float* c2, unsigned char* lds, int wave, int lane, int tid, int gw, int NGW, int G, int bx) {
        for (int row = gw; row < M_TOK; row += NGW) {
            f32x4 v[4][2]; float mx = 0.f;
#pragma unroll
            for (int j = 0; j < 4; ++j) { const float* p = x + (size_t)row * DM + (j * 64 + lane) * 8;
                v[j][0] = __builtin_nontemporal_load((const f32x4*)p); v[j][1] = __builtin_nontemporal_load((const f32x4*)(p + 4)); }
#pragma unroll
            for (int j = 0; j < 4; ++j)
#pragma unroll
                for (int h = 0; h < 2; ++h)
#pragma unroll
                    for (int e = 0; e < 4; ++e) mx = fmaxf(mx, fabsf(v[j][h][e]));
#pragma unroll
            for (int o = 1; o < 64; o <<= 1) mx = fmaxf(mx, __shfl_xor(mx, o));
            mx = fmaxf(mx, 1e-30f);
            const float inv = 127.0f / mx;
            if (lane == 0) xs[row] = mx * (1.0f / 127.0f);
#pragma unroll
            for (int j = 0; j < 4; ++j) { const size_t off = (size_t)row * DM + (j * 64 + lane) * 8;
                v4u o; o.x = pkbf(v[j][0][0], v[j][0][1]); o.y = pkbf(v[j][0][2], v[j][0][3]); o.z = pkbf(v[j][1][0], v[j][1][1]); o.w = pkbf(v[j][1][2], v[j][1][3]);
                *(v4u*)(XB + off) = o;
                typedef unsigned u32x2 __attribute__((ext_vector_type(2)));
                *(u32x2*)(X8 + off) = (u32x2){pg8::pack_i8x4(v[j][0] * inv), pg8::pack_i8x4(v[j][1] * inv)}; }
        }
        LAS float* scr = (LAS float*)((LAS unsigned char*)lds + wave * 16640);
        constexpr int I_IN = (DM / 64) * (NPROJ / 64), I_O = (DM / 64) * (DM / 64), I_UP = (DM / 64) * (FF / 64), I_DN = (FF / 64) * (DM / 64);
        constexpr int NITEMS = I_IN + I_O + I_UP + I_DN;
        for (int it = gw; it < NITEMS; it += NGW) {
            int r = it;
            if (r < I_UP) { const int nb = r % (FF / 64); p0_transpose_item_i8(w_up, DM, FF, Wup8, 64 * nb, ln1_g, ln1_b, c1, c2, scr, r, lane); continue; } r -= I_UP;
            if (r < I_IN) { const int n0 = 64 * (r % (NPROJ / 64));
                if (n0 < 2048) p0_transpose_item(w_in, DM, NPROJ, WinT, nullptr, nullptr, nullptr, nullptr, scr, r, lane);
                else { int nd0;
                    if (n0 < 4096) nd0 = n0 - 2048; else { const int isu = n0 >= 5120, ch = n0 - (isu ? 5120 : 4096); nd0 = 2048 + (ch >> 7) * 256 + isu * 128 + (ch & 127); }
                    p0_transpose_item_i8(w_in, DM, NPROJ, Win8, nd0, nullptr, nullptr, nullptr, nullptr, scr, r, lane); }
                continue; } r -= I_IN;
            if (r < I_O) { const int kb = r / (DM / 64);
                if (kb < 16) p0_transpose_item_fp8(w_o, DM, DM, (unsigned char*)WoT, WOA_SCALE, scr, r, lane, attn_g, MIX_PITCH);
                else p0_transpose_item(w_o, DM, DM, WoT, conv_g - AW, nullptr, nullptr, nullptr, scr, r, lane, 0, MIX_PITCH, -1024);
                continue; } r -= I_O;
            p0_transpose_item_fp8(w_down, FF, DM, (unsigned char*)WdnT, WDN_SCALE, scr, r, lane);
        }
}

__device__ __forceinline__ void conv_pass(const bf16* PROJ, bf16* MIXED, const float* conv_w, int vcu, int G) {
    int tid_ = threadIdx.x; asm volatile("" : "+v"(tid_));
    const int lane = tid_ & 63, gw = vcu * NWAVES + __builtin_amdgcn_readfirstlane(tid_ >> 6), NGW = G * NWAVES;
        const bf16* Bg = PROJ + (size_t)3 * M_TOK * 1024; const bf16* Zg = PROJ + (size_t)4 * M_TOK * 1024;
        for (int ch = gw; ch < M_TOK / 8; ch += NGW) {
            const int r0 = ch * 8;
            float w0[16], w1[16], w2[16];
            int l8 = lane * 8; asm volatile("" : "+v"(l8));
#pragma unroll
            for (int hh = 0; hh < 2; ++hh)
#pragma unroll
                for (int e = 0; e < 8; ++e) { const int cc = hh * 512 + l8 + e; w0[hh * 8 + e] = conv_w[cc]; w1[hh * 8 + e] = conv_w[1024 + cc]; w2[hh * 8 + e] = conv_w[2048 + cc]; }
            const bool hist = (r0 & (SEQ - 1)) != 0;
            v4u zh[2][2];
#pragma unroll
            for (int i = 0; i < 2; ++i)
#pragma unroll
                for (int hh = 0; hh < 2; ++hh) { if (!hist) zh[i][hh] = (v4u){0u, 0u, 0u, 0u}; else zh[i][hh] = __builtin_nontemporal_load((const v4u*)(Zg + (size_t)(r0 - 2 + i) * 1024 + hh * 512 + lane * 8)); }
#pragma unroll 1
            for (int half = 0; half < 2; ++half) { int rb = r0 + half * 4; asm volatile("" : "+s"(rb));
                v4u zr[4][2], br[4][2];
#pragma unroll
                for (int i = 0; i < 4; ++i)
#pragma unroll
                    for (int hh = 0; hh < 2; ++hh) zr[i][hh] = __builtin_nontemporal_load((const v4u*)(Zg + (size_t)(rb + i) * 1024 + hh * 512 + lane * 8));
#pragma unroll
                for (int i = 0; i < 4; ++i)
#pragma unroll
                    for (int hh = 0; hh < 2; ++hh) br[i][hh] = __builtin_nontemporal_load((const v4u*)(Bg + (size_t)(rb + i) * 1024 + hh * 512 + lane * 8));
#pragma unroll
                for (int i = 0; i < 4; ++i) { const int row = rb + i;
                    float y[16]; float ss = 0.f;
#pragma unroll
                    for (int hh = 0; hh < 2; ++hh) { asm volatile("" : "+v"(zr[i][hh]), "+v"(br[i][hh])); }
#pragma unroll
                    for (int hh = 0; hh < 2; ++hh)
#pragma unroll
                        for (int e = 0; e < 8; ++e) { const int k = hh * 8 + e; const int w = e >> 1;
                            const float bb = (e & 1) ? __uint_as_float(br[i][hh][w] & 0xffff0000u) : __uint_as_float(br[i][hh][w] << 16);
                            const float z2 = (e & 1) ? __uint_as_float(zh[0][hh][w] & 0xffff0000u) : __uint_as_float(zh[0][hh][w] << 16);
                            const float z1 = (e & 1) ? __uint_as_float(zh[1][hh][w] & 0xffff0000u) : __uint_as_float(zh[1][hh][w] << 16);
                            const float z0 = (e & 1) ? __uint_as_float(zr[i][hh][w] & 0xffff0000u) : __uint_as_float(zr[i][hh][w] << 16);
                            y[k] = bb * (w0[k] * z2 + w1[k] * z1 + w2[k] * z0); ss += y[k] * y[k]; }
                    const float rs = __builtin_amdgcn_rsqf(wave_sum(ss) * (1.0f / 1024.0f) + RMS_EPS);
#pragma unroll
                    for (int hh = 0; hh < 2; ++hh) { v4u o;
#pragma unroll
                        for (int e = 0; e < 4; ++e) o[e] = pkbf(y[hh * 8 + 2 * e] * rs, y[hh * 8 + 2 * e + 1] * rs);
                        *(v4u*)((bf16*)((unsigned char*)MIXED + (size_t)row * MIX_PITCH + 1024) + hh * 512 + lane * 8) = o; }
#pragma unroll
                    for (int hh = 0; hh < 2; ++hh) { zh[0][hh] = zh[1][hh]; zh[1][hh] = zr[i][hh]; } }
            }
        }
}

struct Args { const float* in[12]; float* out; unsigned char* ws; };

__global__ void __launch_bounds__(NWAVES * 64, 2) hymba_fwd(Args args) {
    extern __shared__ __attribute__((aligned(16))) unsigned char lds[];
    const int tid = threadIdx.x, lane = tid & 63, wave = __builtin_amdgcn_readfirstlane(tid >> 6);
    const int G = gridDim.x, bx = blockIdx.x;
    const int vcu = (G % 8 == 0) ? (bx % 8) * (G / 8) + bx / 8 : bx;
    const int gw = vcu * NWAVES + wave, NGW = G * NWAVES;
    unsigned char* ws = args.ws;
    const float* x = args.in[0]; const float* w_in = args.in[1]; const float* conv_w = args.in[2]; const float* attn_g = args.in[3]; const float* conv_g = args.in[4];
    const float* w_o = args.in[5]; const float* ln1_g = args.in[6]; const float* ln1_b = args.in[7]; const float* w_up = args.in[8]; const float* w_down = args.in[9];
    const float* ln2_g = args.in[10]; const float* ln2_b = args.in[11];
    float* stats1 = (float*)(ws + WS_CTL + CTL_STATS1); float* stats2 = (float*)(ws + WS_CTL + CTL_STATS2);
    float* c1 = (float*)(ws + WS_CTL + CTL_C1); float* c2 = (float*)(ws + WS_CTL + CTL_C2);
    float* dummy = (float*)(ws + WS_CTL + CTL_DUMMY);
    float* kpart = (float*)(ws + WS_KPART); float* ssq = (float*)(ws + WS_SSQ);
    bf16* WinT = (bf16*)(ws + WS_WIN); unsigned char* Win8 = ws + WS_WIN8; bf16* WoT = (bf16*)(ws + WS_WO); unsigned char* Wup8 = ws + WS_WUP; bf16* WdnT = (bf16*)(ws + WS_WDN); float* xs = (float*)(ws + WS_XS);
    bf16* XB = (bf16*)(ws + WS_XB); bf16* PROJ = (bf16*)(ws + WS_PROJ); bf16* RB = (bf16*)(ws + WS_R); bf16* MIXED = (bf16*)(ws + WS_MIXED); bf16* YB = (bf16*)(ws + WS_YB); unsigned char* Y8 = ws + WS_Y8; unsigned char* X8 = ws + WS_X8;
    PG8_LAS unsigned char* ldsp = (PG8_LAS unsigned char*)lds;
    volatile LAS unsigned* MISC = (volatile LAS unsigned*)((LAS unsigned char*)lds + MISC_OFF);
    if (tid < 16) MISC[tid] = 0u;
    __syncthreads();
    const XcdBarrier bar = xcd_barrier_post((unsigned*)(ws + WS_CTL + CTL_BAR), MISC + 8);
#define GRID_SYNC() xcd_barrier(bar)

    for (int rep = 0; rep < NREP(0) && (PH_MASK & 1); ++rep) { if (rep) GRID_SYNC();
        p0_prologue(x, w_in, w_o, w_up, w_down, attn_g, conv_g, ln1_g, ln1_b, WinT, Win8, WoT, Wup8, WdnT, XB, X8, xs, rep ? dummy : c1, rep ? dummy + 8192 : c2, lds, wave, lane, tid, gw, NGW, G, bx);
    }
    GRID_SYNC();

    for (int rep = 0; rep < NREP(1) && (PH_MASK & 2); ++rep) { if (rep) GRID_SYNC();
        { pg8::Gemm g{XB, WinT, M_TOK, 2048, DM}; pg8::StaticOrder S; S.init(M_TOK, 2048, G, bx);
          pg8::EpiProj E{PROJ, kpart};
          pg8::gemm_phase<pg8::EpiProj, pg8::StaticOrder, true, true>(ldsp, g, S, E); }
        { pg8::Gemm g{(const bf16*)X8, (const bf16*)Win8, M_TOK, 4096, DM / 2}; pg8::StaticOrder S; S.init(M_TOK, 4096, G, bx);
          pg8::EpiProjI8 E{PROJ, xs};
          pg8::gemm_phase<pg8::EpiProjI8, pg8::StaticOrder, true, true, 3>(ldsp, g, S, E); }
    }
    GRID_SYNC();

    for (int rep = 0; rep < NREP(2) && (PH_MASK & 4); ++rep) { if (rep) GRID_SYNC();
        if (vcu & 1) conv_pass(PROJ, MIXED, conv_w, vcu, G);
        att::Seam S; const att::Bases AB{PROJ, MIXED, ssq, kpart};
        int L = vcu, pass = 0;
        if (L < 256) {
            att::BlockRef cur{L >> 5, (L >> 2) & 7, L & 3};
            att::moba_prime(AB, cur, (char*)lds, S);
            for (;;) {
                const bool more_pass = pass == 0, more_item = L + G < 256, last = !more_pass && !more_item;
                int passn = pass + 1, Ln = L; if (!more_pass) { passn = 0; Ln = more_item ? L + G : L; }
                att::BlockRef nxt{Ln >> 5, (Ln >> 2) & 7, passn ? 7 - (Ln & 3) : (Ln & 3)}; if (last) nxt = cur;
                att::moba_block<true>(AB, cur, nxt, (char*)lds, S);
                if (last) break;
                cur = nxt; pass = passn; L = Ln;
            }
        }
        asm volatile("s_waitcnt vmcnt(0)" ::: "memory");
        if (!(vcu & 1)) conv_pass(PROJ, MIXED, conv_w, vcu, G);
    }
    GRID_SYNC();

    for (int rep = 0; rep < NREP(3) && (PH_MASK & 8); ++rep) { if (rep) GRID_SYNC();
        pg8::Gemm g{MIXED, WoT, M_TOK, DM, MIX_PITCH / 2}; pg8::StaticOrder S; S.init(M_TOK, DM, G, bx);
        pg8::EpiWo E{XB, YB, Y8, rep ? dummy : stats1, ssq};
        pg8::gemm_phase<pg8::EpiWo, pg8::StaticOrder, true, true, 6>(ldsp, g, S, E);
    }
    GRID_SYNC();

    for (int rep = 0; rep < NREP(4) && (PH_MASK & 16); ++rep) { if (rep) GRID_SYNC();
        pg8::Gemm g{(const bf16*)Y8, (const bf16*)Wup8, M_TOK, FF, DM / 2}; pg8::StaticOrder S; S.init(M_TOK, FF, G, bx);
        pg8::EpiUp E{stats1, c1, c2, (unsigned char*)RB};
        pg8::gemm_phase<pg8::EpiUp, pg8::StaticOrder, true, true, 3>(ldsp, g, S, E);
    }
    GRID_SYNC();

    for (int rep = 0; rep < NREP(5) && (PH_MASK & 32); ++rep) { if (rep) GRID_SYNC();
        pg8::Gemm g{RB, WdnT, M_TOK, DM, FF / 2}; pg8::PanelOrder S; S.init(M_TOK, DM, G, bx);
        pg8::EpiDownLN E{Y8, stats1, ln1_g, ln1_b, rep ? dummy : stats2, (unsigned*)(ws + WS_CTL + (rep ? CTL_CNT_DUMMY : CTL_CNT)), ln2_g, ln2_b, args.out};
        pg8::gemm_phase<pg8::EpiDownLN, pg8::PanelOrder, true, true, 2>(ldsp, g, S, E);
    }

    for (int xs = 0; xs < ((DUP_MASK >> 8) & 0xff); ++xs) GRID_SYNC();
    if ((DUP_MASK >> 7) & 1) { GRID_SYNC(); p0_prologue(x, w_in, w_o, w_up, w_down, attn_g, conv_g, ln1_g, ln1_b, WinT, Win8, WoT, Wup8, WdnT, XB, X8, xs, dummy, dummy + 8192, lds, wave, lane, tid, gw, NGW, G, bx); }
}

extern "C" void kernel_launch(void* const* d_in, const int* in_sizes, int n_in, void* d_out, int out_size, void* d_ws, size_t ws_size, hipStream_t stream) {
    static int grid = 0;
    if (grid == 0) {
        if (n_in != 12 || in_sizes[0] != M_TOK * DM || out_size != M_TOK * DM || ws_size < WS_END) {
            fprintf(stderr, "kernel_launch: shape/workspace mismatch (n_in %d, in0 %d, out %d, ws %zu; need ws >= %zu); nothing launched\n", n_in, n_in > 0 ? in_sizes[0] : -1, out_size, ws_size, (size_t)WS_END); grid = -1; return; }
        int dev = 0, cus = 0, per_cu = 0;
        if (hipGetDevice(&dev) != hipSuccess || hipDeviceGetAttribute(&cus, hipDeviceAttributeMultiprocessorCount, dev) != hipSuccess) { fprintf(stderr, "kernel_launch: device query failed\n"); grid = -1; return; }
        if (hipFuncSetAttribute((const void*)hymba_fwd, hipFuncAttributeMaxDynamicSharedMemorySize, LDS_BYTES) != hipSuccess) { fprintf(stderr, "kernel_launch: hipFuncSetAttribute failed\n"); grid = -1; return; }
        if (hipOccupancyMaxActiveBlocksPerMultiprocessor(&per_cu, (const void*)hymba_fwd, NWAVES * 64, LDS_BYTES) != hipSuccess || per_cu < 1) { fprintf(stderr, "kernel_launch: occupancy query says %d blocks per CU\n", per_cu); grid = -1; (void)hipGetLastError(); return; }
        grid = cus;
        if (grid > 256) grid = 256;
    }
    if (grid < 0) return;
    (void)hipMemsetAsync((char*)d_ws + WS_CTL, 0, CTL_ZERO_BYTES, stream);
    Args a{};
    for (int i = 0; i < 12; ++i) a.in[i] = (const float*)d_in[i];
    a.out = (float*)d_out; a.ws = (unsigned char*)d_ws;
    void* kargs[] = {&a};
    hipError_t e = hipLaunchCooperativeKernel((const void*)hymba_fwd, dim3(grid), dim3(NWAVES * 64), kargs, LDS_BYTES, stream);
    if (e != hipSuccess) fprintf(stderr, "kernel_launch: cooperative launch failed: %s (grid %d)\n", hipGetErrorString(e), grid);
}
```

```cpp
#include <hip/hip_runtime.h>
#include <hip/hip_cooperative_groups.h>
#include <cstdio>
#include <cstdint>
namespace cg = cooperative_groups;

constexpr int M_TOK = 16384, DM = 2048, SEQ = 2048, NBATCH = 8, AW = 1024, NPROJ = 6144, FF = 8192, NHEAD = 8, HD = 128, NBLK = 8;
constexpr float LN_EPS = 1e-5f, RMS_EPS = 1e-6f, ALPHA = 1.189207115002721f;
constexpr float WQ_SCALE = 1536.f, WQ_INV = 1.0f / 1536.f;
constexpr float AQ_SCALE = 16.f, WOA_SCALE = 512.f, P3_ATT_INV = 1.0f / (16.f * 512.f);
constexpr int MIX_PITCH = 3072;
constexpr float YQ_SCALE = 24.f, YQ_INV = 1.0f / 24.f;
constexpr float WDN_SCALE = 1024.f, WDN_INV_SCALE = 1.0f / 1024.f;

namespace pg8 {
template <int CTRL> __device__ __forceinline__ float dpp_f(float v) { return __uint_as_float((unsigned)__builtin_amdgcn_update_dpp(0, (int)__float_as_uint(v), CTRL, 0xf, 0xf, true)); }
#define XL_Q1 0xB1
#define XL_Q2 0x4E
#define XL_H8 0x141
#define XL_R16 0x140
__device__ __forceinline__ float xsum8(float v)  { v += dpp_f<XL_Q1>(v); v += dpp_f<XL_Q2>(v); v += dpp_f<XL_H8>(v); return v; }
__device__ __forceinline__ float xsum16r(float v) { v = xsum8(v); v += dpp_f<XL_R16>(v); return v; }
__device__ __forceinline__ float xsum_rows(float v) {
    { auto r = __builtin_amdgcn_permlane16_swap(__float_as_uint(v), __float_as_uint(v), false, false); v = __uint_as_float(r[0]) + __uint_as_float(r[1]); }
    { auto r = __builtin_amdgcn_permlane32_swap(__float_as_uint(v), __float_as_uint(v), false, false); v = __uint_as_float(r[0]) + __uint_as_float(r[1]); }
    return v; }
__device__ __forceinline__ float xsum64(float v) { return xsum_rows(xsum16r(v)); }
__device__ __forceinline__ float xmax64(float v) {
    v = fmaxf(v, dpp_f<XL_Q1>(v)); v = fmaxf(v, dpp_f<XL_Q2>(v)); v = fmaxf(v, dpp_f<XL_H8>(v)); v = fmaxf(v, dpp_f<XL_R16>(v));
    { auto r = __builtin_amdgcn_permlane16_swap(__float_as_uint(v), __float_as_uint(v), false, false); v = fmaxf(__uint_as_float(r[0]), __uint_as_float(r[1])); }
    { auto r = __builtin_amdgcn_permlane32_swap(__float_as_uint(v), __float_as_uint(v), false, false); v = fmaxf(__uint_as_float(r[0]), __uint_as_float(r[1])); }
    return v; }

#define PG8_LAS __attribute__((address_space(3)))
typedef unsigned short bf16_t;
typedef short bf16x8 __attribute__((ext_vector_type(8)));
typedef float f32x4 __attribute__((ext_vector_type(4)));
typedef unsigned u32x4 __attribute__((ext_vector_type(4)));
typedef int v4i_t __attribute__((ext_vector_type(4)));
constexpr int BM = 256, BK = 64, HALF = 128, HTB = HALF * BK * 2  , STAGE_BYTES = 8 * HTB, NXCD = 8, WGM = 4;

__host__ __device__ __forceinline__ int lds_byte(int r, int c) { const int st = (r >> 4) * 2 + (c >> 5), rr = r & 15, cc = c & 31, ob = rr * 64 + cc * 2; return st * 1024 + (ob ^ (((ob >> 9) & 1) << 5)); }
__host__ __device__ __forceinline__ void stage_rc(int b, int& R, int& C) { const int st = b / 1024, sb = b % 1024, swz = sb ^ (((sb >> 9) & 1) << 5); R = (st >> 1) * 16 + swz / 64; C = (st & 1) * 32 + (swz % 64) / 2; }
__host__ __device__ __forceinline__ int perm32(int rho) { const int n = rho >> 4, i = rho & 15; return 8 * (i >> 2) + 4 * n + (i & 3); }

struct Unit { int pm, pn; };
struct Gemm { const bf16_t* A; const bf16_t* Bt; int M, N, K; };

struct StaticOrder {
    int nM, nN, nwg, G, c;
    __host__ __device__ void init(int M, int N, int G_, int c_) { nM = M / BM; nN = N / BM; nwg = nM * nN; G = G_; c = c_; }
    __host__ __device__ bool next(int i, Unit& u) const {
        const long L = (long)i * G + c; if (L >= nwg) return false;
        int wgid = (int)L; { const int q = nwg / NXCD, r = nwg % NXCD, xcd = wgid % NXCD, off = wgid / NXCD; wgid = (xcd < r ? xcd * (q + 1) : r * (q + 1) + (xcd - r) * q) + off; }
        const int nig = WGM * nN, gid = wgid / nig, fm = gid * WGM, gsz = (nM - fm) < WGM ? (nM - fm) : WGM;
        u.pm = fm + ((wgid % nig) % gsz); u.pn = (wgid % nig) / gsz; return true;
    }
    __device__ __forceinline__ void a_ready(const Unit&) const {}
    __device__ __forceinline__ void done(const Unit&) const {}
};
__device__ __forceinline__ unsigned cvt_pk_bf16(float lo, float hi) { unsigned r; asm volatile("v_cvt_pk_bf16_f32 %0, %1, %2" : "=v"(r) : "v"(lo), "v"(hi)); return r; }
__device__ __forceinline__ float bf_lo(unsigned w) { return __uint_as_float(w << 16); }
__device__ __forceinline__ float bf_hi(unsigned w) { return __uint_as_float(w & 0xffff0000u); }
__device__ __forceinline__ float hsum4(f32x4 v) { return (v[0] + v[1]) + (v[2] + v[3]); }
__device__ __forceinline__ float hsq4(f32x4 v) { return (v[0] * v[0] + v[1] * v[1]) + (v[2] * v[2] + v[3] * v[3]); }
__device__ __forceinline__ unsigned pack_i8x4(f32x4 v) {
    const unsigned u0 = __float_as_uint(__builtin_amdgcn_fmed3f(v[0], -127.f, 127.f) + 12582912.f), u1 = __float_as_uint(__builtin_amdgcn_fmed3f(v[1], -127.f, 127.f) + 12582912.f);
    const unsigned u2 = __float_as_uint(__builtin_amdgcn_fmed3f(v[2], -127.f, 127.f) + 12582912.f), u3 = __float_as_uint(__builtin_amdgcn_fmed3f(v[3], -127.f, 127.f) + 12582912.f);
    const unsigned w01 = __builtin_amdgcn_perm(u1, u0, 0x0c0c0400u), w23 = __builtin_amdgcn_perm(u3, u2, 0x0c0c0400u);
    return __builtin_amdgcn_perm(w23, w01, 0x05040100u);
}
__device__ __forceinline__ f32x4 i32_to_f32(f32x4 a) { return __builtin_convertvector(__builtin_bit_cast(v4i_t, a), f32x4); }
__device__ __forceinline__ void atomic_addf(float* p, float v) { (void)__hip_atomic_fetch_add(p, v, __ATOMIC_RELAXED, __HIP_MEMORY_SCOPE_AGENT); }

struct EpiProj {
    static constexpr int NS = 16;     static constexpr bool STAGED = false, PERM = true, AFTER_DRAIN = false, MID = false; static constexpr int MID_T = 0;
    bf16_t* O; float* kpart;
    __device__ __forceinline__ void mid(f32x4 (&)[2][2][4][2], PG8_LAS unsigned char*, int, int) const {}
    __device__ __forceinline__ void operator()(const f32x4 (&acc)[2][2][4][2], const Unit& u, int wr, int wc, int fr, int fq) const {
        const int t = u.pn >> 2, colt = (u.pn & 3) * BM;
        const int row0 = u.pm * BM + wr * 64 + fr;
        bf16_t* base = O + (size_t)t * ((size_t)M_TOK * 1024);
        const int col0 = colt + wc * 32 + 8 * fq;
#pragma unroll
        for (int ai = 0; ai < 2; ++ai)
#pragma unroll
            for (int m = 0; m < 4; ++m) { bf16_t* rowp = base + (size_t)(row0 + ai * HALF + m * 16) * 1024 + col0;
#pragma unroll
                for (int bj = 0; bj < 2; ++bj) { const f32x4 v0 = acc[ai][bj][m][0], v1 = acc[ai][bj][m][1];
                    u32x4 w; w.x = cvt_pk_bf16(v0[0], v0[1]); w.y = cvt_pk_bf16(v0[2], v0[3]); w.z = cvt_pk_bf16(v1[0], v1[1]); w.w = cvt_pk_bf16(v1[2], v1[3]);
                    *(u32x4*)(rowp + bj * HALF) = w; } }
        if (t == 1) {
#pragma unroll
            for (int bj = 0; bj < 2; ++bj)
#pragma unroll
                for (int n = 0; n < 2; ++n) { f32x4 s = (f32x4){0.f, 0.f, 0.f, 0.f};
#pragma unroll
                    for (int ai = 0; ai < 2; ++ai)
#pragma unroll
                        for (int m = 0; m < 4; ++m) s += acc[ai][bj][m][n];
#pragma unroll
                    for (int e = 0; e < 4; ++e) s[e] = xsum16r(s[e]);
                    if (fr == 0) *(f32x4*)(kpart + ((size_t)wr * 64 + u.pm) * 1024 + col0 + bj * HALF + 4 * n) = s; }
        }
    }
};

struct EpiProjI8 {
    static constexpr int NS = 8;      static constexpr bool STAGED = false, PERM = true, AFTER_DRAIN = false, MID = false, LDSX = false; static constexpr int MID_T = 0;
    bf16_t* O; const float* xs;
    __device__ __forceinline__ void mid(f32x4 (&)[2][2][4][2], PG8_LAS unsigned char*, int, int) const {}
    __device__ __forceinline__ void operator()(const f32x4 (&acc)[2][2][4][2], const Unit& u, int wr, int wc, int fr, int fq) const {
        const int row0 = u.pm * BM + wr * 64 + fr;
        float sc[2][4];
#pragma unroll
        for (int ai = 0; ai < 2; ++ai)
#pragma unroll
            for (int m = 0; m < 4; ++m) sc[ai][m] = xs[row0 + ai * HALF + m * 16] * WQ_INV;
        if (u.pn >= 8) {
            bf16_t* zb = O + (size_t)4 * ((size_t)M_TOK * 1024); const int ch0 = (u.pn - 8) * HALF + wc * 32 + 8 * fq;
#pragma unroll
            for (int ai = 0; ai < 2; ++ai)
#pragma unroll
                for (int m = 0; m < 4; ++m) { const float s2 = sc[ai][m] * sc[ai][m];
                    const f32x4 v0 = i32_to_f32(acc[ai][0][m][0]) * i32_to_f32(acc[ai][1][m][0]) * s2, v1 = i32_to_f32(acc[ai][0][m][1]) * i32_to_f32(acc[ai][1][m][1]) * s2;
                    u32x4 w; w.x = cvt_pk_bf16(v0[0], v0[1]); w.y = cvt_pk_bf16(v0[2], v0[3]); w.z = cvt_pk_bf16(v1[0], v1[1]); w.w = cvt_pk_bf16(v1[2], v1[3]);
                    __builtin_nontemporal_store(w, (u32x4*)(zb + (size_t)(row0 + ai * HALF + m * 16) * 1024 + ch0)); }
            return;
        }
        bf16_t* base = O + (size_t)(2 + (u.pn >> 2)) * ((size_t)M_TOK * 1024);
        const int col0 = (u.pn & 3) * BM + wc * 32 + 8 * fq;
#pragma unroll
        for (int ai = 0; ai < 2; ++ai)
#pragma unroll
            for (int m = 0; m < 4; ++m) { bf16_t* rowp = base + (size_t)(row0 + ai * HALF + m * 16) * 1024 + col0;
#pragma unroll
                for (int bj = 0; bj < 2; ++bj) { const f32x4 v0 = i32_to_f32(acc[ai][bj][m][0]) * sc[ai][m], v1 = i32_to_f32(acc[ai][bj][m][1]) * sc[ai][m];
                    u32x4 w; w.x = cvt_pk_bf16(v0[0], v0[1]); w.y = cvt_pk_bf16(v0[2], v0[3]); w.z = cvt_pk_bf16(v1[0], v1[1]); w.w = cvt_pk_bf16(v1[2], v1[3]);
                    if (u.pn >= 4) __builtin_nontemporal_store(w, (u32x4*)(rowp + bj * HALF)); else *(u32x4*)(rowp + bj * HALF) = w; } }
    }
};

struct EpiWo {
    static constexpr int NS = 0; static constexpr bool STAGED = true, PERM = true, AFTER_DRAIN = false, MID = true; static constexpr int MID_T = 8;
    const bf16_t* xb; bf16_t* YB; unsigned char* Y8; float* stats; const float* ssq;
    __device__ __forceinline__ void pre(const Unit& u, PG8_LAS unsigned char* ldsx, int tid) const {
        if (tid < BM) { const int row = u.pm * BM + tid;
            const f32x4 a = *(const f32x4*)(ssq + (size_t)row * 8), b = *(const f32x4*)(ssq + (size_t)row * 8 + 4);
            ((PG8_LAS float*)ldsx)[tid] = __builtin_amdgcn_rsqf((hsum4(a) + hsum4(b)) * (1.0f / 1024.0f) + RMS_EPS) * P3_ATT_INV; }
    }
    __device__ __forceinline__ void mid(f32x4 (&acc)[2][2][4][2], PG8_LAS unsigned char* ldsx, int wr, int fr) const {
#pragma unroll
        for (int ai = 0; ai < 2; ++ai)
#pragma unroll
            for (int m = 0; m < 4; ++m) { const float ra = ((const PG8_LAS float*)ldsx)[ai * HALF + wr * 64 + m * 16 + fr];
#pragma unroll
                for (int bj = 0; bj < 2; ++bj)
#pragma unroll
                    for (int n = 0; n < 2; ++n) acc[ai][bj][m][n] *= ra; }
    }
    __device__ __forceinline__ void operator()(const f32x4 (&)[2][2][4][2], const Unit&, int, int, int, int) const {}
    __device__ __forceinline__ void staged(const f32x4 (&acc)[2][2][4][2], const Unit& u, int wr, int wc, int fr, int fq, PG8_LAS unsigned char* stg, int tid) const {
        typedef float f32x2 __attribute__((ext_vector_type(2)));
        PG8_LAS f32x2* tab = (PG8_LAS f32x2*)(stg + 1024);
        const int row0 = u.pm * BM + wr * 64 + fr, col0 = u.pn * BM + wc * 32 + 8 * fq;
        constexpr int YP = 272, YBUF = 32 * YP;
        PG8_LAS unsigned char* ybase = stg + 1024 + 4 * BM * 8;
        const int ywofs = (wr * 16 + fr) * YP + wc * 32 + 8 * fq, yrrow = tid >> 4, yrofs = yrrow * YP + (tid & 15) * 16;
        unsigned char* ydst = Y8 + (size_t)(u.pm * BM + (yrrow >> 4) * 64 + (yrrow & 15)) * DM + u.pn * BM + (tid & 15) * 16;
#pragma unroll
        for (int ai = 0; ai < 2; ++ai) {
        u32x4 xr[2][4][2];
#pragma unroll
            for (int m = 0; m < 4; ++m)
#pragma unroll
                for (int bj = 0; bj < 2; ++bj) xr[ai][m][bj] = __builtin_nontemporal_load((const u32x4*)(xb + (size_t)(row0 + ai * HALF + m * 16) * DM + col0 + bj * HALF));
#pragma unroll
            for (int m = 0; m < 4; ++m) { float s = 0.f, q = 0.f; PG8_LAS unsigned char* yb_ = ybase + ((ai * 4 + m) & 1) * YBUF;
#pragma unroll
                for (int bj = 0; bj < 2; ++bj) { const u32x4 xw = xr[ai][m][bj];
                    const f32x4 x0 = (f32x4){bf_lo(xw.x), bf_hi(xw.x), bf_lo(xw.y), bf_hi(xw.y)}, x1 = (f32x4){bf_lo(xw.z), bf_hi(xw.z), bf_lo(xw.w), bf_hi(xw.w)};
                    const f32x4 v0 = acc[ai][bj][m][0] + x0 * ALPHA, v1 = acc[ai][bj][m][1] + x1 * ALPHA;
                    s += hsum4(v0) + hsum4(v1); q += hsq4(v0) + hsq4(v1);
                    u32x4 w; w.x = cvt_pk_bf16(v0[0], v0[1]); w.y = cvt_pk_bf16(v0[2], v0[3]); w.z = cvt_pk_bf16(v1[0], v1[1]); w.w = cvt_pk_bf16(v1[2], v1[3]);
                    typedef unsigned u32x2 __attribute__((ext_vector_type(2)));
                    *(PG8_LAS u32x2*)(yb_ + ywofs + bj * HALF) = (u32x2){pack_i8x4(v0 * YQ_SCALE), pack_i8x4(v1 * YQ_SCALE)}; }
                s = xsum_rows(s); q = xsum_rows(q);
                if (fq == 0) tab[wc * BM + ai * HALF + wr * 64 + m * 16 + fr] = (f32x2){s, q};
                asm volatile("s_waitcnt lgkmcnt(0)" ::: "memory"); __builtin_amdgcn_s_barrier();
                *(u32x4*)(ydst + (size_t)(ai * HALF + m * 16) * DM) = *(const PG8_LAS u32x4*)(yb_ + yrofs); }
        }
        if (tid < BM) { const f32x2 a = tab[tid], b = tab[BM + tid], c = tab[2 * BM + tid], d = tab[3 * BM + tid];
            float* sp = stats + (size_t)(u.pm * BM + tid) * 2;
            atomic_addf(sp, (a.x + b.x) + (c.x + d.x)); atomic_addf(sp + 1, (a.y + b.y) + (c.y + d.y)); }
    }
};

struct EpiUp {
    static constexpr int NS = 8;
    static constexpr bool STAGED = true, PERM = true, AFTER_DRAIN = false, MID = false; static constexpr int MID_T = 0;
    const float* stats1; const float* c1; const float* c2; unsigned char* R;
    __device__ __forceinline__ void mid(f32x4 (&)[2][2][4][2], PG8_LAS unsigned char*, int, int) const {}
    __device__ __forceinline__ void operator()(const f32x4 (&)[2][2][4][2], const Unit&, int, int, int, int) const {}
    __device__ __forceinline__ void staged(const f32x4 (&acc)[2][2][4][2], const Unit& u, int wr, int wc, int fr, int fq, PG8_LAS unsigned char* stg, int tid) const {
        const int row0 = u.pm * BM + wr * 64 + fr, col0 = u.pn * BM + wc * 32 + 8 * fq;
        f32x4 k1[2][2], k2[2][2];
#pragma unroll
        for (int bj = 0; bj < 2; ++bj)
#pragma unroll
            for (int n = 0; n < 2; ++n) { k1[bj][n] = *(const f32x4*)(c1 + col0 + bj * HALF + 4 * n); k2[bj][n] = *(const f32x4*)(c2 + col0 + bj * HALF + 4 * n); }
        typedef float f32x2 __attribute__((ext_vector_type(2))); f32x2 st[2][4];
#pragma unroll
        for (int ai = 0; ai < 2; ++ai)
#pragma unroll
            for (int m = 0; m < 4; ++m) st[ai][m] = *(const f32x2*)(stats1 + (size_t)(row0 + ai * HALF + m * 16) * 2);
        int w0 = 0, w1 = 0;
        constexpr int PITCH = 272, BUF = 32 * PITCH;
        const int wofs = (wr * 16 + fr) * PITCH + wc * 32 + 8 * fq, rrow = tid >> 4, rofs = rrow * PITCH + (tid & 15) * 16;
        unsigned char* gout = R + (size_t)(u.pm * BM + (rrow >> 4) * 64 + (rrow & 15)) * FF + u.pn * BM + (tid & 15) * 16;
#pragma unroll
        for (int ai = 0; ai < 2; ++ai)
#pragma unroll
            for (int m = 0; m < 4; ++m) { PG8_LAS unsigned char* buf = stg + ((ai * 4 + m) & 1) * BUF;
                const float sm = st[ai][m].x, sq = st[ai][m].y;
                const float mu = sm * (1.0f / DM), var = sq * (1.0f / DM) - mu * mu, rstd = __builtin_amdgcn_rsqf(var + LN_EPS), rs = rstd * (YQ_INV * WQ_INV), nm = -rstd * mu;
#pragma unroll
                for (int bj = 0; bj < 2; ++bj) {
                    f32x4 v0 = i32_to_f32(acc[ai][bj][m][0]) * rs + (k1[bj][0] * nm + k2[bj][0]), v1 = i32_to_f32(acc[ai][bj][m][1]) * rs + (k1[bj][1] * nm + k2[bj][1]);
#pragma unroll
                    for (int e = 0; e < 4; ++e) { v0[e] = __builtin_amdgcn_fmed3f(v0[e], 0.f, 21.166f); v1[e] = __builtin_amdgcn_fmed3f(v1[e], 0.f, 21.166f); }
                    v0 = v0 * v0; v1 = v1 * v1;
                    w0 = __builtin_amdgcn_cvt_pk_fp8_f32(v0[0], v0[1], w0, false); w0 = __builtin_amdgcn_cvt_pk_fp8_f32(v0[2], v0[3], w0, true);
                    w1 = __builtin_amdgcn_cvt_pk_fp8_f32(v1[0], v1[1], w1, false); w1 = __builtin_amdgcn_cvt_pk_fp8_f32(v1[2], v1[3], w1, true);
                    typedef int i32x2 __attribute__((ext_vector_type(2)));
                    *(PG8_LAS i32x2*)(buf + wofs + bj * HALF) = (i32x2){w0, w1}; }
                asm volatile("s_waitcnt lgkmcnt(0)" ::: "memory"); __builtin_amdgcn_s_barrier();
                const u32x4 v = *(const PG8_LAS u32x4*)(buf + rofs);
                __builtin_nontemporal_store(v, (u32x4*)(gout + (size_t)(ai * HALF + m * 16) * FF)); }
    }
};

#ifndef OUT_NT
#define OUT_NT 1
#endif
#if OUT_NT
#define OUT_STORE(v_, p_) __builtin_nontemporal_store(v_, p_)
#else
#define OUT_STORE(v_, p_) (*(p_) = (v_))
#endif
struct EpiDownLN {
    static constexpr int NS = 0; static constexpr bool STAGED = true, PERM = true, AFTER_DRAIN = false, MID = false; static constexpr int MID_T = 0;
    const unsigned char* Y8; const float* stats1; const float* g1; const float* b1; float* stats2; unsigned* cnt; const float* g2; const float* b2; float* out;
    __device__ __forceinline__ void mid(f32x4 (&)[2][2][4][2], PG8_LAS unsigned char*, int, int) const {}
    __device__ __forceinline__ void operator()(f32x4 (&)[2][2][4][2], const Unit&, int, int, int, int) const {}
    __device__ __forceinline__ void staged(f32x4 (&acc)[2][2][4][2], const Unit& u, int wr, int wc, int fr, int fq, PG8_LAS unsigned char* stg, int tid) const {
        const int row0 = u.pm * BM + wr * 64 + fr, col0 = u.pn * BM + wc * 32 + 8 * fq;
        typedef float f32x2 __attribute__((ext_vector_type(2)));
        PG8_LAS f32x2* tab = (PG8_LAS f32x2*)(stg + 1024); PG8_LAS f32x2* tab2 = tab + 4 * BM;
        {
        f32x4 gv[2][2], bv[2][2];
#pragma unroll
        for (int bj = 0; bj < 2; ++bj)
#pragma unroll
            for (int n = 0; n < 2; ++n) { gv[bj][n] = *(const f32x4*)(g1 + col0 + bj * HALF + 4 * n); bv[bj][n] = *(const f32x4*)(b1 + col0 + bj * HALF + 4 * n); }
        typedef unsigned u32x2 __attribute__((ext_vector_type(2)));
        constexpr int YP = 272, YBUF = 32 * YP;
        PG8_LAS unsigned char* ybase = stg + 1024 + 4 * BM * 8 + BM * 8;
        const int yrow = tid >> 4, ychunk = tid & 15;
        const unsigned char* ysrc = Y8 + (size_t)(u.pm * BM + (yrow >> 4) * 64 + (yrow & 15)) * DM + u.pn * BM + ychunk * 16;
        const int ywofs = yrow * YP + ychunk * 16, yrofs = (wr * 16 + fr) * YP + wc * 32 + 8 * fq;
#pragma unroll
        for (int ai = 0; ai < 2; ++ai) {
            u32x4 yl[4]; f32x2 st1[4];
#pragma unroll
            for (int m = 0; m < 4; ++m) yl[m] = __builtin_nontemporal_load((const u32x4*)(ysrc + (size_t)(ai * HALF + m * 16) * DM));
#pragma unroll
            for (int m = 0; m < 4; ++m) st1[m] = *(const f32x2*)(stats1 + (size_t)(row0 + ai * HALF + m * 16) * 2);
#pragma unroll
            for (int m = 0; m < 4; ++m) { const int row = row0 + ai * HALF + m * 16;
                PG8_LAS unsigned char* yb_ = ybase + ((ai * 4 + m) & 1) * YBUF;
                *(PG8_LAS u32x4*)(yb_ + ywofs) = yl[m];
                asm volatile("s_waitcnt lgkmcnt(0)" ::: "memory"); __builtin_amdgcn_s_barrier();
                u32x2 yr[2]; yr[0] = *(const PG8_LAS u32x2*)(yb_ + yrofs); yr[1] = *(const PG8_LAS u32x2*)(yb_ + yrofs + HALF);
                const f32x2 stv = st1[m]; const float sm = stv.x, sq = stv.y;
                const float mu = sm * (1.0f / DM), var = sq * (1.0f / DM) - mu * mu, rstd = __builtin_amdgcn_rsqf(var + LN_EPS);
                float s = 0.f, q = 0.f;
#pragma unroll
                for (int bj = 0; bj < 2; ++bj) { const u32x2 yb = yr[bj];
                    f32x4 y0 = (f32x4){(float)(int)(signed char)(yb.x), (float)(int)(signed char)(yb.x >> 8), (float)(int)(signed char)(yb.x >> 16), (float)((int)yb.x >> 24)} * YQ_INV;
                    f32x4 y1 = (f32x4){(float)(int)(signed char)(yb.y), (float)(int)(signed char)(yb.y >> 8), (float)(int)(signed char)(yb.y >> 16), (float)((int)yb.y >> 24)} * YQ_INV;
                    const f32x4 h0 = (y0 - mu) * rstd * gv[bj][0] + bv[bj][0], h1 = (y1 - mu) * rstd * gv[bj][1] + bv[bj][1];
                    const f32x4 v0 = acc[ai][bj][m][0] * WDN_INV_SCALE + h0 * ALPHA, v1 = acc[ai][bj][m][1] * WDN_INV_SCALE + h1 * ALPHA;
                    s += hsum4(v0) + hsum4(v1); q += hsq4(v0) + hsq4(v1);
                    acc[ai][bj][m][0] = v0; acc[ai][bj][m][1] = v1; }
                s = xsum_rows(s); q = xsum_rows(q);
                if (fq == 0) tab[wc * BM + ai * HALF + wr * 64 + m * 16 + fr] = (f32x2){s, q}; }
        }
        }
        asm volatile("s_waitcnt lgkmcnt(0)" ::: "memory"); __builtin_amdgcn_s_barrier();
        unsigned* pc = cnt + 64 * u.pm;
        if (tid < BM) {
            const f32x2 a = tab[tid], b = tab[BM + tid], c = tab[2 * BM + tid], d = tab[3 * BM + tid];
            float* sp = stats2 + (size_t)(u.pm * BM + tid) * 2;
            atomic_addf(sp, (a.x + b.x) + (c.x + d.x)); atomic_addf(sp + 1, (a.y + b.y) + (c.y + d.y));
            asm volatile("s_waitcnt vmcnt(0)" ::: "memory");
            if ((tid & 63) == 0) (void)__hip_atomic_fetch_add(pc, 1u, __ATOMIC_RELAXED, __HIP_MEMORY_SCOPE_AGENT);
            { unsigned spins = 0;
              while ((unsigned)__builtin_amdgcn_readfirstlane(__hip_atomic_load(pc, __ATOMIC_RELAXED, __HIP_MEMORY_SCOPE_AGENT)) < 32u) { __builtin_amdgcn_s_sleep(2); if (++spins > (1u << 20)) break; } }
            const float sm = __hip_atomic_load(sp, __ATOMIC_RELAXED, __HIP_MEMORY_SCOPE_AGENT), sq = __hip_atomic_load(sp + 1, __ATOMIC_RELAXED, __HIP_MEMORY_SCOPE_AGENT);
            const float mu = sm * (1.0f / DM), var = sq * (1.0f / DM) - mu * mu;
            tab2[tid] = (f32x2){mu, __builtin_amdgcn_rsqf(var + LN_EPS)}; }
        asm volatile("s_waitcnt lgkmcnt(0)" ::: "memory"); __builtin_amdgcn_s_barrier();
        f32x4 gg[2][2], bb[2][2];
#pragma unroll
        for (int bj = 0; bj < 2; ++bj)
#pragma unroll
            for (int n = 0; n < 2; ++n) { gg[bj][n] = *(const f32x4*)(g2 + col0 + bj * HALF + 4 * n); bb[bj][n] = *(const f32x4*)(b2 + col0 + bj * HALF + 4 * n); }
#pragma unroll
        for (int ai = 0; ai < 2; ++ai)
#pragma unroll
            for (int m = 0; m < 4; ++m) { const int row = row0 + ai * HALF + m * 16;
                const f32x2 mr = tab2[ai * HALF + wr * 64 + m * 16 + fr]; const float mu = mr.x, rstd = mr.y;
#pragma unroll
                for (int bj = 0; bj < 2; ++bj) {
                    const f32x4 o0 = (acc[ai][bj][m][0] - mu) * rstd * gg[bj][0] + bb[bj][0], o1 = (acc[ai][bj][m][1] - mu) * rstd * gg[bj][1] + bb[bj][1];
                    const bool odd = (fr & 1) != 0;
                    f32x4 snd, rcv;
#pragma unroll
                    for (int e = 0; e < 4; ++e) { snd[e] = odd ? o0[e] : o1[e]; rcv[e] = dpp_f<XL_Q1>(snd[e]); }
                    f32x4 sa, sb;
#pragma unroll
                    for (int e = 0; e < 4; ++e) { sa[e] = odd ? rcv[e] : o0[e]; sb[e] = odd ? o1[e] : rcv[e]; }
                    float* op = out + (size_t)(row - (fr & 1)) * DM + col0 + bj * HALF + 4 * (fr & 1);
                    OUT_STORE(sa, (f32x4*)op); OUT_STORE(sb, (f32x4*)(op + DM)); } }
    }
};
struct PanelOrder {
    int G, vcu, ntile;
    __host__ __device__ void init(int M, int N, int G_, int c) { G = G_; vcu = (G_ % 8 == 0) ? (c % 8) * (G_ / 8) + c / 8 : c; ntile = (M / BM) * (N / BM); }
    __host__ __device__ bool next(int i, Unit& u) const { const int idx = i * G + vcu; if (idx >= ntile) return false;
        if (G == 256) { const int g = vcu >> 5, w = vcu & 31; u.pm = 8 * g + 4 * i + (w >> 3); u.pn = w & 7; }
        else { u.pm = idx >> 3; u.pn = idx & 7; }
        return true; }
    __device__ __forceinline__ void a_ready(const Unit&) const {}
    __device__ __forceinline__ void done(const Unit&) const {}
};

template <class Epi, class Sched, bool ALIGN_EPI = false, bool SP2 = false, int FP8M = 0, int F8T1 = 0>
__device__ __forceinline__ void gemm_phase(PG8_LAS unsigned char* lds, const Gemm g, const Sched& S, const Epi& E) {
    int tid_ = threadIdx.x; asm volatile("" : "+v"(tid_));
    const int tid = tid_, wid = __builtin_amdgcn_readfirstlane(tid >> 6), lane = tid & 63, wr = wid >> 2, wc = wid & 3, fr = lane & 15, fq = lane >> 4;
    const int K = g.K, nt = K / BK;
    unsigned voffA[2], voffB[2];
#pragma unroll
    for (int i = 0; i < 2; ++i) { int R, C; stage_rc(tid * 16 + i * 8192, R, C); const int Rb = Epi::PERM ? ((R & ~31) + perm32(R & 31)) : R;
        voffA[i] = (unsigned)(R * K + C) * 2u; voffB[i] = (unsigned)(Rb * K + C) * 2u; }
    const size_t kstep = (size_t)(BK * 2);
    const size_t hstep = (size_t)HALF * K * 2;
    const size_t tstep = 2 * hstep;
    const unsigned ldsw = (unsigned)wid * 1024u;
    const int aoff = lds_byte(wr * 64 + fr, fq * 8), boff = lds_byte(wc * 32 + fr, fq * 8);
#define PG8_SA(b, h) (((b) * 2 + (h)) * HTB)
#define PG8_SB(b, h) ((4 + (b) * 2 + (h)) * HTB)
#define PG8_STAGE(bufoff, gbase, voff) do { _Pragma("unroll") for (int _i = 0; _i < 2; ++_i) \
        __builtin_amdgcn_global_load_lds((const unsigned*)((const char*)(gbase) + (voff)[_i]), (PG8_LAS unsigned*)(lds + (bufoff) + ldsw + _i * 8192), 16, 0, 0); } while (0)
#define PG8_LDA(dst, b, h) do { _Pragma("unroll") for (int m = 0; m < 4; ++m) _Pragma("unroll") for (int k = 0; k < 2; ++k) dst[m][k] = *(const PG8_LAS bf16x8*)(lds + PG8_SA(b, h) + aoff + m * 2048 + k * 1024); } while (0)
#define PG8_LDB(dst, b, h) do { _Pragma("unroll") for (int n = 0; n < 2; ++n) _Pragma("unroll") for (int k = 0; k < 2; ++k) dst[n][k] = *(const PG8_LAS bf16x8*)(lds + PG8_SB(b, h) + boff + n * 2048 + k * 1024); } while (0)
#define PG8_CAT(x0, x1) __builtin_shufflevector(__builtin_bit_cast(v4i_t, x0), __builtin_bit_cast(v4i_t, x1), 0, 1, 2, 3, 4, 5, 6, 7)
#define PG8_MMA_F8(ai, bj, At, Bt) do { __builtin_amdgcn_s_setprio(1); _Pragma("unroll") for (int m = 0; m < 4; ++m) _Pragma("unroll") for (int n = 0; n < 2; ++n) \
        asm volatile("v_mfma_scale_f32_16x16x128_f8f6f4 %0, %1, %2, %0, %3, %3 op_sel_hi:[0,0,0]" : "+v"(acc[ai][bj][m][n]) : "v"(PG8_CAT(Bt[n][0], Bt[n][1])), "v"(PG8_CAT(At[m][0], At[m][1])), "v"(scl8)); \
        __builtin_amdgcn_s_setprio(0); } while (0)
#define PG8_MMA_B16A(ai, bj, At, Bt) do { __builtin_amdgcn_s_setprio(1); _Pragma("unroll") for (int m = 0; m < 4; ++m) _Pragma("unroll") for (int n = 0; n < 2; ++n) _Pragma("unroll") for (int k = 0; k < 2; ++k) \
        asm volatile("v_mfma_f32_16x16x32_bf16 %0, %1, %2, %0" : "+v"(acc[ai][bj][m][n]) : "v"(Bt[n][k]), "v"(At[m][k]));   \
        __builtin_amdgcn_s_setprio(0); } while (0)
#define PG8_MMA_B16(ai, bj, At, Bt) do { __builtin_amdgcn_s_setprio(1); _Pragma("unroll") for (int m = 0; m < 4; ++m) _Pragma("unroll") for (int n = 0; n < 2; ++n) _Pragma("unroll") for (int k = 0; k < 2; ++k) \
        acc[ai][bj][m][n] = __builtin_amdgcn_mfma_f32_16x16x32_bf16(Bt[n][k], At[m][k], acc[ai][bj][m][n], 0, 0, 0); __builtin_amdgcn_s_setprio(0); } while (0)
#define PG8_MMA_I8(ai, bj, At, Bt) do { __builtin_amdgcn_s_setprio(1); _Pragma("unroll") for (int m = 0; m < 4; ++m) _Pragma("unroll") for (int n = 0; n < 2; ++n) _Pragma("unroll") for (int k = 0; k < 2; ++k) \
        acc[ai][bj][m][n] = __builtin_bit_cast(f32x4, __builtin_amdgcn_mfma_i32_16x16x64_i8(__builtin_bit_cast(v4i_t, Bt[n][k]), __builtin_bit_cast(v4i_t, At[m][k]), __builtin_bit_cast(v4i_t, acc[ai][bj][m][n]), 0, 0, 0)); \
        __builtin_amdgcn_s_setprio(0); } while (0)
#define PG8_MMA(ai, bj, At, Bt) PG8_MMA_B16(ai, bj, At, Bt)
#define PG8_WAIT_V(n) asm volatile("s_waitcnt vmcnt(" #n ")" ::: "memory")
#define PG8_WAIT_L(n) asm volatile("s_waitcnt lgkmcnt(" #n ")" ::: "memory")
#define PG8_WAIT_V1() do { if constexpr (Epi::NS == 8) asm volatile("s_waitcnt vmcnt(16)\n\ts_cmp_lg_u32 %0, 0\n\ts_cbranch_scc1 .Lrx%=\n\ts_waitcnt vmcnt(8)\n.Lrx%=:" :: "s"(rxi) : "scc", "memory"); \
                           else if constexpr (Epi::NS == 16) asm volatile("s_waitcnt vmcnt(24)\n\ts_cmp_lg_u32 %0, 0\n\ts_cbranch_scc1 .Lrx%=\n\ts_waitcnt vmcnt(8)\n.Lrx%=:" :: "s"(rxi) : "scc", "memory"); \
                           else asm volatile("s_waitcnt vmcnt(8)" ::: "memory"); } while (0)
#define PG8_BAR __builtin_amdgcn_s_barrier()
#define PG8_SCHED __builtin_amdgcn_sched_barrier(0)
#define PG8_ITER_SP2(MMA_) do { \
            PG8_LDB(B0, 0, 0); PG8_LDB(B1, 0, 1); PG8_SCHED; PG8_LDA(At, 0, 0); PG8_STAGE(PG8_SA(1, 1), a1 + hstep, voffA); \
            PG8_WAIT_V1(); PG8_WAIT_L(0); PG8_BAR; MMA_(0, 0, At, B0); MMA_(0, 1, At, B1); PG8_BAR; PG8_SCHED; \
            PG8_LDA(At, 0, 1); PG8_STAGE(PG8_SB(0, 0), b2, voffB); PG8_STAGE(PG8_SB(0, 1), b2 + hstep, voffB); PG8_STAGE(PG8_SA(0, 0), a2, voffA); \
            PG8_WAIT_V1(); PG8_WAIT_L(0); PG8_BAR; MMA_(1, 0, At, B0); MMA_(1, 1, At, B1); PG8_BAR; PG8_SCHED; \
            PG8_LDB(B0, 1, 0); PG8_LDB(B1, 1, 1); PG8_SCHED; PG8_LDA(At, 1, 0); PG8_STAGE(PG8_SA(0, 1), a2 + hstep, voffA); \
            PG8_WAIT_V(8); PG8_WAIT_L(0); PG8_BAR; MMA_(0, 0, At, B0); MMA_(0, 1, At, B1); PG8_BAR; PG8_SCHED; \
            PG8_LDA(At, 1, 1); PG8_STAGE(PG8_SB(1, 0), b3, voffB); PG8_STAGE(PG8_SB(1, 1), b3 + hstep, voffB); PG8_STAGE(PG8_SA(1, 0), a3, voffA); \
            PG8_WAIT_V(8); PG8_WAIT_L(0); PG8_BAR; MMA_(1, 0, At, B0); MMA_(1, 1, At, B1); PG8_BAR; PG8_SCHED; \
            } while (0)
    Unit cur, nxt; int ui = 0;
    if (!S.next(0, cur)) return;
    f32x4 acc[2][2][4][2];
#pragma unroll
    for (int a = 0; a < 2; ++a)
#pragma unroll
        for (int b = 0; b < 2; ++b)
#pragma unroll
            for (int m = 0; m < 4; ++m)
#pragma unroll
                for (int n = 0; n < 2; ++n) acc[a][b][m][n] = (f32x4){0.f, 0.f, 0.f, 0.f};
    bf16x8 At[4][2], B0[2][2], B1[2][2];
    int scl8 = 0x7f7f7f7f; asm volatile("" : "+v"(scl8));
    const char* cA = (const char*)g.A + (size_t)cur.pm * tstep; const char* cB = (const char*)g.Bt + (size_t)cur.pn * tstep;
    S.a_ready(cur);
    if constexpr (Epi::MID) E.pre(cur, lds + STAGE_BYTES, tid);
    if constexpr (SP2) {
        PG8_STAGE(PG8_SB(0, 0), cB, voffB); PG8_STAGE(PG8_SB(0, 1), cB + hstep, voffB); PG8_STAGE(PG8_SA(0, 0), cA, voffA); PG8_STAGE(PG8_SA(0, 1), cA + hstep, voffA);
        if (wr == 1) PG8_BAR;
        PG8_WAIT_V(2); PG8_BAR;
        PG8_STAGE(PG8_SB(1, 0), cB + kstep, voffB); PG8_STAGE(PG8_SA(1, 0), cA + kstep, voffA); PG8_STAGE(PG8_SB(1, 1), cB + hstep + kstep, voffB);
        PG8_WAIT_V(6); PG8_BAR;
    } else {
        PG8_STAGE(PG8_SB(0, 0), cB, voffB); PG8_STAGE(PG8_SA(0, 0), cA, voffA); PG8_STAGE(PG8_SB(0, 1), cB + hstep, voffB); PG8_STAGE(PG8_SA(0, 1), cA + hstep, voffA);
        if (wr == 1) PG8_BAR;
        PG8_WAIT_V(4); PG8_BAR;
        PG8_STAGE(PG8_SB(1, 0), cB + kstep, voffB); PG8_STAGE(PG8_SA(1, 0), cA + kstep, voffA); PG8_STAGE(PG8_SB(1, 1), cB + hstep + kstep, voffB);
        PG8_WAIT_V(6); PG8_BAR;
    }
    for (;;) {
        const bool has_next = S.next(ui + 1, nxt);
        const char* nA = has_next ? (const char*)g.A + (size_t)nxt.pm * tstep : cA; const char* nB = has_next ? (const char*)g.Bt + (size_t)nxt.pn * tstep : cB;
        constexpr int SPLIT = Epi::MID ? Epi::MID_T : (FP8M == 1 ? F8T1 : 0);
        if constexpr (SPLIT > 0 && SP2) {
            for (int t = 0; t < SPLIT; t += 2) { constexpr int rxi = 0; (void)rxi;
                const char* a1 = cA + (size_t)(t + 1) * kstep; const char* a2 = cA + (size_t)(t + 2) * kstep; const char* b2 = cB + (size_t)(t + 2) * kstep;
                const char* a3 = a2 + kstep; const char* b3 = b2 + kstep;
                if constexpr (FP8M == 1) PG8_ITER_SP2(PG8_MMA_B16A); else if constexpr (FP8M == 2 || FP8M == 6) PG8_ITER_SP2(PG8_MMA_F8); else if constexpr (FP8M == 3) PG8_ITER_SP2(PG8_MMA_I8); else PG8_ITER_SP2(PG8_MMA_B16);
            }
            if constexpr (FP8M == 1) asm volatile("s_nop 15" ::: "memory");
            if constexpr (FP8M == 6) { asm volatile("s_nop 15\n\ts_nop 15" ::: "memory"); PG8_SCHED; }
            if constexpr (Epi::MID) E.mid(acc, lds + STAGE_BYTES, wr, fr);
        }
        for (int t = SPLIT; t < nt; t += 2) {
            const bool last = (t == nt - 2); const int rxi = __builtin_amdgcn_readfirstlane(((Epi::NS > 0) && t == 0 && ui > 0) ? 1 : 0); (void)rxi;
            const char* a1 = cA + (size_t)(t + 1) * kstep;
            const char* a2 = last ? nA : cA + (size_t)(t + 2) * kstep; const char* b2 = last ? nB : cB + (size_t)(t + 2) * kstep;
            const char* a3 = a2 + kstep; const char* b3 = b2 + kstep;
            if (last && has_next) S.a_ready(nxt);
            if constexpr (SP2) {
            if constexpr (FP8M == 1) PG8_ITER_SP2(PG8_MMA_F8);
            else if constexpr (FP8M == 2) PG8_ITER_SP2(PG8_MMA_F8);
            else if constexpr (FP8M == 3) PG8_ITER_SP2(PG8_MMA_I8);
            else PG8_ITER_SP2(PG8_MMA_B16);
            } else {
            PG8_LDB(B0, 0, 0); PG8_SCHED; PG8_LDA(At, 0, 0); PG8_STAGE(PG8_SA(1, 1), a1 + hstep, voffA);
            PG8_WAIT_L(8); PG8_BAR; PG8_WAIT_L(0); PG8_MMA(0, 0, At, B0); PG8_BAR; PG8_SCHED;
            PG8_LDB(B1, 0, 1); PG8_STAGE(PG8_SB(0, 0), b2, voffB);
            PG8_BAR; PG8_WAIT_L(0); PG8_MMA(0, 1, At, B1); PG8_BAR;
            PG8_LDA(At, 0, 1); PG8_STAGE(PG8_SA(0, 0), a2, voffA);
            PG8_BAR; PG8_WAIT_L(0); PG8_MMA(1, 0, At, B0); PG8_BAR; PG8_SCHED;
            PG8_STAGE(PG8_SB(0, 1), b2 + hstep, voffB);
            PG8_WAIT_V(6); PG8_BAR; PG8_MMA(1, 1, At, B1); PG8_BAR;
            PG8_LDB(B0, 1, 0); PG8_SCHED; PG8_LDA(At, 1, 0); PG8_STAGE(PG8_SA(0, 1), a2 + hstep, voffA);
            PG8_WAIT_L(8); PG8_BAR; PG8_WAIT_L(0); PG8_MMA(0, 0, At, B0); PG8_BAR; PG8_SCHED;
            PG8_LDB(B1, 1, 1); PG8_STAGE(PG8_SB(1, 0), b3, voffB);
            PG8_BAR; PG8_WAIT_L(0); PG8_MMA(0, 1, At, B1); PG8_BAR;
            PG8_LDA(At, 1, 1); PG8_STAGE(PG8_SA(1, 0), a3, voffA);
            PG8_BAR; PG8_WAIT_L(0); PG8_MMA(1, 0, At, B0); PG8_BAR; PG8_SCHED;
            PG8_STAGE(PG8_SB(1, 1), b3 + hstep, voffB);
            PG8_WAIT_V(6); PG8_BAR; PG8_MMA(1, 1, At, B1); PG8_BAR;
            }
        }
        if constexpr (ALIGN_EPI) { if (wr == 0) PG8_BAR; }
        if constexpr (FP8M == 1 || FP8M == 2) { asm volatile("s_nop 15\n\ts_nop 15" ::: "memory"); PG8_SCHED; }
        if constexpr (Epi::STAGED) { E.staged(acc, cur, wr, wc, fr, fq, lds + STAGE_BYTES, tid); S.done(cur); }
        else if constexpr (!Epi::AFTER_DRAIN) { E(acc, cur, wr, wc, fr, fq); S.done(cur); }
        if (!has_next) break;
#pragma unroll
        for (int a = 0; a < 2; ++a)
#pragma unroll
            for (int b = 0; b < 2; ++b)
#pragma unroll
                for (int m = 0; m < 4; ++m)
#pragma unroll
                    for (int n = 0; n < 2; ++n) acc[a][b][m][n] = (f32x4){0.f, 0.f, 0.f, 0.f};
        cur = nxt; cA = nA; cB = nB; ++ui;
        if constexpr (Epi::MID) E.pre(cur, lds + STAGE_BYTES, tid);
        if constexpr (ALIGN_EPI) { if (wr == 1) PG8_BAR; }
    }
    PG8_WAIT_V(0);
    if constexpr (!ALIGN_EPI) { if (wr == 0) PG8_BAR; }
    PG8_BAR;
    if constexpr (Epi::AFTER_DRAIN) { E.fused(acc, cur, wr, wc, fr, fq, lds, wid, lane); S.done(cur); }
#undef PG8_SA
#undef PG8_SB
#undef PG8_STAGE
#undef PG8_LDA
#undef PG8_LDB
#undef PG8_MMA
#undef PG8_MMA_F8
#undef PG8_MMA_I8
#undef PG8_MMA_B16
#undef PG8_MMA_B16A
#undef PG8_ITER_SP2
#undef PG8_CAT
#undef PG8_WAIT_V
#undef PG8_WAIT_L
#undef PG8_BAR
#undef PG8_SCHED
}
}

#ifndef PG8_SP2
#define PG8_SP2 true
#endif
#ifndef PG8_ALIGN
#define PG8_ALIGN true
#endif
namespace att {
typedef unsigned short bf16;
typedef short bf16x8 __attribute__((ext_vector_type(8)));
typedef short s16x4 __attribute__((ext_vector_type(4)));
typedef float f32x16 __attribute__((ext_vector_type(16)));
typedef float f32x4 __attribute__((ext_vector_type(4)));
typedef unsigned u32x4 __attribute__((ext_vector_type(4)));
constexpr int D = 128, NW = 8, QBLK = 32, KVBLK = 64, QB = NW * QBLK, LDQ = 1024, LDO = 2048;
constexpr int SHM_V = KVBLK * D * 2, SHM_K = KVBLK * D * 2;
constexpr int NVB = 3;
constexpr int LDS_BYTES = NVB * SHM_V + 2 * SHM_K + NW * 64 * 4;
constexpr int KM_OFF = LDS_BYTES + NW * QBLK * D * 2, KM_PITCH = 272;
constexpr float SCALE = 0.08838834764831845f, THR = 8.f;
constexpr size_t KPART_STRIDE = (size_t)64 * 1024;

#define KSWZ(row, colB) ((((colB) >> 7) * 8192) + (row) * 128 + (((((colB) >> 4) & 7) ^ (((row) >> 1) & 7)) << 4))
#define SBAR() __builtin_amdgcn_sched_barrier(0)
__device__ __forceinline__ int v_st(int k, int c) { const int kk = (k & ~0xC) | ((k & 4) << 1) | ((k & 8) >> 1); return ((kk >> 3) * 4 + (c >> 5)) * 512 + ((kk & 7) * 32 + (c & 31)) * 2; }
__device__ __forceinline__ int v_rd_base(int lane) { return ((lane & 3) << 3) | (((lane >> 2) & 3) << 6) | (((lane >> 4) & 1) << 5) | (((lane >> 5) & 1) << 8); }
constexpr int v_rd_off(int d0, int ks, int half) { return d0 * 512 + ks * 4096 + half * 2048; }
__device__ __forceinline__ int crow(int r, int hi) { return (r & 3) + 8 * (r >> 2) + 4 * hi; }
__device__ __forceinline__ unsigned cvtpk(float lo, float hi) { unsigned r; asm volatile("v_cvt_pk_bf16_f32 %0, %1, %2" : "=v"(r) : "v"(lo), "v"(hi)); return r; }
__device__ __forceinline__ bf16x8 pack8(f32x4 a, f32x4 b) { u32x4 w = {cvtpk(a[0], a[1]), cvtpk(a[2], a[3]), cvtpk(b[0], b[1]), cvtpk(b[2], b[3])}; return *reinterpret_cast<bf16x8*>(&w); }
__device__ __forceinline__ bf16x8 load8(const bf16* p) { return *reinterpret_cast<const bf16x8*>(p); }
__device__ __forceinline__ void mask_tile(f32x16& p0, f32x16& p1, int dq) {
#define MT1(P, r, c_) do { float t_ = P[r]; asm volatile("v_cmp_le_i32 vcc, %1, %2\n\tv_cndmask_b32 %0, %3, %0, vcc" : "+v"(t_) : "n"(c_), "v"(dq), "v"(NEG) : "vcc"); P[r] = t_; } while (0)
    float NEG = -__builtin_inff(); asm volatile("" : "+v"(NEG));
    MT1(p0, 0, 0); MT1(p0, 1, 1); MT1(p0, 2, 2); MT1(p0, 3, 3); MT1(p0, 4, 8); MT1(p0, 5, 9); MT1(p0, 6, 10); MT1(p0, 7, 11);
    MT1(p0, 8, 16); MT1(p0, 9, 17); MT1(p0, 10, 18); MT1(p0, 11, 19); MT1(p0, 12, 24); MT1(p0, 13, 25); MT1(p0, 14, 26); MT1(p0, 15, 27);
    MT1(p1, 0, 32); MT1(p1, 1, 33); MT1(p1, 2, 34); MT1(p1, 3, 35); MT1(p1, 4, 40); MT1(p1, 5, 41); MT1(p1, 6, 42); MT1(p1, 7, 43);
    MT1(p1, 8, 48); MT1(p1, 9, 49); MT1(p1, 10, 50); MT1(p1, 11, 51); MT1(p1, 12, 56); MT1(p1, 13, 57); MT1(p1, 14, 58); MT1(p1, 15, 59);
#undef MT1
}
__device__ __forceinline__ void mask_all(f32x16& p0, f32x16& p1, bool keep) {
    const float NEG = -__builtin_inff();
#pragma unroll
    for (int r = 0; r < 16; ++r) { p0[r] = keep ? p0[r] : NEG; p1[r] = keep ? p1[r] : NEG; }
}
__device__ __forceinline__ void partialSM(f32x16& p0, f32x16& p1, float& m_reg, float& mn, float& alpha) {
    float pmax = p0[0];
#pragma unroll
    for (int r = 1; r < 16; ++r) pmax = fmaxf(pmax, p0[r]);
#pragma unroll
    for (int r = 0; r < 16; ++r) pmax = fmaxf(pmax, p1[r]);
    { auto rr = __builtin_amdgcn_permlane32_swap(__float_as_uint(pmax), __float_as_uint(pmax), false, false);
      pmax = fmaxf(__uint_as_float(rr[0]), __uint_as_float(rr[1])); }
    constexpr float C2 = 1.4426950408889634f * SCALE;
    if (__builtin_expect(__all((pmax - m_reg) * SCALE <= THR), 1)) { mn = m_reg; alpha = 1.f; }
    else { mn = fmaxf(m_reg, pmax); alpha = __builtin_amdgcn_exp2f((m_reg - mn) * C2); m_reg = mn; }
    const float mnL = -mn * C2;
#pragma unroll
    for (int r = 0; r < 16; ++r) p0[r] = fmaf(p0[r], C2, mnL);
#pragma unroll
    for (int r = 0; r < 16; ++r) p1[r] = fmaf(p1[r], C2, mnL);
#pragma unroll
    for (int r = 0; r < 16; ++r) p0[r] = __builtin_amdgcn_exp2f(p0[r]);
}
__device__ __forceinline__ void finishSM(f32x16& p0, f32x16& p1, float alpha, float& l_reg, bf16x8& pa0, bf16x8& pa1, bf16x8& pa2, bf16x8& pa3) {
#pragma unroll
    for (int r = 0; r < 16; ++r) p1[r] = __builtin_amdgcn_exp2f(p1[r]);
    float ps = 0;
#pragma unroll
    for (int r = 0; r < 16; ++r) ps += p0[r];
#pragma unroll
    for (int r = 0; r < 16; ++r) ps += p1[r];
    { auto rr = __builtin_amdgcn_permlane32_swap(__float_as_uint(ps), __float_as_uint(ps), false, false);
      ps = __uint_as_float(rr[0]) + __uint_as_float(rr[1]); }
    l_reg = l_reg * alpha + ps;
#define PK4(P, B_, OUT) do { unsigned a0 = cvtpk(P[B_+0], P[B_+1]), a1 = cvtpk(P[B_+2], P[B_+3]);                          \
        unsigned b0 = cvtpk(P[B_+4], P[B_+5]), b1 = cvtpk(P[B_+6], P[B_+7]);                                             \
        auto r0 = __builtin_amdgcn_permlane32_swap(a0, b0, false, false); auto r1 = __builtin_amdgcn_permlane32_swap(a1, b1, false, false); \
        u32x4 w = {r0[0], r1[0], r0[1], r1[1]}; OUT = *reinterpret_cast<bf16x8*>(&w); } while (0)
    PK4(p0, 0, pa0); PK4(p0, 8, pa1); PK4(p1, 0, pa2); PK4(p1, 8, pa3);
#undef PK4
}
template <int KB>
__device__ __forceinline__ void qkt(f32x16& p0, f32x16& p1, const char* K_lds, int r32, int hi, const bf16x8* qr) {
    p0 = f32x16{}; p1 = f32x16{};
    int kb[4];
#pragma unroll
    for (int dd = 0; dd < 4; ++dd) kb[dd] = (int)(uintptr_t)(K_lds + KSWZ(r32, (dd * 16 + hi * 8) * 2));
#define KRD(dst, d0_) do { asm volatile("ds_read_b128 %0, %1 offset:%2" : "=&v"(dst[0]) : "v"(kb[(d0_) & 3]), "i"(KB * SHM_K + ((d0_) >> 2) * 8192) : "memory");          \
                           asm volatile("ds_read_b128 %0, %1 offset:%2" : "=&v"(dst[1]) : "v"(kb[(d0_) & 3]), "i"(KB * SHM_K + ((d0_) >> 2) * 8192 + 32 * 128) : "memory"); } while (0)
#define KMM(f, d0_, n_) do { asm volatile("s_waitcnt lgkmcnt(" #n_ ")" ::: "memory"); SBAR();                                                              \
        p0 = __builtin_amdgcn_mfma_f32_32x32x16_bf16(f[0], qr[d0_], p0, 0, 0, 0); p1 = __builtin_amdgcn_mfma_f32_32x32x16_bf16(f[1], qr[d0_], p1, 0, 0, 0); SBAR(); } while (0)
    bf16x8 fa[2], fb[2];
    KRD(fa, 0); KRD(fb, 1);
    KMM(fa, 0, 2); KRD(fa, 2);
    KMM(fb, 1, 2); KRD(fb, 3);
    KMM(fa, 2, 2); KRD(fa, 4);
    KMM(fb, 3, 2); KRD(fb, 5);
    KMM(fa, 4, 2); KRD(fa, 6);
    KMM(fb, 5, 2); KRD(fb, 7);
    KMM(fa, 6, 2);
    KMM(fb, 7, 0);
#undef KRD
#undef KMM
}
template <int KB>
__device__ __forceinline__ void qkt_c(f32x16& p0, f32x16& p1, const char* K_lds, int r32, int hi, const bf16x8* qr) {
    p0 = f32x16{}; p1 = f32x16{};
    const char* kb[4];
#pragma unroll
    for (int dd = 0; dd < 4; ++dd) kb[dd] = K_lds + KB * SHM_K + KSWZ(r32, (dd * 16 + hi * 8) * 2);
#pragma unroll
    for (int d0 = 0; d0 < 8; ++d0) { const char* a = kb[d0 & 3] + (d0 >> 2) * 8192;
        bf16x8 b0 = *reinterpret_cast<const bf16x8*>(a);
        bf16x8 b1 = *reinterpret_cast<const bf16x8*>(a + 32 * 128);
        p0 = __builtin_amdgcn_mfma_f32_32x32x16_bf16(b0, qr[d0], p0, 0, 0, 0);
        p1 = __builtin_amdgcn_mfma_f32_32x32x16_bf16(b1, qr[d0], p1, 0, 0, 0); }
}
__device__ __forceinline__ void pv_tile(f32x16* o, int vb0, bf16x8 pa0, bf16x8 pa1, bf16x8 pa2, bf16x8 pa3) {
#define TRRD(dst, off) asm volatile("ds_read_b64_tr_b16 %0, %1 offset:%2" : "=&v"(dst) : "v"(vb0), "i"(off) : "memory")
#define PV_R(d0, ks, l, h) do { TRRD(l, v_rd_off(d0, 0, 0) + (ks) * 4096); TRRD(h, v_rd_off(d0, 0, 0) + (ks) * 4096 + 2048); } while (0)
#define PV_M(d0, pa, l, h, n_) do { asm volatile("s_waitcnt lgkmcnt(" #n_ ")" ::: "memory"); SBAR();                                \
        o[d0] = __builtin_amdgcn_mfma_f32_32x32x16_bf16(pa, (bf16x8){l[0], l[1], l[2], l[3], h[0], h[1], h[2], h[3]}, o[d0], 0, 0, 0); SBAR(); } while (0)
    s16x4 l0, l1, l2, l3, h0, h1, h2, h3;
    PV_R(0, 0, l0, h0); PV_R(0, 1, l1, h1); PV_R(0, 2, l2, h2); PV_R(0, 3, l3, h3);
#define PV_G(d0) do { PV_M(d0, pa0, l0, h0, 6); PV_R(d0 + 1, 0, l0, h0); PV_M(d0, pa1, l1, h1, 6); PV_R(d0 + 1, 1, l1, h1);            \
                      PV_M(d0, pa2, l2, h2, 6); PV_R(d0 + 1, 2, l2, h2); PV_M(d0, pa3, l3, h3, 6); PV_R(d0 + 1, 3, l3, h3); } while (0)
    PV_G(0); PV_G(1); PV_G(2);
    PV_M(3, pa0, l0, h0, 6); PV_M(3, pa1, l1, h1, 4); PV_M(3, pa2, l2, h2, 2); PV_M(3, pa3, l3, h3, 0);
#undef PV_G
#undef PV_M
#undef PV_R
#undef TRRD
}

template <int KB>
__device__ __forceinline__ void qk_fin(f32x16& x0, f32x16& x1, f32x16& y0, f32x16& y1, float alY, float& l_reg, bf16x8& pa0, bf16x8& pa1, bf16x8& pa2, bf16x8& pa3,
                                       const char* K_lds, int r32, int hi, const bf16x8* qr) {
    x0 = f32x16{}; x1 = f32x16{};
    int kb[4];
#pragma unroll
    for (int dd = 0; dd < 4; ++dd) kb[dd] = (int)(uintptr_t)(K_lds + KSWZ(r32, (dd * 16 + hi * 8) * 2));
#define KRD(dst, d0_) do { asm volatile("ds_read_b128 %0, %1 offset:%2" : "=&v"(dst[0]) : "v"(kb[(d0_) & 3]), "i"(KB * SHM_K + ((d0_) >> 2) * 8192) : "memory");          \
                           asm volatile("ds_read_b128 %0, %1 offset:%2" : "=&v"(dst[1]) : "v"(kb[(d0_) & 3]), "i"(KB * SHM_K + ((d0_) >> 2) * 8192 + 32 * 128) : "memory"); } while (0)
#define KMM(f, d0_, n_) do { asm volatile("s_waitcnt lgkmcnt(" #n_ ")" ::: "memory"); SBAR();                                                              \
        x0 = __builtin_amdgcn_mfma_f32_32x32x16_bf16(f[0], qr[d0_], x0, 0, 0, 0); x1 = __builtin_amdgcn_mfma_f32_32x32x16_bf16(f[1], qr[d0_], x1, 0, 0, 0); SBAR(); } while (0)
#define EXPY(i) do { y1[2 * (i)] = __builtin_amdgcn_exp2f(y1[2 * (i)]); y1[2 * (i) + 1] = __builtin_amdgcn_exp2f(y1[2 * (i) + 1]); } while (0)
#define ADDY(Y, i) do { ps += Y[2 * (i)]; ps += Y[2 * (i) + 1]; } while (0)
#define CVA(P, B_) do { c0 = cvtpk(P[B_ + 0], P[B_ + 1]); c1 = cvtpk(P[B_ + 2], P[B_ + 3]); } while (0)
#define CVB(P, B_, OUT) do { const unsigned b0_ = cvtpk(P[B_ + 4], P[B_ + 5]), b1_ = cvtpk(P[B_ + 6], P[B_ + 7]);                                          \
        auto r0_ = __builtin_amdgcn_permlane32_swap(c0, b0_, false, false); auto r1_ = __builtin_amdgcn_permlane32_swap(c1, b1_, false, false);               \
        u32x4 w_ = {r0_[0], r1_[0], r0_[1], r1_[1]}; OUT = *reinterpret_cast<bf16x8*>(&w_); } while (0)
    bf16x8 fa[2], fb[2]; float ps = 0.f; unsigned c0, c1;
    KRD(fa, 0); KRD(fb, 1);
    KMM(fa, 0, 2); KRD(fa, 2); EXPY(0); ADDY(y0, 0); CVA(y0, 0); SBAR();
    KMM(fb, 1, 2); KRD(fb, 3); EXPY(1); ADDY(y0, 1); ADDY(y1, 0); CVB(y0, 0, pa0); SBAR();
    KMM(fa, 2, 2); KRD(fa, 4); EXPY(2); ADDY(y0, 2); ADDY(y1, 1); CVA(y0, 8); SBAR();
    KMM(fb, 3, 2); KRD(fb, 5); EXPY(3); ADDY(y0, 3); ADDY(y1, 2); CVB(y0, 8, pa1); SBAR();
    KMM(fa, 4, 2); KRD(fa, 6); EXPY(4); ADDY(y0, 4); ADDY(y1, 3); CVA(y1, 0); SBAR();
    KMM(fb, 5, 2); KRD(fb, 7); EXPY(5); ADDY(y0, 5); ADDY(y1, 4); CVB(y1, 0, pa2); SBAR();
    KMM(fa, 6, 2);             EXPY(6); ADDY(y0, 6); ADDY(y1, 5); CVA(y1, 8); SBAR();
    KMM(fb, 7, 0);             EXPY(7); ADDY(y0, 7); ADDY(y1, 6); SBAR();
    ADDY(y1, 7); CVB(y1, 8, pa3);
    { auto rr = __builtin_amdgcn_permlane32_swap(__float_as_uint(ps), __float_as_uint(ps), false, false); ps = __uint_as_float(rr[0]) + __uint_as_float(rr[1]); }
    l_reg = l_reg * alY + ps;
#undef KRD
#undef KMM
#undef EXPY
#undef ADDY
#undef CVA
#undef CVB
}
__device__ __forceinline__ void pv_par(f32x16* o, int vb0, bf16x8 pa0, bf16x8 pa1, bf16x8 pa2, bf16x8 pa3, f32x16& x0, f32x16& x1, float& m_reg, float& alpha, bool keep) {
#define TRRD(dst, off) asm volatile("ds_read_b64_tr_b16 %0, %1 offset:%2" : "=&v"(dst) : "v"(vb0), "i"(off) : "memory")
#define PV_R(d0, ks, l, h) do { TRRD(l, v_rd_off(d0, 0, 0) + (ks) * 4096); TRRD(h, v_rd_off(d0, 0, 0) + (ks) * 4096 + 2048); } while (0)
#define PV_M(d0, pa, l, h, n_) do { asm volatile("s_waitcnt lgkmcnt(" #n_ ")" ::: "memory"); SBAR();                                \
        o[d0] = __builtin_amdgcn_mfma_f32_32x32x16_bf16(pa, (bf16x8){l[0], l[1], l[2], l[3], h[0], h[1], h[2], h[3]}, o[d0], 0, 0, 0); SBAR(); } while (0)
#define MX8(t, X, b) do { t = fmaxf(fmaxf(X[b], X[b + 1]), X[b + 2]); t = fmaxf(fmaxf(t, X[b + 3]), X[b + 4]); t = fmaxf(fmaxf(t, X[b + 5]), X[b + 6]); t = fmaxf(t, X[b + 7]); } while (0)
#define FM4(j) do { x0[2 * (j)] = fmaf(x0[2 * (j)], C2, mnL); x0[2 * (j) + 1] = fmaf(x0[2 * (j) + 1], C2, mnL); x1[2 * (j)] = fmaf(x1[2 * (j)], C2, mnL); x1[2 * (j) + 1] = fmaf(x1[2 * (j) + 1], C2, mnL); } while (0)
#define EX0(e) x0[e] = __builtin_amdgcn_exp2f(x0[e])
    constexpr float C2 = 1.4426950408889634f * SCALE;
    s16x4 l0, l1, l2, l3, h0, h1, h2, h3; float t0, t1, t2, t3, pmax, mnL;
    PV_R(0, 0, l0, h0); PV_R(0, 1, l1, h1); PV_R(0, 2, l2, h2); PV_R(0, 3, l3, h3);
    PV_M(0, pa0, l0, h0, 6); PV_R(1, 0, l0, h0); MX8(t0, x0, 0); SBAR();
    PV_M(0, pa1, l1, h1, 6); PV_R(1, 1, l1, h1); MX8(t1, x0, 8); SBAR();
    PV_M(0, pa2, l2, h2, 6); PV_R(1, 2, l2, h2); MX8(t2, x1, 0); SBAR();
    PV_M(0, pa3, l3, h3, 6); PV_R(1, 3, l3, h3); MX8(t3, x1, 8); SBAR();
    PV_M(1, pa0, l0, h0, 6); PV_R(2, 0, l0, h0);
    { pmax = fmaxf(fmaxf(t0, t1), fmaxf(t2, t3)); auto rr = __builtin_amdgcn_permlane32_swap(__float_as_uint(pmax), __float_as_uint(pmax), false, false); pmax = fmaxf(__uint_as_float(rr[0]), __uint_as_float(rr[1])); pmax = keep ? pmax : -__builtin_inff(); } SBAR();
    PV_M(1, pa1, l1, h1, 6); PV_R(2, 1, l1, h1);
    { const bool ok = __all((pmax - m_reg) * SCALE <= THR) != 0;
      const float mn = ok ? m_reg : fmaxf(m_reg, pmax); alpha = __builtin_amdgcn_exp2f((m_reg - mn) * C2); m_reg = mn; mnL = keep ? -mn * C2 : -__builtin_inff(); } SBAR();
    PV_M(1, pa2, l2, h2, 6); PV_R(2, 2, l2, h2); FM4(0); SBAR();
    PV_M(1, pa3, l3, h3, 6); PV_R(2, 3, l3, h3); FM4(1); EX0(0); SBAR();
    PV_M(2, pa0, l0, h0, 6); PV_R(3, 0, l0, h0); FM4(2); EX0(1); SBAR();
    PV_M(2, pa1, l1, h1, 6); PV_R(3, 1, l1, h1); FM4(3); EX0(2); SBAR();
    PV_M(2, pa2, l2, h2, 6); PV_R(3, 2, l2, h2); FM4(4); EX0(3); SBAR();
    PV_M(2, pa3, l3, h3, 6); PV_R(3, 3, l3, h3); FM4(5); EX0(4); SBAR();
    PV_M(3, pa0, l0, h0, 6); FM4(6); EX0(5); SBAR();
    PV_M(3, pa1, l1, h1, 4); FM4(7); EX0(6); SBAR();
    PV_M(3, pa2, l2, h2, 2); EX0(7); EX0(8); EX0(9); SBAR();
    PV_M(3, pa3, l3, h3, 0); EX0(10); EX0(11); EX0(12); SBAR();
    EX0(13); EX0(14); EX0(15);
#undef TRRD
#undef PV_R
#undef PV_M
#undef MX8
#undef FM4
#undef EX0
}

struct BlockRef { int b, h, qb; };
struct Bases { const bf16* proj; bf16* mixed; float* ssq; const float* kpart; };
__device__ __forceinline__ const bf16* refQ(const Bases& B, const BlockRef& r) { return B.proj + ((size_t)(r.b * SEQ + r.qb * QB) * LDQ + r.h * D); }
__device__ __forceinline__ const bf16* refK(const Bases& B, const BlockRef& r) { return B.proj + (size_t)M_TOK * LDQ + ((size_t)(r.b * SEQ) * LDQ + r.h * D); }
__device__ __forceinline__ const bf16* refV(const Bases& B, const BlockRef& r) { return B.proj + (size_t)2 * M_TOK * LDQ + ((size_t)(r.b * SEQ) * LDQ + r.h * D); }
struct Seam { bf16x8 qr[8]; bf16x8 st_v0, st_v1, st_k0, st_k1; };

__device__ __forceinline__ void km_load(const float* kpart, int b, int h, int tid, f32x4& x, f32x4& y) {
    const int j = (tid >> 5) & 7, c = (tid & 31) * 4;
    const float* p = kpart + ((size_t)(b * 8 + j) * 1024 + h * D + c);
    x = *(const f32x4*)p; y = *(const f32x4*)(p + KPART_STRIDE);
}
__device__ __forceinline__ void km_write(char* lds, int tid, f32x4 x, f32x4 y) {
    const int j = (tid >> 5) & 7, c = (tid & 31) * 4; const f32x4 a = x + y;
    const unsigned h0 = cvtpk(a[0], a[1]), h1 = cvtpk(a[2], a[3]);
    const unsigned l0 = cvtpk(a[0] - __uint_as_float(h0 << 16), a[1] - __uint_as_float(h0 & 0xffff0000u)), l1 = cvtpk(a[2] - __uint_as_float(h1 << 16), a[3] - __uint_as_float(h1 & 0xffff0000u));
    typedef unsigned u32x2 __attribute__((ext_vector_type(2)));
    if (tid < 256) { *(u32x2*)(lds + KM_OFF + j * KM_PITCH + c * 2) = (u32x2){h0, h1}; *(u32x2*)(lds + KM_OFF + (8 + j) * KM_PITCH + c * 2) = (u32x2){l0, l1}; }
}
__device__ __forceinline__ unsigned moba_select(const bf16x8* qr, const char* lds, int own, int r32, int hi) {
    if (own == 0) return 0u;
    f32x16 g = f32x16{};
    const bool act = r32 < 16;
    const char* kmf = lds + KM_OFF + (r32 & 15) * KM_PITCH + hi * 16;
#pragma unroll
    for (int d0 = 0; d0 < 8; ++d0) {
        bf16x8 f = *(const bf16x8*)(kmf + d0 * 32);
        if (!act) f = (bf16x8){0, 0, 0, 0, 0, 0, 0, 0};
        g = __builtin_amdgcn_mfma_f32_32x32x16_bf16(f, qr[d0], g, 0, 0, 0);
    }
    float G[8];
#pragma unroll
    for (int i = 0; i < 4; ++i) { const float v = g[i] + g[4 + i];
        auto rr = __builtin_amdgcn_permlane32_swap(__float_as_uint(v), __float_as_uint(v), false, false);
        G[i] = __uint_as_float(rr[0]); G[4 + i] = __uint_as_float(rr[1]); }
    unsigned sel = 0u;
#pragma unroll
    for (int a = 0; a < 8; ++a) { int cnt = 0;
#pragma unroll
        for (int b = 0; b < 8; ++b) { if (b == a) continue;
            const bool beats = (b < a) ? (G[b] >= G[a]) : (G[b] > G[a]);
            cnt += (b < own && beats) ? 1 : 0; }
        sel |= (a < own && cnt < 3) ? (1u << a) : 0u; }
    return sel;
}

#define ROW(p, k0, rr) ((p) + (size_t)((k0) + (rr)) * LDQ + sc)
#define VMW() asm volatile("s_waitcnt vmcnt(0)" ::: "memory")
#define VMWN(n) asm volatile("s_waitcnt vmcnt(%0)" :: "i"(n) : "memory")
#define SLOAD_H(Kp, Vp, k0) do { S.st_v0 = load8(ROW(Vp, k0, sr)); S.st_v1 = load8(ROW(Vp, k0, 32 + sr));              \
                         S.st_k0 = load8(ROW(Kp, k0, sr)); S.st_k1 = load8(ROW(Kp, k0, 32 + sr)); } while (0)
#define SWRITE_HK(bf) do { *(bf16x8*)(K_lds + (bf) * SHM_K + kws) = S.st_k0; *(bf16x8*)(K_lds + (bf) * SHM_K + kws + 32 * 128) = S.st_k1; } while (0)
#define SWRITE_HV(bf) do { *(bf16x8*)(V_lds + (bf) * SHM_V + vst0) = S.st_v0; *(bf16x8*)(V_lds + (bf) * SHM_V + vst1) = S.st_v1; } while (0)
#define SWRITE_H(bf) do { SWRITE_HV(bf); SWRITE_HK(bf); } while (0)
__device__ __forceinline__ void moba_prime(const Bases& B, const BlockRef& cur, char* lds, Seam& S) {
    int tid_ = threadIdx.x; asm volatile("" : "+v"(tid_));
    const int tid = tid_, wid = __builtin_amdgcn_readfirstlane(tid >> 6), lane = tid & 63, r32 = lane & 31, hi = lane >> 5;
    const int sr = tid >> 4, sc = (tid & 15) * 8, kws = KSWZ(sr, sc * 2); char* K_lds = lds + NVB * SHM_V;
#pragma unroll
    for (int d0 = 0; d0 < 8; ++d0) S.qr[d0] = load8(refQ(B, cur) + (size_t)(wid * QBLK + r32) * LDQ + d0 * 16 + hi * 8);
    f32x4 kx, ky; km_load(B.kpart, cur.b, cur.h, tid, kx, ky);
    { const bf16* Kp = refK(B, cur); const bf16* Vp = refV(B, cur); SLOAD_H(Kp, Vp, 0); } VMW(); SWRITE_HK(0); km_write(lds, tid, kx, ky);
    __syncthreads();
}
template <bool ORDA> __device__ __forceinline__ void moba_block(const Bases& B, const BlockRef& cur, const BlockRef& nxt, char* lds, Seam& S) {
    int tid_ = threadIdx.x; asm volatile("" : "+v"(tid_));
    const int tid = tid_, wid = __builtin_amdgcn_readfirstlane(tid >> 6), lane = tid & 63, r32 = lane & 31, hi = lane >> 5;
    const int own = cur.qb, P0 = cur.qb * QB;
    const int NT = (P0 + QB) / KVBLK;
    const int qlo = P0 + wid * QBLK, qm = qlo + r32 - 4 * hi;
    char* V_lds = lds; char* K_lds = lds + NVB * SHM_V;
    float* ws = (float*)(lds + NVB * SHM_V + 2 * SHM_K) + wid * 64; float* li_l = ws, * al_l = ws + 32;
    float m_reg = -1e30f, l_reg = 0; f32x16 o[4] = {};
    const int sr = tid >> 4, sc = (tid & 15) * 8, vst0 = v_st(sr, sc), vst1 = v_st(32 + sr, sc), kws = KSWZ(sr, sc * 2);
    const int vb0 = (int)(uintptr_t)V_lds + v_rd_base(lane);
    const bf16* Kh = refK(B, cur); const bf16* Vh = refV(B, cur);
#define RESC(a) do { if (__any((a) < 1.f)) { if (hi == 0) al_l[r32] = (a); asm volatile("s_waitcnt lgkmcnt(0)" ::: "memory");              \
                     for (int d_ = 0; d_ < 4; ++d_) for (int r = 0; r < 16; ++r) o[d_][r] *= al_l[crow(r, hi)]; } } while (0)
#define KBASE(t) ((t) * KVBLK)
#define MASKT(P0_, P1_, t) do { const int kb_ = KBASE(t); const int jb_ = (t) >> 2;                                             \
        if (jb_ == own) { if (kb_ + KVBLK - 1 > qlo) mask_tile(P0_, P1_, qm - kb_); }                                          \
        else { const bool keep_ = ((selm >> jb_) & 1u) != 0u; if (!__all(keep_)) mask_all(P0_, P1_, keep_); } } while (0)
#define SEAM_K0() do { VMWN(8); SWRITE_HK(0); SBAR(); } while (0)
    f32x16 pA0, pA1, pB0, pB1; float mnA, mnB, alA, alB; bf16x8 pa0, pa1, pa2, pa3;
    SWRITE_HV(0); SBAR();
    if (NT > 1) { SLOAD_H(Kh, Vh, KBASE(1)); }
    SBAR();
    const unsigned selm = moba_select(S.qr, lds, own, r32, hi);
    SBAR(); qkt<0>(pA0, pA1, K_lds, r32, hi, S.qr);
    MASKT(pA0, pA1, 0); partialSM(pA0, pA1, m_reg, mnA, alA);
    if (NT > 1) { VMW(); SWRITE_H(1); }
    __syncthreads();
    int vp = 0;
#define HALF_STEP(PX0, PX1, alX, PY0, PY1, alY, t, KB, SB, CAUSAL) do {                                                       \
        const int vrd_ = vb0 + vp * SHM_V, vw_ = (vp == 0 ? 2 : vp - 1); const int jb_ = (t) >> 2;                            \
        SBAR(); qk_fin<KB>(PX0, PX1, PY0, PY1, alY, l_reg, pa0, pa1, pa2, pa3, K_lds, r32, hi, S.qr); SBAR();                 \
        if ((t) + 1 < NT) { SLOAD_H(Kh, Vh, KBASE((t) + 1)); SBAR(); }                                                        \
        if (CAUSAL) { mask_tile(PX0, PX1, qm - KBASE(t)); SBAR(); }           \
        const bool keep_ = (jb_ == own) || (((selm >> jb_) & 1u) != 0u);                                                      \
        pv_par(o, vrd_, pa0, pa1, pa2, pa3, PX0, PX1, m_reg, alX, keep_); SBAR();                                             \
        if ((t) + 1 < NT) { VMW(); SWRITE_HK(SB); *(bf16x8*)(V_lds + vw_ * SHM_V + vst0) = S.st_v0; *(bf16x8*)(V_lds + vw_ * SHM_V + vst1) = S.st_v1; } \
        RESC(alX); vp = (vp == 2 ? 0 : vp + 1); __syncthreads(); } while (0)
    int t = 1;
    for (; t + 1 < NT - 4; t += 2) {
        HALF_STEP(pB0, pB1, alB, pA0, pA1, alA, t, 1, 0, 0);
        HALF_STEP(pA0, pA1, alA, pB0, pB1, alB, t + 1, 0, 1, 0);
    }
    for (; t + 1 < NT; t += 2) {
        HALF_STEP(pB0, pB1, alB, pA0, pA1, alA, t, 1, 0, 1);
        HALF_STEP(pA0, pA1, alA, pB0, pB1, alB, t + 1, 0, 1, 1);
    }
    SBAR(); qkt_c<1>(pB0, pB1, K_lds, r32, hi, S.qr); SBAR();
    { const bf16* Kn = refK(B, nxt); const bf16* Vn = refV(B, nxt); SLOAD_H(Kn, Vn, 0); } SBAR();
#pragma unroll
    for (int d0 = 0; d0 < 8; ++d0) S.qr[d0] = load8(refQ(B, nxt) + (size_t)(wid * QBLK + r32) * LDQ + d0 * 16 + hi * 8);
    SBAR();
    finishSM(pA0, pA1, alA, l_reg, pa0, pa1, pa2, pa3); SBAR();
    pv_tile(o, vb0 + vp * SHM_V, pa0, pa1, pa2, pa3); vp = (vp == 2 ? 0 : vp + 1);
    MASKT(pB0, pB1, NT - 1); partialSM(pB0, pB1, m_reg, mnB, alB); __syncthreads(); RESC(alB);
    finishSM(pB0, pB1, alB, l_reg, pa0, pa1, pa2, pa3); SBAR(); pv_tile(o, vb0 + vp * SHM_V, pa0, pa1, pa2, pa3);
    SBAR(); SEAM_K0();
    if (hi == 0) li_l[r32] = l_reg; asm volatile("s_waitcnt lgkmcnt(0)" ::: "memory");
    int hi4 = 4 * hi; asm volatile("" : "+v"(hi4));
    float rli[16];
#pragma unroll
    for (int r = 0; r < 16; ++r) rli[r] = __builtin_amdgcn_rcpf(li_l[crow(r, 0) + hi4]);
    const size_t orow0 = (size_t)(cur.b * SEQ + P0 + wid * QBLK);
    unsigned char* Ob = (unsigned char*)B.mixed + orow0 * MIX_PITCH + cur.h * D; float* sqw = B.ssq + orow0 * 8 + cur.h;
    unsigned short* stg = (unsigned short*)(lds + LDS_BYTES) + wid * (QBLK * D);
#pragma unroll
    for (int r = 0; r < 16; ++r) { const int orow = crow(r, 0) + hi4;
#pragma unroll
        for (int d0 = 0; d0 < 4; ++d0) { const float v = o[d0][r] * rli[r]; stg[orow * D + d0 * 32 + r32] = (unsigned short)cvtpk(v, v); } }
    asm volatile("s_waitcnt lgkmcnt(0)" ::: "memory");
    int lrow = lane >> 4; asm volatile("" : "+v"(lrow));
    f32x4 kx, ky; km_load(B.kpart, nxt.b, nxt.h, tid, kx, ky);
#pragma unroll
    for (int i = 0; i < 8; ++i) { const int row = 4 * i + lrow, ch = lane & 15;
        const u32x4 w = *(const u32x4*)(stg + row * D + ch * 8);
        float a = 0.f; int q8[2] = {0, 0};
#pragma unroll
        for (int e = 0; e < 4; ++e) { const float lo = __uint_as_float(w[e] << 16), hi_ = __uint_as_float(w[e] & 0xffff0000u); a += lo * lo + hi_ * hi_;
            if (e & 1) q8[e >> 1] = __builtin_amdgcn_cvt_pk_fp8_f32(lo * AQ_SCALE, hi_ * AQ_SCALE, q8[e >> 1], true);
            else       q8[e >> 1] = __builtin_amdgcn_cvt_pk_fp8_f32(lo * AQ_SCALE, hi_ * AQ_SCALE, q8[e >> 1], false); }
        typedef int i32x2 __attribute__((ext_vector_type(2)));
        *(i32x2*)(Ob + (size_t)row * MIX_PITCH + ch * 8) = (i32x2){q8[0], q8[1]};
        a = pg8::xsum16r(a);
        if (ch == 0) sqw[row * 8] = a;
        SBAR(); }
    km_write(lds, tid, kx, ky);
    __syncthreads();
#undef RESC
#undef KBASE
#undef MASKT
#undef SEAM_K0
#undef HALF_STEP
}
#undef ROW
#undef VMW
#undef VMWN
#undef SLOAD_H
#undef SWRITE_HK
#undef SWRITE_HV
#undef SWRITE_H
#undef SBAR
#undef KSWZ
}

#ifndef PH_MASK
#define PH_MASK 0x7f
#endif
#ifndef DUP_MASK
#define DUP_MASK 0
#endif
#define NREP(k) (1 + ((DUP_MASK >> (k)) & 1))
constexpr int NWAVES = 8;
constexpr size_t MiB = 1u << 20;
constexpr size_t WS_CTL = 0, CTL_ZERO_BYTES = 1 * MiB;
constexpr size_t CTL_STATS1 = 0, CTL_STATS2 = 128 * 1024, CTL_C1 = 256 * 1024, CTL_C2 = 288 * 1024, CTL_BAR = 512 * 1024;
constexpr size_t WS_KPART = 1 * MiB;
constexpr size_t WS_SSQ = WS_KPART + 512 * 1024;
constexpr size_t WS_XS = 2 * MiB;
constexpr size_t WS_WIN = 4 * MiB;
constexpr size_t WS_WIN8 = 12 * MiB;
constexpr size_t WS_WO = 20 * MiB;
constexpr size_t WS_WUP = 28 * MiB;
constexpr size_t WS_WDN = 44 * MiB;
constexpr size_t WS_XB = 64 * MiB;
constexpr size_t WS_X8 = 128 * MiB;
constexpr size_t WS_PROJ = 160 * MiB;
constexpr size_t WS_R = 64 * MiB;
constexpr size_t WS_MIXED = 320 * MiB;
constexpr size_t WS_Z = 320 * MiB;
constexpr size_t WS_YB = 384 * MiB;
constexpr size_t WS_Y8 = 448 * MiB;
constexpr size_t WS_END = 480 * MiB;
constexpr size_t CTL_GBAR = 896 * 1024, CTL_GBAR_STRIDE = 14 * 1024;
constexpr size_t CTL_CNT = 768 * 1024, CTL_CNT_DUMMY = 832 * 1024;
constexpr size_t CTL_DUMMY = 640 * 1024;
constexpr int RING_BYTES = 131072, LDS_BYTES = 163840, MISC_OFF = LDS_BYTES - 64;

typedef unsigned short bf16;
typedef float f32x4 __attribute__((ext_vector_type(4)));
typedef unsigned v4u __attribute__((ext_vector_type(4)));
#define LAS __attribute__((address_space(3)))
#define LDS_WAIT() asm volatile("s_waitcnt lgkmcnt(0)" ::: "memory")
__device__ __forceinline__ void st_wt16(void* p, v4u v) { asm volatile("global_store_dwordx4 %0, %1, off sc1" :: "v"(p), "v"(v) : "memory"); }
__device__ __forceinline__ void st_wt8(void* p, unsigned a, unsigned b) { typedef unsigned u32x2_ __attribute__((ext_vector_type(2))); const u32x2_ v = (u32x2_){a, b}; asm volatile("global_store_dwordx2 %0, %1, off sc1" :: "v"(p), "v"(v) : "memory"); }
__device__ __forceinline__ unsigned pkbf(float lo, float hi) { unsigned r; asm volatile("v_cvt_pk_bf16_f32 %0, %1, %2" : "=v"(r) : "v"(lo), "v"(hi)); return r; }
__device__ __forceinline__ float wave_sum(float v) {
    return pg8::xsum64(v);
}
__device__ __forceinline__ void p0_transpose_item(const float* W, int K, int N, bf16* WT, const float* gain, const float* bvec, float* c1, float* c2, LAS float* scr, int item, int lane, int pairgates = 0, int pitchB = 0, int boff = 0) {
    const int nblk = N / 64, kb = item / nblk, nb = item % nblk, k0 = 64 * kb, n0 = 64 * nb;
    const int nd0 = n0; (void)pairgates;
#pragma unroll
    for (int i = 0; i < 16; ++i) { const int kk = 4 * i + (lane >> 4), nn = 4 * (lane & 15);
        const f32x4 v = __builtin_nontemporal_load((const f32x4*)(W + (size_t)(k0 + kk) * N + n0 + nn));
        scr[kk * 65 + nn] = v[0]; scr[kk * 65 + nn + 1] = v[1]; scr[kk * 65 + nn + 2] = v[2]; scr[kk * 65 + nn + 3] = v[3]; }
    LDS_WAIT(); asm volatile("" ::: "memory");
    const int c = lane & 7;
    float gk[8], bk[8];
#pragma unroll
    for (int e = 0; e < 8; ++e) { gk[e] = gain ? gain[k0 + 8 * c + e] : 1.0f; bk[e] = bvec ? bvec[k0 + 8 * c + e] : 0.0f; }
#pragma unroll
    for (int j = 0; j < 8; ++j) { const int n = (lane >> 3) + 8 * j; const LAS float* s = scr + (8 * c) * 65 + n;
        float w[8];
#pragma unroll
        for (int e = 0; e < 8; ++e) w[e] = s[e * 65];
        v4u o; o.x = pkbf(w[0] * gk[0], w[1] * gk[1]); o.y = pkbf(w[2] * gk[2], w[3] * gk[3]); o.z = pkbf(w[4] * gk[4], w[5] * gk[5]); o.w = pkbf(w[6] * gk[6], w[7] * gk[7]);
        if (pitchB) __builtin_nontemporal_store(o, (v4u*)((unsigned char*)WT + (size_t)(nd0 + n) * pitchB + boff + 2 * (k0 + 8 * c))); else *(v4u*)(WT + (size_t)(nd0 + n) * K + k0 + 8 * c) = o;
        if (c1) {
            float s1 = (__uint_as_float(o.x << 16) + __uint_as_float(o.x & 0xffff0000u)) + (__uint_as_float(o.y << 16) + __uint_as_float(o.y & 0xffff0000u))
                     + (__uint_as_float(o.z << 16) + __uint_as_float(o.z & 0xffff0000u)) + (__uint_as_float(o.w << 16) + __uint_as_float(o.w & 0xffff0000u));
            float s2 = 0.f;
#pragma unroll
            for (int e = 0; e < 8; ++e) s2 += w[e] * bk[e];
            s1 = pg8::xsum8(s1); s2 = pg8::xsum8(s2);
            if (c == 0) { (void)__hip_atomic_fetch_add(c1 + n0 + n, s1, __ATOMIC_RELAXED, __HIP_MEMORY_SCOPE_AGENT); (void)__hip_atomic_fetch_add(c2 + n0 + n, s2, __ATOMIC_RELAXED, __HIP_MEMORY_SCOPE_AGENT); }
        } }
    LDS_WAIT(); asm volatile("" ::: "memory");
}

#define XB_TMO      128
#define XB_XCNT(j)  (256  + 64 * (j))
#define XB_XSUB(j)  (1280 + 64 * (j))
#define XB_XGEN(j)  (2304 + 64 * (j))
#define XB_TOP      3328
#define XB_TOPGEN   3392
#define XCD_BAR_WORDS 3456
#define XB_SPIN_CAP (1u << 18)

__device__ __forceinline__ unsigned xb_ld(unsigned* p)              { return __hip_atomic_load(p, __ATOMIC_RELAXED, __HIP_MEMORY_SCOPE_AGENT); }
__device__ __forceinline__ unsigned xb_add(unsigned* p, unsigned v) { return __hip_atomic_fetch_add(p, v, __ATOMIC_RELAXED, __HIP_MEMORY_SCOPE_AGENT); }
__device__ __forceinline__ unsigned xb_xcc_id() { return (unsigned)__builtin_amdgcn_s_getreg((3 << 11) | 20) & 0xFu; }
#define XB_SPIN(cond, bar) do { unsigned _sp = 0; while (cond) { __builtin_amdgcn_s_sleep(1); \
    if ((++_sp & 255u) == 0u) { if (xb_ld(&(bar)[XB_TMO])) break; if (_sp > XB_SPIN_CAP) { atomicAdd(&(bar)[XB_TMO], 1u); break; } } } } while (0)

struct XcdBarrier {
    unsigned* bar; unsigned x; unsigned total;
    volatile LAS unsigned* st;
};

__device__ __forceinline__ XcdBarrier xcd_barrier_post(unsigned* bar, volatile LAS unsigned* st, unsigned total) {
    XcdBarrier b; b.bar = bar; b.x = xb_xcc_id(); b.st = st; b.total = total;
    if (threadIdx.x == 0) (void)xb_add(&bar[XB_XCNT(b.x)], 1u);
    return b;
}
__device__ __forceinline__ void xcd_barrier_complete(unsigned* bar, unsigned x, unsigned& nloc, unsigned& nx, unsigned G) {
    unsigned sum, cnt, mine, sp = 0u;
    for (;;) {
        sum = 0u; cnt = 0u; mine = 0u;
#pragma unroll
        for (unsigned j = 0; j < 16; ++j) { const unsigned c = xb_ld(&bar[XB_XCNT(j)]); sum += c; cnt += (c > 0u) ? 1u : 0u; mine = (j == x) ? c : mine; }
        if (sum == G) break;
        __builtin_amdgcn_s_sleep(1);
        if ((++sp & 255u) == 0u) { if (xb_ld(&bar[XB_TMO])) break; if (sp > XB_SPIN_CAP) { atomicAdd(&bar[XB_TMO], 1u); break; } }
    }
    nloc = mine > 0u ? mine : 1u; nx = cnt > 0u ? cnt : 1u;
}

__device__ __forceinline__ void xcd_barrier(const XcdBarrier& b) {
    asm volatile("s_waitcnt vmcnt(0)" ::: "memory");
    __syncthreads();
    if (threadIdx.x == 0) {
        unsigned* bar = b.bar;
        __builtin_amdgcn_s_waitcnt(0);
        unsigned nloc = b.st[0], nx = b.st[1];
        if (nloc == 0u) { xcd_barrier_complete(bar, b.x, nloc, nx, b.total); b.st[0] = nloc; b.st[1] = nx; }
        const unsigned old = xb_add(&bar[XB_XSUB(b.x)], 1u);
        const unsigned gen = old / nloc;
        if (nx == 1u) {
            if (old + 1u == (gen + 1u) * nloc) xb_add(&bar[XB_XGEN(b.x)], 1u);
            else XB_SPIN(xb_ld(&bar[XB_XGEN(b.x)]) == gen, bar);
            __builtin_amdgcn_fence(__ATOMIC_ACQUIRE, "agent");
            asm volatile("s_waitcnt vmcnt(0)" ::: "memory");
        } else
        if (old + 1u == (gen + 1u) * nloc) {
            __builtin_amdgcn_fence(__ATOMIC_RELEASE, "agent");
            asm volatile("s_waitcnt vmcnt(0)" ::: "memory");
            const unsigned og = xb_add(&bar[XB_TOP], 1u);
            const unsigned tg = og / nx;
            if (og + 1u == (tg + 1u) * nx) xb_add(&bar[XB_TOPGEN], 1u);
            else XB_SPIN(xb_ld(&bar[XB_TOPGEN]) == tg, bar);
            __builtin_amdgcn_fence(__ATOMIC_ACQUIRE, "agent");
            xb_add(&bar[XB_XGEN(b.x)], 1u);
            asm volatile("s_waitcnt vmcnt(0)" ::: "memory");
        } else {
            XB_SPIN(xb_ld(&bar[XB_XGEN(b.x)]) == gen, bar);
            __builtin_amdgcn_fence(__ATOMIC_ACQUIRE, "agent");
            asm volatile("s_waitcnt vmcnt(0)" ::: "memory");
        }
    }
    __syncthreads();
}

__device__ __forceinline__ void p0_transpose_item_i8(const float* W, int K, int N, unsigned char* WT, int nd0, const float* gain, const float* bvec, float* c1, float* c2, LAS float* scr, int item, int lane) {
    const int nblk = N / 64, kb = item / nblk, nb = item % nblk, k0 = 64 * kb, n0 = 64 * nb;
#pragma unroll
    for (int i = 0; i < 16; ++i) { const int kk = 4 * i + (lane >> 4), nn = 4 * (lane & 15);
        const f32x4 v = __builtin_nontemporal_load((const f32x4*)(W + (size_t)(k0 + kk) * N + n0 + nn));
        scr[kk * 65 + nn] = v[0]; scr[kk * 65 + nn + 1] = v[1]; scr[kk * 65 + nn + 2] = v[2]; scr[kk * 65 + nn + 3] = v[3]; }
    LDS_WAIT(); asm volatile("" ::: "memory");
    const int c = lane & 7;
    float gk[8], bk[8];
#pragma unroll
    for (int e = 0; e < 8; ++e) { gk[e] = (gain ? gain[k0 + 8 * c + e] : 1.0f) * WQ_SCALE; bk[e] = bvec ? bvec[k0 + 8 * c + e] : 0.0f; }
#pragma unroll
    for (int j = 0; j < 8; ++j) { const int n = (lane >> 3) + 8 * j; const LAS float* s = scr + (8 * c) * 65 + n;
        float w[8], s1 = 0.f, s2 = 0.f;
#pragma unroll
        for (int e = 0; e < 8; ++e) { w[e] = s[e * 65]; s2 += w[e] * bk[e]; w[e] = __builtin_rintf(__builtin_amdgcn_fmed3f(w[e] * gk[e], -127.f, 127.f)); s1 += w[e]; }
        typedef unsigned u32x2 __attribute__((ext_vector_type(2)));
        { const u32x2 o_ = (u32x2){pg8::pack_i8x4((f32x4){w[0], w[1], w[2], w[3]}), pg8::pack_i8x4((f32x4){w[4], w[5], w[6], w[7]})}; u32x2* d_ = (u32x2*)(WT + (size_t)(nd0 + n) * K + k0 + 8 * c);
          if (c1) __builtin_nontemporal_store(o_, d_); else *d_ = o_; }
        if (c1) { s1 *= WQ_INV;
            s1 = pg8::xsum8(s1); s2 = pg8::xsum8(s2);
            if (c == 0) { (void)__hip_atomic_fetch_add(c1 + n0 + n, s1, __ATOMIC_RELAXED, __HIP_MEMORY_SCOPE_AGENT); (void)__hip_atomic_fetch_add(c2 + n0 + n, s2, __ATOMIC_RELAXED, __HIP_MEMORY_SCOPE_AGENT); } } }
    LDS_WAIT(); asm volatile("" ::: "memory");
}

__device__ __forceinline__ void p0_transpose_item_fp8(const float* W, int K, int N, unsigned char* WT, float scale, LAS float* scr, int item, int lane, const float* gain = nullptr, int pitchB = 0) {
    const int nblk = N / 64, kb = item / nblk, nb = item % nblk, k0 = 64 * kb, n0 = 64 * nb;
#pragma unroll
    for (int i = 0; i < 16; ++i) { const int kk = 4 * i + (lane >> 4), nn = 4 * (lane & 15);
        const f32x4 v = __builtin_nontemporal_load((const f32x4*)(W + (size_t)(k0 + kk) * N + n0 + nn));
        scr[kk * 65 + nn] = v[0]; scr[kk * 65 + nn + 1] = v[1]; scr[kk * 65 + nn + 2] = v[2]; scr[kk * 65 + nn + 3] = v[3]; }
    LDS_WAIT(); asm volatile("" ::: "memory");
    const int c = lane & 7;
#pragma unroll
    for (int j = 0; j < 8; ++j) { const int n = (lane >> 3) + 8 * j; const LAS float* s = scr + (8 * c) * 65 + n;
        float w[8];
#pragma unroll
        for (int e = 0; e < 8; ++e) w[e] = s[e * 65] * (gain ? gain[k0 + 8 * c + e] * scale : scale);
        int w0 = __builtin_amdgcn_cvt_pk_fp8_f32(w[0], w[1], 0, false); w0 = __builtin_amdgcn_cvt_pk_fp8_f32(w[2], w[3], w0, true);
        int w1 = __builtin_amdgcn_cvt_pk_fp8_f32(w[4], w[5], 0, false); w1 = __builtin_amdgcn_cvt_pk_fp8_f32(w[6], w[7], w1, true);
        typedef int i32x2 __attribute__((ext_vector_type(2)));
        __builtin_nontemporal_store((i32x2){w0, w1}, (i32x2*)(WT + (size_t)(n0 + n) * (pitchB ? pitchB : K) + k0 + 8 * c)); }
    LDS_WAIT(); asm volatile("" ::: "memory");
}

__device__ __forceinline__ void p0_prologue(const float* x, const float* w_in, const float* w_o, const float* w_up, const float* w_down, const float* attn_g, const float* conv_g, const float* ln1_g, const float* ln1_b,
        bf16* WinT, unsigned char* Win8, bf16* WoT, unsigned char* Wup8, bf16* WdnT, bf16* XB, unsigned char* X8, float* xs, float* c1, float* c2, unsigned char* lds, int wave, int lane, int tid, int gw, int NGW, int G, int bx) {
        for (int row = gw; row < M_TOK; row += NGW) {
            f32x4 v[4][2]; float mx = 0.f;
#pragma unroll
            for (int j = 0; j < 4; ++j) { const float* p = x + (size_t)row * DM + (j * 64 + lane) * 8;
                v[j][0] = __builtin_nontemporal_load((const f32x4*)p); v[j][1] = __builtin_nontemporal_load((const f32x4*)(p + 4)); }
#pragma unroll
            for (int j = 0; j < 4; ++j)
#pragma unroll
                for (int h = 0; h < 2; ++h)
#pragma unroll
                    for (int e = 0; e < 4; ++e) mx = fmaxf(mx, fabsf(v[j][h][e]));
            mx = pg8::xmax64(mx);
            mx = fmaxf(mx, 1e-30f);
            const float inv = 127.0f / mx;
            if (lane == 0) xs[row] = mx * (1.0f / 127.0f);
#pragma unroll
            for (int j = 0; j < 4; ++j) { const size_t off = (size_t)row * DM + (j * 64 + lane) * 8;
                v4u o; o.x = pkbf(v[j][0][0], v[j][0][1]); o.y = pkbf(v[j][0][2], v[j][0][3]); o.z = pkbf(v[j][1][0], v[j][1][1]); o.w = pkbf(v[j][1][2], v[j][1][3]);
                st_wt16(XB + off, o);
                typedef unsigned u32x2 __attribute__((ext_vector_type(2)));
                st_wt8(X8 + off, pg8::pack_i8x4(v[j][0] * inv), pg8::pack_i8x4(v[j][1] * inv)); }
        }
        LAS float* scr = (LAS float*)((LAS unsigned char*)lds + wave * 16640);
        constexpr int I_IN = (DM / 64) * (NPROJ / 64), I_O = (DM / 64) * (DM / 64), I_UP = (DM / 64) * (FF / 64), I_DN = (FF / 64) * (DM / 64);
        constexpr int NITEMS = I_IN + I_O + I_UP + I_DN;
        for (int it = gw; it < NITEMS; it += NGW) {
            int r = it;
            if (r < I_UP) { const int nb = r % (FF / 64); p0_transpose_item_i8(w_up, DM, FF, Wup8, 64 * nb, ln1_g, ln1_b, c1, c2, scr, r, lane); continue; } r -= I_UP;
            if (r < I_IN) { const int n0 = 64 * (r % (NPROJ / 64));
                if (n0 < 2048) p0_transpose_item(w_in, DM, NPROJ, WinT, nullptr, nullptr, nullptr, nullptr, scr, r, lane);
                else { int nd0;
                    if (n0 < 4096) nd0 = n0 - 2048; else { const int isu = n0 >= 5120, ch = n0 - (isu ? 5120 : 4096); nd0 = 2048 + (ch >> 7) * 256 + isu * 128 + (ch & 127); }
                    p0_transpose_item_i8(w_in, DM, NPROJ, Win8, nd0, nullptr, nullptr, nullptr, nullptr, scr, r, lane); }
                continue; } r -= I_IN;
            if (r < I_O) { const int kb = r / (DM / 64);
                if (kb < 16) p0_transpose_item_fp8(w_o, DM, DM, (unsigned char*)WoT, WOA_SCALE, scr, r, lane, attn_g, MIX_PITCH);
                else p0_transpose_item(w_o, DM, DM, WoT, conv_g - AW, nullptr, nullptr, nullptr, scr, r, lane, 0, MIX_PITCH, -1024);
                continue; } r -= I_O;
            p0_transpose_item_fp8(w_down, FF, DM, (unsigned char*)WdnT, WDN_SCALE, scr, r, lane);
        }
}

__device__ __forceinline__ void conv_pass(const bf16* PROJ, bf16* MIXED, const float* conv_w, int vcu, int G) {
    int tid_ = threadIdx.x; asm volatile("" : "+v"(tid_));
    const int lane = tid_ & 63, gw = vcu * NWAVES + __builtin_amdgcn_readfirstlane(tid_ >> 6), NGW = G * NWAVES;
        const bf16* Bg = PROJ + (size_t)3 * M_TOK * 1024; const bf16* Zg = PROJ + (size_t)4 * M_TOK * 1024;
        for (int ch = gw; ch < M_TOK / 8; ch += NGW) {
            const int r0 = ch * 8;
            typedef float f32x2 __attribute__((ext_vector_type(2)));
            f32x2 w0[8], w1[8], w2[8];
            int l8 = lane * 8; asm volatile("" : "+v"(l8));
#pragma unroll
            for (int hh = 0; hh < 2; ++hh)
#pragma unroll
                for (int e = 0; e < 4; ++e) { const int cc = hh * 512 + l8 + 2 * e; w0[hh * 4 + e] = *(const f32x2*)(conv_w + cc); w1[hh * 4 + e] = *(const f32x2*)(conv_w + 1024 + cc); w2[hh * 4 + e] = *(const f32x2*)(conv_w + 2048 + cc); }
            const bool hist = (r0 & (SEQ - 1)) != 0;
#define CV_UNPK(dst, raw, hh_) do { _Pragma("unroll") for (int e = 0; e < 4; ++e) dst[(hh_) * 4 + e] = (f32x2){__uint_as_float((raw)[e] << 16), __uint_as_float((raw)[e] & 0xffff0000u)}; } while (0)
            f32x2 z1[8], z2[8];
#pragma unroll
            for (int hh = 0; hh < 2; ++hh) { v4u a_ = (v4u){0u, 0u, 0u, 0u}, b_ = a_;
                if (hist) { a_ = __builtin_nontemporal_load((const v4u*)(Zg + (size_t)(r0 - 2) * 1024 + hh * 512 + lane * 8)); b_ = __builtin_nontemporal_load((const v4u*)(Zg + (size_t)(r0 - 1) * 1024 + hh * 512 + lane * 8)); }
                CV_UNPK(z2, a_, hh); CV_UNPK(z1, b_, hh); }
#pragma unroll 1
            for (int half = 0; half < 2; ++half) { int rb = r0 + half * 4; asm volatile("" : "+s"(rb));
                v4u zr[4][2], br[4][2];
#pragma unroll
                for (int i = 0; i < 4; ++i)
#pragma unroll
                    for (int hh = 0; hh < 2; ++hh) zr[i][hh] = __builtin_nontemporal_load((const v4u*)(Zg + (size_t)(rb + i) * 1024 + hh * 512 + lane * 8));
#pragma unroll
                for (int i = 0; i < 4; ++i)
#pragma unroll
                    for (int hh = 0; hh < 2; ++hh) br[i][hh] = __builtin_nontemporal_load((const v4u*)(Bg + (size_t)(rb + i) * 1024 + hh * 512 + lane * 8));
#pragma unroll
                for (int i = 0; i < 4; ++i) { const int row = rb + i;
#pragma unroll
                    for (int hh = 0; hh < 2; ++hh) { asm volatile("" : "+v"(zr[i][hh]), "+v"(br[i][hh])); }
                    f32x2 z0[8], bb[8], y[8], ss2 = (f32x2){0.f, 0.f};
                    CV_UNPK(z0, zr[i][0], 0); CV_UNPK(z0, zr[i][1], 1); CV_UNPK(bb, br[i][0], 0); CV_UNPK(bb, br[i][1], 1);
#pragma unroll
                    for (int k = 0; k < 8; ++k) { y[k] = bb[k] * (w0[k] * z2[k] + w1[k] * z1[k] + w2[k] * z0[k]); ss2 += y[k] * y[k]; }
                    const float rs = __builtin_amdgcn_rsqf(wave_sum(ss2.x + ss2.y) * (1.0f / 1024.0f) + RMS_EPS);
#pragma unroll
                    for (int hh = 0; hh < 2; ++hh) { v4u o;
#pragma unroll
                        for (int e = 0; e < 4; ++e) { const f32x2 t = y[hh * 4 + e] * rs; o[e] = pkbf(t.x, t.y); }
                        *(v4u*)((bf16*)((unsigned char*)MIXED + (size_t)row * MIX_PITCH + 1024) + hh * 512 + lane * 8) = o; }
#pragma unroll
                    for (int k = 0; k < 8; ++k) { z2[k] = z1[k]; z1[k] = z0[k]; } }
            }
#undef CV_UNPK
        }
}

struct Args { const float* in[12]; float* out; unsigned char* ws; };

__global__ void __launch_bounds__(NWAVES * 64, 2) hymba_fwd(Args args) {
    extern __shared__ __attribute__((aligned(16))) unsigned char lds[];
    const int tid = threadIdx.x, lane = tid & 63, wave = __builtin_amdgcn_readfirstlane(tid >> 6);
    const int G = gridDim.x, bx = blockIdx.x;
    const int vcu = (G % 8 == 0) ? (bx % 8) * (G / 8) + bx / 8 : bx;
    const int gw = vcu * NWAVES + wave, NGW = G * NWAVES;
    unsigned char* ws = args.ws;
    const float* x = args.in[0]; const float* w_in = args.in[1]; const float* conv_w = args.in[2]; const float* attn_g = args.in[3]; const float* conv_g = args.in[4];
    const float* w_o = args.in[5]; const float* ln1_g = args.in[6]; const float* ln1_b = args.in[7]; const float* w_up = args.in[8]; const float* w_down = args.in[9];
    const float* ln2_g = args.in[10]; const float* ln2_b = args.in[11];
    float* stats1 = (float*)(ws + WS_CTL + CTL_STATS1); float* stats2 = (float*)(ws + WS_CTL + CTL_STATS2);
    float* c1 = (float*)(ws + WS_CTL + CTL_C1); float* c2 = (float*)(ws + WS_CTL + CTL_C2);
    float* dummy = (float*)(ws + WS_CTL + CTL_DUMMY);
    float* kpart = (float*)(ws + WS_KPART); float* ssq = (float*)(ws + WS_SSQ);
    bf16* WinT = (bf16*)(ws + WS_WIN); unsigned char* Win8 = ws + WS_WIN8; bf16* WoT = (bf16*)(ws + WS_WO); unsigned char* Wup8 = ws + WS_WUP; bf16* WdnT = (bf16*)(ws + WS_WDN); float* xs = (float*)(ws + WS_XS);
    bf16* XB = (bf16*)(ws + WS_XB); bf16* PROJ = (bf16*)(ws + WS_PROJ); bf16* RB = (bf16*)(ws + WS_R); bf16* MIXED = (bf16*)(ws + WS_MIXED); bf16* YB = (bf16*)(ws + WS_YB); unsigned char* Y8 = ws + WS_Y8; unsigned char* X8 = ws + WS_X8;
    PG8_LAS unsigned char* ldsp = (PG8_LAS unsigned char*)lds;
    volatile LAS unsigned* MISC = (volatile LAS unsigned*)((LAS unsigned char*)lds + MISC_OFF);
    if (tid < 16) MISC[tid] = 0u;
    __syncthreads();
    const XcdBarrier bar = xcd_barrier_post((unsigned*)(ws + WS_CTL + CTL_BAR), MISC + 8, gridDim.x);
#define GRID_SYNC() xcd_barrier(bar)
    const bool grp_ok = (G == 256);
    const XcdBarrier gbar = xcd_barrier_post((unsigned*)(ws + WS_CTL + CTL_GBAR + (size_t)(bx & 7) * CTL_GBAR_STRIDE), MISC + 10, G / 8);
#define GROUP_SYNC() do { if (grp_ok) xcd_barrier(gbar); else xcd_barrier(bar); } while (0)

    for (int rep = 0; rep < NREP(0) && (PH_MASK & 1); ++rep) { if (rep) GRID_SYNC();
        p0_prologue(x, w_in, w_o, w_up, w_down, attn_g, conv_g, ln1_g, ln1_b, WinT, Win8, WoT, Wup8, WdnT, XB, X8, xs, rep ? dummy : c1, rep ? dummy + 8192 : c2, lds, wave, lane, tid, gw, NGW, G, bx);
    }
    GRID_SYNC();

    for (int rep = 0; rep < NREP(1) && (PH_MASK & 2); ++rep) { if (rep) GRID_SYNC();
        { pg8::Gemm g{XB, WinT, M_TOK, 2048, DM}; pg8::StaticOrder S; S.init(M_TOK, 2048, G, bx);
          pg8::EpiProj E{PROJ, kpart};
          pg8::gemm_phase<pg8::EpiProj, pg8::StaticOrder, true, true>(ldsp, g, S, E); }
        { pg8::Gemm g{(const bf16*)X8, (const bf16*)Win8, M_TOK, 4096, DM / 2}; pg8::StaticOrder S; S.init(M_TOK, 4096, G, bx);
          pg8::EpiProjI8 E{PROJ, xs};
          pg8::gemm_phase<pg8::EpiProjI8, pg8::StaticOrder, true, true, 3>(ldsp, g, S, E); }
    }
    GROUP_SYNC();

    for (int rep = 0; rep < NREP(2) && (PH_MASK & 4); ++rep) { if (rep) GRID_SYNC();
        if (vcu & 1) conv_pass(PROJ, MIXED, conv_w, vcu, G);
        att::Seam S; const att::Bases AB{PROJ, MIXED, ssq, kpart};
        int L = vcu, pass = 0;
        if (L < 256) {
            att::BlockRef cur{L >> 5, (L >> 3) & 3, L & 7};
            att::moba_prime(AB, cur, (char*)lds, S);
            for (;;) {
                const bool more_pass = pass == 0, more_item = L + G < 256, last = !more_pass && !more_item;
                int passn = pass + 1, Ln = L; if (!more_pass) { passn = 0; Ln = more_item ? L + G : L; }
                att::BlockRef nxt{Ln >> 5, passn ? 4 + ((Ln >> 3) & 3) : ((Ln >> 3) & 3), passn ? 7 - (Ln & 7) : (Ln & 7)}; if (last) nxt = cur;
                att::moba_block<true>(AB, cur, nxt, (char*)lds, S);
                if (last) break;
                cur = nxt; pass = passn; L = Ln;
            }
        }
        asm volatile("s_waitcnt vmcnt(0)" ::: "memory");
        if (!(vcu & 1)) conv_pass(PROJ, MIXED, conv_w, vcu, G);
    }
    GROUP_SYNC();

    for (int rep = 0; rep < NREP(3) && (PH_MASK & 8); ++rep) { if (rep) GRID_SYNC();
        pg8::Gemm g{MIXED, WoT, M_TOK, DM, MIX_PITCH / 2}; pg8::StaticOrder S; S.init(M_TOK, DM, G, bx);
        pg8::EpiWo E{XB, YB, Y8, rep ? dummy : stats1, ssq};
        pg8::gemm_phase<pg8::EpiWo, pg8::StaticOrder, true, true, 6>(ldsp, g, S, E);
    }
    GRID_SYNC();

    for (int rep = 0; rep < NREP(4) && (PH_MASK & 16); ++rep) { if (rep) GRID_SYNC();
        pg8::Gemm g{(const bf16*)Y8, (const bf16*)Wup8, M_TOK, FF, DM / 2}; pg8::StaticOrder S; S.init(M_TOK, FF, G, bx);
        pg8::EpiUp E{stats1, c1, c2, (unsigned char*)RB};
        pg8::gemm_phase<pg8::EpiUp, pg8::StaticOrder, true, true, 3>(ldsp, g, S, E);
    }
    GROUP_SYNC();

    for (int rep = 0; rep < NREP(5) && (PH_MASK & 32); ++rep) { if (rep) GRID_SYNC();
        pg8::Gemm g{RB, WdnT, M_TOK, DM, FF / 2}; pg8::PanelOrder S; S.init(M_TOK, DM, G, bx);
        pg8::EpiDownLN E{Y8, stats1, ln1_g, ln1_b, rep ? dummy : stats2, (unsigned*)(ws + WS_CTL + (rep ? CTL_CNT_DUMMY : CTL_CNT)), ln2_g, ln2_b, args.out};
        pg8::gemm_phase<pg8::EpiDownLN, pg8::PanelOrder, true, true, 2>(ldsp, g, S, E);
    }

    for (int xs = 0; xs < ((DUP_MASK >> 8) & 0xff); ++xs) GRID_SYNC();
    if ((DUP_MASK >> 7) & 1) { GRID_SYNC(); p0_prologue(x, w_in, w_o, w_up, w_down, attn_g, conv_g, ln1_g, ln1_b, WinT, Win8, WoT, Wup8, WdnT, XB, X8, xs, dummy, dummy + 8192, lds, wave, lane, tid, gw, NGW, G, bx); }
}

extern "C" void kernel_launch(void* const* d_in, const int* in_sizes, int n_in, void* d_out, int out_size, void* d_ws, size_t ws_size, hipStream_t stream) {
    static int grid = 0;
    if (grid == 0) {
        if (n_in != 12 || in_sizes[0] != M_TOK * DM || out_size != M_TOK * DM || ws_size < WS_END) {
            fprintf(stderr, "kernel_launch: shape/workspace mismatch (n_in %d, in0 %d, out %d, ws %zu; need ws >= %zu); nothing launched\n", n_in, n_in > 0 ? in_sizes[0] : -1, out_size, ws_size, (size_t)WS_END); grid = -1; return; }
        int dev = 0, cus = 0, per_cu = 0;
        if (hipGetDevice(&dev) != hipSuccess || hipDeviceGetAttribute(&cus, hipDeviceAttributeMultiprocessorCount, dev) != hipSuccess) { fprintf(stderr, "kernel_launch: device query failed\n"); grid = -1; return; }
        if (hipFuncSetAttribute((const void*)hymba_fwd, hipFuncAttributeMaxDynamicSharedMemorySize, LDS_BYTES) != hipSuccess) { fprintf(stderr, "kernel_launch: hipFuncSetAttribute failed\n"); grid = -1; return; }
        if (hipOccupancyMaxActiveBlocksPerMultiprocessor(&per_cu, (const void*)hymba_fwd, NWAVES * 64, LDS_BYTES) != hipSuccess || per_cu < 1) { fprintf(stderr, "kernel_launch: occupancy query says %d blocks per CU\n", per_cu); grid = -1; (void)hipGetLastError(); return; }
        grid = cus;
        if (grid > 256) grid = 256;
    }
    if (grid < 0) return;
    (void)hipMemsetAsync((char*)d_ws + WS_CTL, 0, CTL_ZERO_BYTES, stream);
    Args a{};
    for (int i = 0; i < 12; ++i) a.in[i] = (const float*)d_in[i];
    a.out = (float*)d_out; a.ws = (unsigned char*)d_ws;
    void* kargs[] = {&a};
    hipError_t e = hipLaunchCooperativeKernel((const void*)hymba_fwd, dim3(grid), dim3(NWAVES * 64), kargs, LDS_BYTES, stream);
    if (e != hipSuccess) fprintf(stderr, "kernel_launch: cooperative launch failed: %s (grid %d)\n", hipGetErrorString(e), grid);
}
```
